# Optimizing an MI355X kernel written in HIP

```python
import jax, jax.numpy as jnp
from jax import lax
import numpy as np

D_MODEL = 1024
BATCH = 2
SEQ = 16384
DEPTH = 1

CTX_LEN = 256
GRID_W = 64
EPS = 1e-6
N_MOD = 9
D_FF = 2816
M_HEADS = 4
M_HD = 128
M_W = M_HEADS * M_HD
CONV_W = 3
CHUNK = 128
POOL_WINDOWS = (2, 4, 8, 16)
POOL_GROUPS = len(POOL_WINDOWS)
POOL_W = 512
POOL_GW = POOL_W // POOL_GROUPS
MIX_W = M_W + POOL_W
M_COLS = 3 * M_W + 4 * M_HEADS
IN_COLS = M_COLS + POOL_W

kernel_name = 'hybrid_mlstm_pool_macaron_dit'


def rmsnorm(x, g):
    xf = x.astype(jnp.float32)
    y = xf * lax.rsqrt(jnp.mean(xf * xf, axis=-1, keepdims=True) + EPS)
    return (y * g.astype(jnp.float32)).astype(x.dtype)


def ada_in(x, mod, j, g):
    return rmsnorm(x, g) * (1 + mod[:, 3 * j + 1, None]) + mod[:, 3 * j, None]


def ada_out(x, z, mod, j, g, res_w):
    return x + res_w * mod[:, 3 * j + 2, None] * rmsnorm(z, g)


def swiglu(y, w_in, w_out):
    a, b = jnp.split(y @ w_in, 2, axis=-1)
    return (jax.nn.silu(a) * b) @ w_out


def centred_mean(u, win, axis):
    n = u.shape[axis]
    lo, hi = win // 2, win - 1 - win // 2
    pad = [(0, 0)] * u.ndim
    pad[axis] = (lo + 1, hi)
    s = jnp.cumsum(jnp.pad(u.astype(jnp.float32), pad), axis=axis)
    tot = lax.slice_in_dim(s, win, win + n, axis=axis) - lax.slice_in_dim(s, 0, n, axis=axis)
    t = jnp.arange(n)
    cnt = (jnp.minimum(t + hi, n - 1) - jnp.maximum(t - lo, 0) + 1).astype(jnp.float32)
    shape = [1] * u.ndim
    shape[axis] = n
    return (tot / cnt.reshape(shape)).astype(u.dtype)


def pool_mixer(u, w_pool, pool_scale, on_grid):
    bsz, n, _ = u.shape
    outs = []
    for gi, win in enumerate(POOL_WINDOWS):
        ug = u[..., gi * POOL_GW:(gi + 1) * POOL_GW]
        if on_grid:
            rows = n // GRID_W
            ug2 = ug.reshape(bsz, rows, GRID_W, POOL_GW)
            pg = centred_mean(centred_mean(ug2, win, 2), win, 1).reshape(bsz, n, POOL_GW)
        else:
            pg = centred_mean(ug, win, 1)
        outs.append(pg - ug)
    d = jnp.stack(outs, axis=2)
    y = jnp.einsum('bngc,gcd->bngd', d, w_pool).reshape(bsz, n, POOL_W)
    return y * pool_scale


def short_conv(u, w, b):
    n = u.shape[1]
    h = CONV_W // 2
    up = jnp.pad(u, ((0, 0), (h, h), (0, 0)))
    out = b
    for j in range(CONV_W):
        out = out + up[:, j:j + n] * w[j]
    return out


def mlstm_inputs(p, conv_w, conv_b, w_q, w_k, i_bias, f_bias):
    bsz, n, _ = p.shape
    u = jax.nn.silu(short_conv(p[..., :M_W], conv_w, conv_b)).reshape(bsz, n, M_HEADS, M_HD)
    q = jnp.einsum('bnhd,hde->bhne', u, w_q).astype(jnp.float32)
    k = jnp.einsum('bnhd,hde->bhne', u, w_k).astype(jnp.float32)
    v = p[..., M_W:2 * M_W].reshape(bsz, n, M_HEADS, M_HD).transpose(0, 2, 1, 3).astype(jnp.float32)
    g0 = 3 * M_W
    ig = (p[..., g0:g0 + 2 * M_HEADS].reshape(bsz, n, 2, M_HEADS) + i_bias).astype(jnp.float32)
    fg = (p[..., g0 + 2 * M_HEADS:M_COLS].reshape(bsz, n, 2, M_HEADS) + f_bias).astype(jnp.float32)
    return q, k, v, ig.transpose(2, 0, 3, 1), fg.transpose(2, 0, 3, 1)


def mlstm_chunkwise(q, k, v, i_pre, f_pre):
    bsz, nh, t_len, dk = q.shape
    nc = t_len // CHUNK
    q = q.reshape(bsz, nh, nc, CHUNK, dk)
    k = k.reshape(bsz, nh, nc, CHUNK, dk) * (dk ** -0.5)
    v = v.reshape(bsz, nh, nc, CHUNK, dk)
    ip = i_pre.reshape(bsz, nh, nc, CHUNK)
    b = jnp.cumsum(jax.nn.log_sigmoid(f_pre).reshape(bsz, nh, nc, CHUNK), axis=-1)
    g = b[..., -1]
    a = g[..., None] - b + ip
    m_loc = jnp.max(a, axis=-1)
    wk = jnp.exp(a - m_loc[..., None])[..., None] * k
    ckv = jnp.einsum('bhclk,bhclv->bhckv', wk, v)
    cn = jnp.sum(wk, axis=3)

    def step(carry, inp):
        c_st, n_st, m_st = carry
        g_c, m_c, ckv_c, cn_c = inp
        m_new = jnp.maximum(g_c + m_st, m_c)
        a_old = jnp.exp(g_c + m_st - m_new)
        a_new = jnp.exp(m_c - m_new)
        c_new = a_old[..., None, None] * c_st + a_new[..., None, None] * ckv_c
        n_new = a_old[..., None] * n_st + a_new[..., None] * cn_c
        return (c_new, n_new, m_new), (c_st, n_st, m_st)

    init = (jnp.zeros((bsz, nh, dk, dk), jnp.float32), jnp.zeros((bsz, nh, dk), jnp.float32),
            jnp.zeros((bsz, nh), jnp.float32))
    xs = (jnp.moveaxis(g, -1, 0), jnp.moveaxis(m_loc, -1, 0), jnp.moveaxis(ckv, 2, 0), jnp.moveaxis(cn, 2, 0))
    _, (c_in, n_in, m_in) = lax.scan(step, init, xs)
    c_in = jnp.moveaxis(c_in, 0, 2)
    n_in = jnp.moveaxis(n_in, 0, 2)
    m_in = jnp.moveaxis(m_in, 0, -1)
    mask = jnp.tril(jnp.ones((CHUNK, CHUNK), dtype=bool))
    dmat = jnp.where(mask, b[..., :, None] - b[..., None, :] + ip[..., None, :], -jnp.inf)
    inter = b + m_in[..., None]
    m_t = jnp.maximum(jnp.max(dmat, axis=-1), inter)
    s = jnp.einsum('bhctk,bhcsk->bhcts', q, k) * jnp.exp(dmat - m_t[..., None])
    w_inter = jnp.exp(inter - m_t)
    num = w_inter[..., None] * jnp.einsum('bhctk,bhckv->bhctv', q, c_in) + jnp.einsum('bhcts,bhcsv->bhctv', s, v)
    den = w_inter * jnp.einsum('bhctk,bhck->bhct', q, n_in) + jnp.sum(s, axis=-1)
    h = num / jnp.maximum(jnp.abs(den), jnp.exp(-m_t))[..., None]
    return h.reshape(bsz, nh, t_len, dk)


def mlstm_bidir(p_lat, p_ctx, conv_w, conv_b, w_q, w_k, i_bias, f_bias):
    ql, kl, vl, il, fl = mlstm_inputs(p_lat, conv_w, conv_b, w_q, w_k, i_bias, f_bias)
    qc, kc, vc, ic, fc = mlstm_inputs(p_ctx, conv_w, conv_b, w_q, w_k, i_bias, f_bias)
    lc = qc.shape[2]
    cat = lambda a, b: jnp.concatenate([a, b], axis=2)
    rev = lambda a: jnp.flip(a, axis=2)
    h_f = mlstm_chunkwise(cat(qc, ql), cat(kc, kl), cat(vc, vl), cat(ic[0], il[0]), cat(fc[0], fl[0]))
    h_b = mlstm_chunkwise(cat(rev(qc), rev(ql)), cat(rev(kc), rev(kl)), cat(rev(vc), rev(vl)),
                          cat(rev(ic[1]), rev(il[1])), cat(rev(fc[1]), rev(fl[1])))
    h_lat = h_f[:, :, lc:] + rev(h_b[:, :, lc:])
    h_ctx = h_f[:, :, :lc] + rev(h_b[:, :, :lc])
    return h_lat, h_ctx


def mlstm_out(h, o, g):
    bsz, _, n, _ = h.shape
    h = h.transpose(0, 2, 1, 3)
    h = h * lax.rsqrt(jnp.mean(h * h, axis=-1, keepdims=True) + EPS) * g.reshape(M_HEADS, M_HD).astype(jnp.float32)
    return (h.reshape(bsz, n, M_W) * jax.nn.sigmoid(o.astype(jnp.float32))).astype(o.dtype)


def setup_inputs(seed: int = 0) -> dict:
    key = jax.random.key(seed)
    ks = jax.random.split(key, 24)
    nrm = lambda k, shape, s: jax.random.normal(k, shape, jnp.float32) * s
    f_base = jnp.linspace(3.0, 6.0, M_HEADS, dtype=jnp.float32)
    return {
        'x': nrm(ks[0], (BATCH, SEQ, D_MODEL), 1.0),
        'c': nrm(ks[1], (BATCH, D_MODEL), 1.0),
        'ctx': nrm(ks[2], (BATCH, CTX_LEN, D_MODEL), 1.0),
        'c_ctx': nrm(ks[3], (D_MODEL,), 1.0),
        'w_mod': nrm(ks[4], (DEPTH, D_MODEL, N_MOD * D_MODEL), D_MODEL ** -0.5),
        'b_mod': nrm(ks[5], (DEPTH, N_MOD * D_MODEL), 0.02),
        'norm_pre': 1.0 + nrm(ks[6], (DEPTH, 3, D_MODEL), 0.05),
        'norm_post': 1.0 + nrm(ks[7], (DEPTH, 3, D_MODEL), 0.05),
        'ffn_w_in': nrm(ks[8], (DEPTH, 2, D_MODEL, 2 * D_FF), D_MODEL ** -0.5),
        'ffn_w_out': nrm(ks[9], (DEPTH, 2, D_FF, D_MODEL), D_FF ** -0.5),
        'w_in': nrm(ks[10], (DEPTH, D_MODEL, IN_COLS), D_MODEL ** -0.5),
        'w_out': nrm(ks[11], (DEPTH, MIX_W, D_MODEL), MIX_W ** -0.5),
        'conv_w': nrm(ks[12], (DEPTH, CONV_W, M_W), CONV_W ** -0.5),
        'conv_b': nrm(ks[13], (DEPTH, M_W), 0.02),
        'w_q': nrm(ks[14], (DEPTH, M_HEADS, M_HD, M_HD), M_HD ** -0.5),
        'w_k': nrm(ks[15], (DEPTH, M_HEADS, M_HD, M_HD), M_HD ** -0.5),
        'i_bias': nrm(ks[16], (DEPTH, 2, M_HEADS), 0.1),
        'f_bias': f_base + nrm(ks[17], (DEPTH, 2, M_HEADS), 0.1),
        'head_norm': 1.0 + nrm(ks[18], (DEPTH, M_W), 0.05),
        'pool_w': nrm(ks[19], (DEPTH, POOL_GROUPS, POOL_GW, POOL_GW), POOL_GW ** -0.5),
        'pool_scale': 1.0 + nrm(ks[20], (DEPTH, POOL_W), 0.1),
    }


def reference(x, c, ctx, c_ctx, w_mod, b_mod, norm_pre, norm_post, ffn_w_in, ffn_w_out, w_in, w_out,
              conv_w, conv_b, w_q, w_k, i_bias, f_bias, head_norm, pool_w, pool_scale):
    sc = jax.nn.silu(c)
    scc = jax.nn.silu(c_ctx)[None]
    xc = ctx
    for l in range(DEPTH):
        ctx_out = l < DEPTH - 1
        mod = (sc @ w_mod[l] + b_mod[l]).reshape(-1, N_MOD, D_MODEL)
        modc = (scc @ w_mod[l] + b_mod[l]).reshape(1, N_MOD, D_MODEL)
        x = ada_out(x, swiglu(ada_in(x, mod, 0, norm_pre[l, 0]), ffn_w_in[l, 0], ffn_w_out[l, 0]),
                    mod, 0, norm_post[l, 0], 0.5)
        xc = ada_out(xc, swiglu(ada_in(xc, modc, 0, norm_pre[l, 0]), ffn_w_in[l, 0], ffn_w_out[l, 0]),
                     modc, 0, norm_post[l, 0], 0.5)
        p = ada_in(x, mod, 1, norm_pre[l, 1]) @ w_in[l]
        pc = ada_in(xc, modc, 1, norm_pre[l, 1]) @ (w_in[l] if ctx_out else w_in[l, :, :M_COLS])
        h_lat, h_ctx = mlstm_bidir(p[..., :M_COLS], pc[..., :M_COLS], conv_w[l], conv_b[l],
                                   w_q[l], w_k[l], i_bias[l], f_bias[l])
        mix = jnp.concatenate([mlstm_out(h_lat, p[..., 2 * M_W:3 * M_W], head_norm[l]),
                               pool_mixer(p[..., M_COLS:], pool_w[l], pool_scale[l], True)], axis=-1)
        x = ada_out(x, mix @ w_out[l], mod, 1, norm_post[l, 1], 1.0)
        if ctx_out:
            mixc = jnp.concatenate([mlstm_out(h_ctx, pc[..., 2 * M_W:3 * M_W], head_norm[l]),
                                    pool_mixer(pc[..., M_COLS:], pool_w[l], pool_scale[l], False)], axis=-1)
            xc = ada_out(xc, mixc @ w_out[l], modc, 1, norm_post[l, 1], 1.0)
        x = ada_out(x, swiglu(ada_in(x, mod, 2, norm_pre[l, 2]), ffn_w_in[l, 1], ffn_w_out[l, 1]),
                    mod, 2, norm_post[l, 2], 0.5)
        if ctx_out:
            xc = ada_out(xc, swiglu(ada_in(xc, modc, 2, norm_pre[l, 2]), ffn_w_in[l, 1], ffn_w_out[l, 1]),
                         modc, 2, norm_post[l, 2], 0.5)
    return x
```

```cpp
#include <hip/hip_runtime.h>
#include <hip/hip_cooperative_groups.h>
#include <cstdio>
#include <cstdint>
namespace cg = cooperative_groups;
namespace pg8 {
#define PG8_LAS __attribute__((address_space(3)))
typedef unsigned short bf16_t;
typedef short bf16x8 __attribute__((ext_vector_type(8)));
typedef float f32x4 __attribute__((ext_vector_type(4)));
typedef unsigned u32x4 __attribute__((ext_vector_type(4)));
constexpr int BM = 256, BK = 64, HALF = 128, HTB = HALF * BK * 2  , STAGE_BYTES = 8 * HTB, NXCD = 8, WGM = 8;

__host__ __device__ __forceinline__ int lds_byte(int r, int c) { const int st = (r >> 4) * 2 + (c >> 5), rr = r & 15, cc = c & 31, ob = rr * 64 + cc * 2; return st * 1024 + (ob ^ (((ob >> 9) & 1) << 5)); }
__host__ __device__ __forceinline__ void stage_rc(int b, int& R, int& C) { const int st = b / 1024, sb = b % 1024, swz = sb ^ (((sb >> 9) & 1) << 5); R = (st >> 1) * 16 + swz / 64; C = (st & 1) * 32 + (swz % 64) / 2; }
__host__ __device__ __forceinline__ int perm32(int rho) { const int n = rho >> 4, i = rho & 15; return 8 * (i >> 2) + 4 * n + (i & 3); }

struct Unit { int pm, pn; };
struct Gemm { const bf16_t* A; const bf16_t* Bt; int M, N, K; };

struct StaticOrder {
    int nM, nN, nwg, G, c;
    __host__ __device__ void init(int M, int N, int G_, int c_) { nM = M / BM; nN = N / BM; nwg = nM * nN; G = G_; c = c_; }
    __host__ __device__ bool next(int i, Unit& u) const {
        const long L = (long)i * G + c; if (L >= nwg) return false;
        int wgid = (int)L; { const int q = nwg / NXCD, r = nwg % NXCD, xcd = wgid % NXCD, off = wgid / NXCD; wgid = (xcd < r ? xcd * (q + 1) : r * (q + 1) + (xcd - r) * q) + off; }
        const int nig = WGM * nN, gid = wgid / nig, fm = gid * WGM, gsz = (nM - fm) < WGM ? (nM - fm) : WGM;
        u.pm = fm + ((wgid % nig) % gsz); u.pn = (wgid % nig) / gsz; return true;
    }
    __device__ __forceinline__ void a_ready(const Unit&) const {}
    __device__ __forceinline__ void done(const Unit&) const {}
};
__device__ __forceinline__ unsigned cvt_pk_bf16(float lo, float hi) { unsigned r; asm volatile("v_cvt_pk_bf16_f32 %0, %1, %2" : "=v"(r) : "v"(lo), "v"(hi)); return r; }
typedef float f32x2 __attribute__((ext_vector_type(2)));
typedef unsigned u32x2 __attribute__((ext_vector_type(2)));
struct EpiStore {
    static constexpr bool PERM = true, AFTER_DRAIN = false;
    bf16_t* O; int ldc;
    __device__ __forceinline__ void operator()(const f32x4 (&acc)[2][2][4][2], const Unit& u, int wr, int wc, int fr, int fq) const {
        const int row0 = u.pm * BM + wr * 64 + fr, col0 = u.pn * BM + wc * 32 + 8 * fq;
#pragma unroll
        for (int ai = 0; ai < 2; ++ai)
#pragma unroll
            for (int m = 0; m < 4; ++m) { bf16_t* rowp = O + (size_t)(row0 + ai * HALF + m * 16) * ldc + col0;
#pragma unroll
                for (int bj = 0; bj < 2; ++bj) { const f32x4 v0 = acc[ai][bj][m][0], v1 = acc[ai][bj][m][1];
                    u32x4 w; w.x = cvt_pk_bf16(v0[0], v0[1]); w.y = cvt_pk_bf16(v0[2], v0[3]); w.z = cvt_pk_bf16(v1[0], v1[1]); w.w = cvt_pk_bf16(v1[2], v1[3]);
                    *(u32x4*)(rowp + bj * HALF) = w; } }
    }
};
__device__ __forceinline__ float silu_mul(float a, float b) { return a * b * __builtin_amdgcn_rcpf(1.0f + __builtin_amdgcn_exp2f(a * -1.4426950408889634f)); }
struct EpiSwiglu {
    static constexpr bool PERM = true, AFTER_DRAIN = false;
    bf16_t* O; int ldc;
    __device__ __forceinline__ void operator()(const f32x4 (&acc)[2][2][4][2], const Unit& u, int wr, int wc, int fr, int fq) const {
        const int row0 = u.pm * BM + wr * 64 + fr, col0 = u.pn * HALF + wc * 32 + 8 * fq;
#pragma unroll
        for (int ai = 0; ai < 2; ++ai)
#pragma unroll
            for (int m = 0; m < 4; ++m) { bf16_t* rowp = O + (size_t)(row0 + ai * HALF + m * 16) * ldc + col0;
                const f32x4 a0 = acc[ai][0][m][0], a1 = acc[ai][0][m][1], b0 = acc[ai][1][m][0], b1 = acc[ai][1][m][1];
                u32x4 w; w.x = cvt_pk_bf16(silu_mul(a0[0], b0[0]), silu_mul(a0[1], b0[1])); w.y = cvt_pk_bf16(silu_mul(a0[2], b0[2]), silu_mul(a0[3], b0[3]));
                w.z = cvt_pk_bf16(silu_mul(a1[0], b1[0]), silu_mul(a1[1], b1[1])); w.w = cvt_pk_bf16(silu_mul(a1[2], b1[2]), silu_mul(a1[3], b1[3]));
                *(u32x4*)rowp = w; }
    }
};
struct EpiInProj {
    static constexpr bool PERM = true, AFTER_DRAIN = false;
    bf16_t* P; float* gates; const float* ib; const float* fb;
    __device__ __forceinline__ void operator()(const f32x4 (&acc)[2][2][4][2], const Unit& u, int wr, int wc, int fr, int fq) const {
        const int row0 = u.pm * BM + wr * 64 + fr;
        if (u.pn < 8) {
            const int col0 = u.pn * BM + wc * 32 + 8 * fq;
#pragma unroll
            for (int ai = 0; ai < 2; ++ai)
#pragma unroll
                for (int m = 0; m < 4; ++m) { bf16_t* rowp = P + (size_t)(row0 + ai * HALF + m * 16) * 2048 + col0;
#pragma unroll
                    for (int bj = 0; bj < 2; ++bj) { const f32x4 v0 = acc[ai][bj][m][0], v1 = acc[ai][bj][m][1];
                        u32x4 w; w.x = cvt_pk_bf16(v0[0], v0[1]); w.y = cvt_pk_bf16(v0[2], v0[3]); w.z = cvt_pk_bf16(v1[0], v1[1]); w.w = cvt_pk_bf16(v1[2], v1[3]);
                        *(u32x4*)(rowp + bj * HALF) = w; } }
        } else if (wc == 0 && fq < 2) {
            const float* bp = (fq == 0) ? ib : fb;
            const f32x4 bv0 = *(const f32x4*)bp, bv1 = *(const f32x4*)(bp + 4);
#pragma unroll
            for (int ai = 0; ai < 2; ++ai)
#pragma unroll
                for (int m = 0; m < 4; ++m) { float* gp = gates + (size_t)(row0 + ai * HALF + m * 16) * 16 + 8 * fq;
                    *(f32x4*)gp = acc[ai][0][m][0] + bv0; *(f32x4*)(gp + 4) = acc[ai][0][m][1] + bv1; }
        }
    }
};
template <class Epi, class Sched, bool ALIGN_EPI = false, bool SP2 = false>
__device__ __forceinline__ void gemm_phase(PG8_LAS unsigned char* lds, const Gemm g, const Sched& S, const Epi& E) {
    const int tid = threadIdx.x, wid = __builtin_amdgcn_readfirstlane(tid >> 6), lane = tid & 63, wr = wid >> 2, wc = wid & 3, fr = lane & 15, fq = lane >> 4;
    const int K = g.K, nt = K / BK;
    unsigned voffA[2], voffB[2];
#pragma unroll
    for (int i = 0; i < 2; ++i) { int R, C; stage_rc(tid * 16 + i * 8192, R, C); const int Rb = Epi::PERM ? ((R & ~31) + perm32(R & 31)) : R;
        voffA[i] = (unsigned)(R * K + C) * 2u; voffB[i] = (unsigned)(Rb * K + C) * 2u; }
    const size_t kstep = (size_t)(BK * 2);
    const size_t hstep = (size_t)HALF * K * 2;
    const size_t tstep = 2 * hstep;
    const unsigned ldsw = (unsigned)wid * 1024u;
    const int aoff = lds_byte(wr * 64 + fr, fq * 8), boff = lds_byte(wc * 32 + fr, fq * 8);
#define PG8_SA(b, h) (((b) * 2 + (h)) * HTB)
#define PG8_SB(b, h) ((4 + (b) * 2 + (h)) * HTB)
#define PG8_STAGE(bufoff, gbase, voff) do { _Pragma("unroll") for (int _i = 0; _i < 2; ++_i) \
        __builtin_amdgcn_global_load_lds((const unsigned*)((const char*)(gbase) + (voff)[_i]), (PG8_LAS unsigned*)(lds + (bufoff) + ldsw + _i * 8192), 16, 0, 0); } while (0)
#define PG8_LDA(dst, b, h) do { _Pragma("unroll") for (int m = 0; m < 4; ++m) _Pragma("unroll") for (int k = 0; k < 2; ++k) dst[m][k] = *(const PG8_LAS bf16x8*)(lds + PG8_SA(b, h) + aoff + m * 2048 + k * 1024); } while (0)
#define PG8_LDB(dst, b, h) do { _Pragma("unroll") for (int n = 0; n < 2; ++n) _Pragma("unroll") for (int k = 0; k < 2; ++k) dst[n][k] = *(const PG8_LAS bf16x8*)(lds + PG8_SB(b, h) + boff + n * 2048 + k * 1024); } while (0)
#define PG8_MMA(ai, bj, At, Bt) do { __builtin_amdgcn_s_setprio(1); _Pragma("unroll") for (int m = 0; m < 4; ++m) _Pragma("unroll") for (int n = 0; n < 2; ++n) _Pragma("unroll") for (int k = 0; k < 2; ++k) \
        acc[ai][bj][m][n] = __builtin_amdgcn_mfma_f32_16x16x32_bf16(Bt[n][k], At[m][k], acc[ai][bj][m][n], 0, 0, 0); __builtin_amdgcn_s_setprio(0); } while (0)
#define PG8_WAIT_V(n) asm volatile("s_waitcnt vmcnt(" #n ")" ::: "memory")
#define PG8_WAIT_L(n) asm volatile("s_waitcnt lgkmcnt(" #n ")" ::: "memory")
#define PG8_BAR __builtin_amdgcn_s_barrier()
#define PG8_SCHED __builtin_amdgcn_sched_barrier(0)
    Unit cur, nxt; int ui = 0;
    if (!S.next(0, cur)) return;
    f32x4 acc[2][2][4][2];
#pragma unroll
    for (int a = 0; a < 2; ++a)
#pragma unroll
        for (int b = 0; b < 2; ++b)
#pragma unroll
            for (int m = 0; m < 4; ++m)
#pragma unroll
                for (int n = 0; n < 2; ++n) acc[a][b][m][n] = (f32x4){0.f, 0.f, 0.f, 0.f};
    bf16x8 At[4][2], B0[2][2], B1[2][2];
    const char* cA = (const char*)g.A + (size_t)cur.pm * tstep; const char* cB = (const char*)g.Bt + (size_t)cur.pn * tstep;
    S.a_ready(cur);
    if constexpr (SP2) {
        PG8_STAGE(PG8_SB(0, 0), cB, voffB); PG8_STAGE(PG8_SB(0, 1), cB + hstep, voffB); PG8_STAGE(PG8_SA(0, 0), cA, voffA); PG8_STAGE(PG8_SA(0, 1), cA + hstep, voffA);
        if (wr == 1) PG8_BAR;
        PG8_WAIT_V(2); PG8_BAR;
        PG8_STAGE(PG8_SB(1, 0), cB + kstep, voffB); PG8_STAGE(PG8_SA(1, 0), cA + kstep, voffA); PG8_STAGE(PG8_SB(1, 1), cB + hstep + kstep, voffB);
        PG8_WAIT_V(6); PG8_BAR;
    } else {
        PG8_STAGE(PG8_SB(0, 0), cB, voffB); PG8_STAGE(PG8_SA(0, 0), cA, voffA); PG8_STAGE(PG8_SB(0, 1), cB + hstep, voffB); PG8_STAGE(PG8_SA(0, 1), cA + hstep, voffA);
        if (wr == 1) PG8_BAR;
        PG8_WAIT_V(4); PG8_BAR;
        PG8_STAGE(PG8_SB(1, 0), cB + kstep, voffB); PG8_STAGE(PG8_SA(1, 0), cA + kstep, voffA); PG8_STAGE(PG8_SB(1, 1), cB + hstep + kstep, voffB);
        PG8_WAIT_V(6); PG8_BAR;
    }
    for (;;) {
        const bool has_next = S.next(ui + 1, nxt);
        const char* nA = has_next ? (const char*)g.A + (size_t)nxt.pm * tstep : cA; const char* nB = has_next ? (const char*)g.Bt + (size_t)nxt.pn * tstep : cB;
        for (int t = 0; t < nt; t += 2) {
            const bool last = (t == nt - 2);
            const char* a1 = cA + (size_t)(t + 1) * kstep;
            const char* a2 = last ? nA : cA + (size_t)(t + 2) * kstep; const char* b2 = last ? nB : cB + (size_t)(t + 2) * kstep;
            const char* a3 = a2 + kstep; const char* b3 = b2 + kstep;
            if (last && has_next) S.a_ready(nxt);
            if constexpr (SP2) {
            PG8_LDB(B0, 0, 0); PG8_LDB(B1, 0, 1); PG8_SCHED; PG8_LDA(At, 0, 0); PG8_STAGE(PG8_SA(1, 1), a1 + hstep, voffA);
            PG8_WAIT_V(8); PG8_WAIT_L(0); PG8_BAR; PG8_MMA(0, 0, At, B0); PG8_MMA(0, 1, At, B1); PG8_BAR; PG8_SCHED;
            PG8_LDA(At, 0, 1); PG8_STAGE(PG8_SB(0, 0), b2, voffB); PG8_STAGE(PG8_SB(0, 1), b2 + hstep, voffB); PG8_STAGE(PG8_SA(0, 0), a2, voffA);
            PG8_WAIT_V(8); PG8_WAIT_L(0); PG8_BAR; PG8_MMA(1, 0, At, B0); PG8_MMA(1, 1, At, B1); PG8_BAR; PG8_SCHED;
            PG8_LDB(B0, 1, 0); PG8_LDB(B1, 1, 1); PG8_SCHED; PG8_LDA(At, 1, 0); PG8_STAGE(PG8_SA(0, 1), a2 + hstep, voffA);
            PG8_WAIT_V(8); PG8_WAIT_L(0); PG8_BAR; PG8_MMA(0, 0, At, B0); PG8_MMA(0, 1, At, B1); PG8_BAR; PG8_SCHED;
            PG8_LDA(At, 1, 1); PG8_STAGE(PG8_SB(1, 0), b3, voffB); PG8_STAGE(PG8_SB(1, 1), b3 + hstep, voffB); PG8_STAGE(PG8_SA(1, 0), a3, voffA);
            PG8_WAIT_V(8); PG8_WAIT_L(0); PG8_BAR; PG8_MMA(1, 0, At, B0); PG8_MMA(1, 1, At, B1); PG8_BAR; PG8_SCHED;
            } else {
            PG8_LDB(B0, 0, 0); PG8_SCHED; PG8_LDA(At, 0, 0); PG8_STAGE(PG8_SA(1, 1), a1 + hstep, voffA);
            PG8_WAIT_L(8); PG8_BAR; PG8_WAIT_L(0); PG8_MMA(0, 0, At, B0); PG8_BAR; PG8_SCHED;
            PG8_LDB(B1, 0, 1); PG8_STAGE(PG8_SB(0, 0), b2, voffB);
            PG8_BAR; PG8_WAIT_L(0); PG8_MMA(0, 1, At, B1); PG8_BAR;
            PG8_LDA(At, 0, 1); PG8_STAGE(PG8_SA(0, 0), a2, voffA);
            PG8_BAR; PG8_WAIT_L(0); PG8_MMA(1, 0, At, B0); PG8_BAR; PG8_SCHED;
            PG8_STAGE(PG8_SB(0, 1), b2 + hstep, voffB);
            PG8_WAIT_V(6); PG8_BAR; PG8_MMA(1, 1, At, B1); PG8_BAR;
            PG8_LDB(B0, 1, 0); PG8_SCHED; PG8_LDA(At, 1, 0); PG8_STAGE(PG8_SA(0, 1), a2 + hstep, voffA);
            PG8_WAIT_L(8); PG8_BAR; PG8_WAIT_L(0); PG8_MMA(0, 0, At, B0); PG8_BAR; PG8_SCHED;
            PG8_LDB(B1, 1, 1); PG8_STAGE(PG8_SB(1, 0), b3, voffB);
            PG8_BAR; PG8_WAIT_L(0); PG8_MMA(0, 1, At, B1); PG8_BAR;
            PG8_LDA(At, 1, 1); PG8_STAGE(PG8_SA(1, 0), a3, voffA);
            PG8_BAR; PG8_WAIT_L(0); PG8_MMA(1, 0, At, B0); PG8_BAR; PG8_SCHED;
            PG8_STAGE(PG8_SB(1, 1), b3 + hstep, voffB);
            PG8_WAIT_V(6); PG8_BAR; PG8_MMA(1, 1, At, B1); PG8_BAR;
            }
        }
        if constexpr (ALIGN_EPI) { if (wr == 0) PG8_BAR; }
        if constexpr (!Epi::AFTER_DRAIN) { E(acc, cur, wr, wc, fr, fq); S.done(cur); }
        if (!has_next) break;
#pragma unroll
        for (int a = 0; a < 2; ++a)
#pragma unroll
            for (int b = 0; b < 2; ++b)
#pragma unroll
                for (int m = 0; m < 4; ++m)
#pragma unroll
                    for (int n = 0; n < 2; ++n) acc[a][b][m][n] = (f32x4){0.f, 0.f, 0.f, 0.f};
        cur = nxt; cA = nA; cB = nB; ++ui;
        if constexpr (ALIGN_EPI) { if (wr == 1) PG8_BAR; }
    }
    PG8_WAIT_V(0);
    if constexpr (!ALIGN_EPI) { if (wr == 0) PG8_BAR; }
    PG8_BAR;
    if constexpr (Epi::AFTER_DRAIN) { E.fused(acc, cur, wr, wc, fr, fq, lds, wid, lane); S.done(cur); }
#undef PG8_SA
#undef PG8_SB
#undef PG8_STAGE
#undef PG8_LDA
#undef PG8_LDB
#undef PG8_MMA
#undef PG8_WAIT_V
#undef PG8_WAIT_L
#undef PG8_BAR
#undef PG8_SCHED
}
}
constexpr int DM = 1024, SEQ = 16384, NB = 2, CTXL = 256, FF = 2816, NMOD = 9;
constexpr int ML = NB * SEQ, MC = NB * CTXL, MT = ML + MC;
constexpr int NH = 4, HD = 128, MW = 512, GW = 64, GRID_ROWS = SEQ / GW;
constexpr int NTB = 130;
constexpr float EPS = 1e-6f;
constexpr int NWAVES = 8, NTHREADS = 512;

constexpr size_t MiB = 1u << 20, KiB = 1024;
constexpr size_t WS_CTL = 0;
constexpr size_t WS_MOD = 1 * MiB;
constexpr size_t WS_WQT = 1 * MiB + 256 * KiB;
constexpr size_t WS_WKT = 1 * MiB + 512 * KiB;
constexpr size_t WS_MLOC = 1 * MiB + 768 * KiB;
constexpr size_t WS_G = WS_MLOC + 16 * KiB;
constexpr size_t WS_MIN = WS_G + 16 * KiB;
constexpr size_t WS_CN = 2 * MiB;
constexpr size_t WS_NIN = 3 * MiB + 256 * KiB;
constexpr size_t WS_GATES = 5 * MiB;
constexpr size_t WS_W1 = 8 * MiB;
constexpr size_t WS_W2 = 30 * MiB;
constexpr size_t WS_WIN = 41 * MiB;
constexpr size_t WS_WOUT = 46 * MiB;
constexpr size_t WS_Y = 48 * MiB;
constexpr size_t WS_Z = 113 * MiB;
constexpr size_t WS_CKV = 48 * MiB;
constexpr size_t WS_H = 178 * MiB;
constexpr size_t WS_P = 178 * MiB;
constexpr size_t WS_Q = 308 * MiB;
constexpr size_t WS_K = WS_Q + (size_t)MT * 512 * 2;
constexpr size_t WS_CIN = 373 * MiB;
constexpr size_t WS_MIX = 437 * MiB;
constexpr size_t WS_END = 501 * MiB;
static_assert(WS_K + (size_t)MT * 512 * 2 <= WS_CIN && WS_Z + (size_t)MT * 1024 * 2 <= WS_H && WS_CKV + (size_t)16 * 130 * 65536 <= WS_H && WS_P + (size_t)MT * 2048 * 2 <= WS_Q, "ws map");
static_assert(WS_GATES + (size_t)MT * 64 <= WS_W1 && WS_NIN + 16 * 130 * 512 <= WS_GATES && WS_CN + 16 * 130 * 512 <= WS_NIN, "ws map small");
constexpr size_t CTL_ZERO_BYTES = 64 * KiB;

constexpr int LDS_BYTES = 160 * 1024;

#define LAS __attribute__((address_space(3)))
typedef unsigned short bf16;
typedef short bf16x8 __attribute__((ext_vector_type(8)));
typedef float f32x4 __attribute__((ext_vector_type(4)));
typedef float f32x2v __attribute__((ext_vector_type(2)));
typedef unsigned u32x4 __attribute__((ext_vector_type(4)));
typedef unsigned u32x2 __attribute__((ext_vector_type(2)));
#define LDS_WAIT() asm volatile("s_waitcnt lgkmcnt(0)" ::: "memory")

__device__ __forceinline__ unsigned f2bf(float f) { unsigned u = __builtin_bit_cast(unsigned, f); return (u + 0x7fffu + ((u >> 16) & 1u)) >> 16; }
__device__ __forceinline__ unsigned pk2(float lo, float hi) { return f2bf(lo) | (f2bf(hi) << 16); }
__device__ __forceinline__ float bflo(unsigned w) { return __uint_as_float(w << 16); }
__device__ __forceinline__ float bfhi(unsigned w) { return __uint_as_float(w & 0xffff0000u); }
__device__ __forceinline__ float wave_sum(float v) {
#pragma unroll
    for (int o = 1; o < 64; o <<= 1) v += __shfl_xor(v, o);
    return v;
}
__device__ __forceinline__ float wave_max(float v) {
#pragma unroll
    for (int o = 1; o < 64; o <<= 1) v = fmaxf(v, __shfl_xor(v, o));
    return v;
}
__device__ __forceinline__ float log_sigmoid(float x) { return fminf(x, 0.f) - log1pf(expf(-fabsf(x))); }
__device__ __forceinline__ f32x4 mfma16(bf16x8 a, bf16x8 b, f32x4 c) { return __builtin_amdgcn_mfma_f32_16x16x32_bf16(a, b, c, 0, 0, 0); }

struct Args { const float* in[21]; float* out; unsigned char* ws; int ph_lo, ph_hi; };

struct Ctx {
    LAS unsigned char* lds;
    int tid, lane, wave, G, bid;
    const float *x, *c, *ctx, *cctx, *wmod, *bmod, *npre, *npost, *fwin, *fwout, *win, *wout, *convw, *convb, *wq, *wk, *ibias, *fbias, *hnorm, *poolw, *pscale;
    float* out; unsigned char* ws;
    float* mod; bf16 *wqt, *wkt; float *mloc, *gsum, *min_, *cn, *nin, *gates;
    bf16 *W1, *W2, *WIN, *WOUT, *Y, *Z, *H, *P, *Q, *K, *CIN, *MIX; float* CKV;
};

constexpr int TP0_SCR = 16384;
constexpr int P0_SC_OFF = 131072, P0_RED_OFF = 131072 + 12288;

__device__ __forceinline__ void tr_store(LAS float* scr, bf16* WT, int K, int n0, int k0, int lane) {
    const int c = lane & 7;
#pragma unroll
    for (int j = 0; j < 4; ++j) { const int n = (lane >> 3) + 8 * j; const LAS float* s = scr + (8 * c) * 33 + n;
        u32x4 o; o.x = pk2(s[0 * 33], s[1 * 33]); o.y = pk2(s[2 * 33], s[3 * 33]); o.z = pk2(s[4 * 33], s[5 * 33]); o.w = pk2(s[6 * 33], s[7 * 33]);
        *(u32x4*)(WT + (size_t)(n0 + n) * K + k0 + 8 * c) = o; }
}
__device__ __forceinline__ void tr_item(const float* W, int ldw, bf16* WT, int K, int n0, int srccol, int k0, LAS float* scr, int lane) {
#pragma unroll 8
    for (int i = 0; i < 32; ++i) { const int kk = 2 * i + (lane >> 5); scr[kk * 33 + (lane & 31)] = (srccol >= 0) ? W[(size_t)(k0 + kk) * ldw + srccol] : 0.f; }
    LDS_WAIT(); asm volatile("" ::: "memory");
    tr_store(scr, WT, K, n0, k0, lane);
    LDS_WAIT(); asm volatile("" ::: "memory");
}

constexpr int IT_W1 = 16 * 176, IT_W2 = 44 * 32, IT_WIN = 16 * 72, IT_WO = 8 * 32, IT_WE = 8 * 32, IT_QK = 8;
constexpr int IT_TOTAL = 2 * IT_W1 + 2 * IT_W2 + IT_WIN + IT_WO + IT_WE + 8 * IT_QK;

__device__ __forceinline__ void p0_wave_item(const Ctx& F, int it, LAS float* scr) {
    const int lane = F.lane, ln = lane & 31;
    int r = it;
    if (r < 2 * IT_W1) { const int f = r / IT_W1; r -= f * IT_W1; const int kb = r / 176, nb = r % 176, n0 = 32 * nb, pn = n0 >> 8, i = (n0 & 255) + ln;
        const int src = (i < 128) ? 128 * pn + i : FF + 128 * pn + (i - 128);
        tr_item(F.fwin + (size_t)f * DM * 2 * FF, 2 * FF, F.W1 + (size_t)f * 2 * FF * DM, DM, n0, src, 64 * kb, scr, lane); return; }
    r -= 2 * IT_W1;
    if (r < 2 * IT_W2) { const int f = r / IT_W2; r -= f * IT_W2; const int kb = r / 32, nb = r % 32;
        tr_item(F.fwout + (size_t)f * FF * DM, DM, F.W2 + (size_t)f * DM * FF, FF, 32 * nb, 32 * nb + ln, 64 * kb, scr, lane); return; }
    r -= 2 * IT_W2;
    if (r < IT_WIN) { const int kb = r / 72, nb = r % 72, n = 32 * nb + ln;
        const int src = (n < 1536) ? n : (n < 2048) ? n + 16 : (n < 2064) ? n - 512 : -1;
        tr_item(F.win, 2064, F.WIN, DM, 32 * nb, src, 64 * kb, scr, lane); return; }
    r -= IT_WIN;
    if (r < IT_WO) { const int kb = r / 32, nb = r % 32;
        tr_item(F.wout, DM, F.WOUT, DM, 32 * nb, 32 * nb + ln, 64 * kb, scr, lane); return; }
    r -= IT_WO;
    if (r < IT_WE) { const int kb = r / 32, nb = r % 32, g = kb >> 1, kk0 = 64 * (kb & 1), n0 = 32 * nb, hf = lane >> 5;
        const float* pw = F.poolw + (size_t)g * 128 * 128; const float* ps = F.pscale + g * 128; const float* wo = F.wout + (size_t)(512 + g * 128) * DM + n0 + ln;
        for (int i = 0; i < 32; ++i) { const int kk = kk0 + 2 * i + hf; float a = 0.f;
#pragma unroll 8
            for (int e = 0; e < 128; ++e) a += pw[kk * 128 + e] * ps[e] * wo[(size_t)e * DM];
            scr[(2 * i + hf) * 33 + ln] = a; }
        LDS_WAIT(); asm volatile("" ::: "memory");
        tr_store(scr, F.WOUT, DM, n0, 512 + 64 * kb, lane);
        LDS_WAIT(); asm volatile("" ::: "memory"); return; }
    r -= IT_WE;
    { const int which = r / (4 * IT_QK); r -= which * 4 * IT_QK; const int h = r / IT_QK; r -= h * IT_QK; const int kb = r / 4, nb = r % 4;
      const float* W = (which ? F.wk : F.wq) + (size_t)h * 128 * 128; bf16* WT = (which ? F.wkt : F.wqt) + (size_t)h * 128 * 128;
      tr_item(W, 128, WT, 128, 32 * nb, 32 * nb + ln, 64 * kb, scr, lane); }
}

__device__ __forceinline__ void p0_prologue(const Ctx& F) {
    LAS float* scl = (LAS float*)(F.lds + P0_SC_OFF); LAS float* red = (LAS float*)(F.lds + P0_RED_OFF);
    for (int j = F.bid; j < 144; j += F.G) {
        for (int i = F.tid; i < 3072; i += NTHREADS) { const int b = i >> 10, k = i & 1023; const float v = (b < 2) ? F.c[b * DM + k] : F.cctx[k]; scl[i] = v / (1.0f + expf(-v)); }
        __syncthreads();
        const int col = 64 * j + F.lane, k0 = 128 * F.wave; float a0 = 0.f, a1 = 0.f, a2 = 0.f;
#pragma unroll 16
        for (int kk = 0; kk < 128; ++kk) { const float wv = F.wmod[(size_t)(k0 + kk) * (NMOD * DM) + col]; a0 += scl[k0 + kk] * wv; a1 += scl[1024 + k0 + kk] * wv; a2 += scl[2048 + k0 + kk] * wv; }
        red[(F.wave * 3 + 0) * 64 + F.lane] = a0; red[(F.wave * 3 + 1) * 64 + F.lane] = a1; red[(F.wave * 3 + 2) * 64 + F.lane] = a2;
        __syncthreads();
        if (F.tid < 192) { const int b = F.tid >> 6, l = F.tid & 63; float s = 0.f;
#pragma unroll
            for (int w = 0; w < 8; ++w) s += red[(w * 3 + b) * 64 + l];
            F.mod[b * (NMOD * DM) + 64 * j + l] = s + F.bmod[64 * j + l]; }
        __syncthreads();
    }
    LAS float* scr = (LAS float*)(F.lds + F.wave * TP0_SCR);
    const int gw = F.bid * NWAVES + F.wave, NGW = F.G * NWAVES;
    for (int it = gw; it < IT_TOTAL; it += NGW) p0_wave_item(F, it, scr);
}

template <bool HAS_Z, bool WRITE_X, bool WRITE_Y>
__device__ __forceinline__ void row_phase(const Ctx& F, int nrows, const float* xlat, const float* xctx, float resw, int jsub) {
    const int gw = F.bid * NWAVES + F.wave, NGW = F.G * NWAVES, lane = F.lane;
    for (int r = gw; r < nrows; r += NGW) {
        const int mb = (r < ML) ? (r >> 14) : 2;
        const float* xr = (r < ML) ? xlat + (size_t)r * DM : xctx + (size_t)(r - ML) * DM;
        f32x4 v[4];
#pragma unroll
        for (int j = 0; j < 4; ++j) v[j] = *(const f32x4*)(xr + 4 * lane + 256 * j);
        if (HAS_Z) {
            const int js = jsub - 1; const bf16* zr = F.Z + (size_t)r * DM; f32x4 z[4]; float ss = 0.f;
#pragma unroll
            for (int j = 0; j < 4; ++j) { const u32x2 w = *(const u32x2*)(zr + 4 * lane + 256 * j); z[j] = (f32x4){bflo(w.x), bfhi(w.x), bflo(w.y), bfhi(w.y)};
                ss += (z[j].x * z[j].x + z[j].y * z[j].y) + (z[j].z * z[j].z + z[j].w * z[j].w); }
            const float rz = resw * rsqrtf(wave_sum(ss) * (1.0f / DM) + EPS);
            const float* gate = F.mod + (size_t)mb * (NMOD * DM) + (3 * js + 2) * DM; const float* gp = F.npost + js * DM;
#pragma unroll
            for (int j = 0; j < 4; ++j) { const f32x4 ga = *(const f32x4*)(gate + 4 * lane + 256 * j), gg = *(const f32x4*)(gp + 4 * lane + 256 * j); v[j] = v[j] + (z[j] * rz) * ga * gg; }
            if (WRITE_X && r < ML) {
#pragma unroll
                for (int j = 0; j < 4; ++j) *(f32x4*)(F.out + (size_t)r * DM + 4 * lane + 256 * j) = v[j];
            }
        }
        if (WRITE_Y) {
            float ss = 0.f;
#pragma unroll
            for (int j = 0; j < 4; ++j) ss += (v[j].x * v[j].x + v[j].y * v[j].y) + (v[j].z * v[j].z + v[j].w * v[j].w);
            const float rr = rsqrtf(wave_sum(ss) * (1.0f / DM) + EPS);
            const float* sh = F.mod + (size_t)mb * (NMOD * DM) + (3 * jsub) * DM; const float* sc = sh + DM; const float* gp = F.npre + jsub * DM;
            bf16* yr = F.Y + (size_t)r * DM;
#pragma unroll
            for (int j = 0; j < 4; ++j) { const f32x4 s4 = *(const f32x4*)(sh + 4 * lane + 256 * j), c4 = *(const f32x4*)(sc + 4 * lane + 256 * j), g4 = *(const f32x4*)(gp + 4 * lane + 256 * j);
                const f32x4 y = (v[j] * rr) * g4 * (c4 + 1.0f) + s4; u32x2 w; w.x = pk2(y.x, y.y); w.y = pk2(y.z, y.w); *(u32x2*)(yr + 4 * lane + 256 * j) = w; }
        }
    }
}

constexpr int TP = 272, TILE_B = 128 * TP;
__device__ __forceinline__ bf16x8 ldfrag(LAS unsigned char* tile, int row, int kk, int fq) { return *(const LAS bf16x8*)(tile + row * TP + (32 * kk + 8 * fq) * 2); }
__device__ __forceinline__ void st4(LAS unsigned char* tile, int row, int col, float a, float b, float c, float d) { u32x2 w; w.x = pk2(a, b); w.y = pk2(c, d); *(LAS u32x2*)(tile + row * TP + col * 2) = w; }
__device__ __forceinline__ bf16x8 ident_frag(int nt, int fr, int fq) { const int jj = 16 * (nt & 1) + fr - 8 * fq; bf16x8 f;
#pragma unroll
    for (int j = 0; j < 8; ++j) f[j] = (j == jj) ? (short)0x3F80 : (short)0;
    return f; }
__device__ __forceinline__ void make_vt(const bf16* vrow  , LAS unsigned char* VT, int w, int fr, int fq) {
#pragma unroll
    for (int nt = 0; nt < 8; ++nt) { const bf16x8 vf = *(const bf16x8*)(vrow + 32 * (nt >> 1) + 8 * fq);
        const f32x4 a = mfma16(vf, ident_frag(nt, fr, fq), (f32x4){0.f, 0.f, 0.f, 0.f});
        st4(VT, 16 * nt + fr, 16 * w + 4 * fq, a[0], a[1], a[2], a[3]); }
}

constexpr int M1_U = 0, M1_KW0 = TILE_B, M1_KW1 = 2 * TILE_B, M1_VT = 3 * TILE_B, M1_WGT = 4 * TILE_B;
__device__ __forceinline__ void m1_unit(const Ctx& F, int unit) {
    const int tid = F.tid, lane = F.lane, w = F.wave, fr = lane & 15, fq = lane >> 4;
    const int tb = unit % NTB, bh = unit / NTB, h = bh & 3, b = bh >> 2;
    const bool isctx = tb < 2;
    const int R0 = isctx ? ML + b * CTXL + tb * 128 : b * SEQ + (tb - 2) * 128, t0 = isctx ? tb * 128 : (tb - 2) * 128, L = isctx ? CTXL : SEQ;
    LAS unsigned char* U = F.lds + M1_U; LAS unsigned char* VT = F.lds + M1_VT; LAS float* wgt = (LAS float*)(F.lds + M1_WGT);
    for (int i = tid; i < 2048; i += NTHREADS) { const int tau = i >> 4, ch8 = (i & 15) * 8, ch = h * 128 + ch8;
        const bf16* p = F.P + (size_t)(R0 + tau) * 2048 + ch;
        const u32x4 cu = *(const u32x4*)p; u32x4 pv = (u32x4){0u, 0u, 0u, 0u}, nx = pv;
        if (t0 + tau > 0) pv = *(const u32x4*)(p - 2048);
        if (t0 + tau < L - 1) nx = *(const u32x4*)(p + 2048);
        float o[8];
#pragma unroll
        for (int e = 0; e < 8; ++e) { const unsigned wc_ = cu[e >> 1], wp = pv[e >> 1], wn = nx[e >> 1];
            const float xc = (e & 1) ? bfhi(wc_) : bflo(wc_), xp = (e & 1) ? bfhi(wp) : bflo(wp), xn = (e & 1) ? bfhi(wn) : bflo(wn);
            const float val = F.convb[ch + e] + xp * F.convw[ch + e] + xc * F.convw[MW + ch + e] + xn * F.convw[2 * MW + ch + e];
            o[e] = val / (1.0f + expf(-val)); }
        u32x4 ow; ow.x = pk2(o[0], o[1]); ow.y = pk2(o[2], o[3]); ow.z = pk2(o[4], o[5]); ow.w = pk2(o[6], o[7]);
        *(LAS u32x4*)(U + tau * TP + ch8 * 2) = ow; }
    if (w < 2) { const int dir = w, tau0 = dir ? 127 - 2 * lane : 2 * lane, tau1 = dir ? tau0 - 1 : tau0 + 1;
        const float* gr = F.gates + (size_t)R0 * 16 + dir * 4 + h;
        const float ip0 = gr[tau0 * 16], ip1 = gr[tau1 * 16], lf0 = log_sigmoid(gr[tau0 * 16 + 8]), lf1 = log_sigmoid(gr[tau1 * 16 + 8]);
        const float s = lf0 + lf1; float incl = s;
#pragma unroll
        for (int o = 1; o < 64; o <<= 1) { const float t = __shfl_up(incl, o); if (lane >= o) incl += t; }
        const float b0 = incl - s + lf0, b1 = incl, g = __shfl(incl, 63);
        const float a0 = g - b0 + ip0, a1 = g - b1 + ip1, ml = wave_max(fmaxf(a0, a1));
        wgt[dir * 128 + tau0] = expf(a0 - ml); wgt[dir * 128 + tau1] = expf(a1 - ml);
        if (lane == 0) { const int sidx = (bh * 2 + dir) * NTB + tb; F.mloc[sidx] = ml; F.gsum[sidx] = g; } }
    __syncthreads();
    { bf16x8 uf[4];
#pragma unroll
      for (int kk = 0; kk < 4; ++kk) uf[kk] = ldfrag(U, 16 * w + fr, kk, fq);
      const size_t grow = (size_t)(R0 + 16 * w + fr) * 512 + h * 128 + 4 * fq;
      { f32x4 acc[8];
#pragma unroll
        for (int mt = 0; mt < 8; ++mt) { acc[mt] = (f32x4){0.f, 0.f, 0.f, 0.f};
#pragma unroll
            for (int kk = 0; kk < 4; ++kk) { const bf16x8 wf = *(const bf16x8*)(F.wqt + (size_t)(h * 128 + 16 * mt + fr) * 128 + 32 * kk + 8 * fq); acc[mt] = mfma16(wf, uf[kk], acc[mt]); } }
#pragma unroll
        for (int mt = 0; mt < 8; ++mt) { u32x2 o; o.x = pk2(acc[mt][0], acc[mt][1]); o.y = pk2(acc[mt][2], acc[mt][3]); *(u32x2*)(F.Q + grow + 16 * mt) = o; } }
      { f32x4 acc[8], acc2[8]; const float ksc = 0.08838834764831845f;
#pragma unroll
        for (int mt = 0; mt < 8; ++mt) { acc[mt] = (f32x4){0.f, 0.f, 0.f, 0.f}; acc2[mt] = acc[mt];
#pragma unroll
            for (int kk = 0; kk < 4; ++kk) { const bf16x8 wf = *(const bf16x8*)(F.wkt + (size_t)(h * 128 + 16 * mt + fr) * 128 + 32 * kk + 8 * fq);
                acc[mt] = mfma16(wf, uf[kk], acc[mt]); acc2[mt] = mfma16(uf[kk], wf, acc2[mt]); } }
#pragma unroll
        for (int mt = 0; mt < 8; ++mt) { u32x2 o; o.x = pk2(acc[mt][0] * ksc, acc[mt][1] * ksc); o.y = pk2(acc[mt][2] * ksc, acc[mt][3] * ksc); *(u32x2*)(F.K + grow + 16 * mt) = o; }
#pragma unroll
        for (int dir = 0; dir < 2; ++dir) { LAS unsigned char* KW = F.lds + (dir ? M1_KW1 : M1_KW0); const f32x4 wv = *(const LAS f32x4*)(wgt + dir * 128 + 16 * w + 4 * fq);
#pragma unroll
            for (int mt = 0; mt < 8; ++mt) st4(KW, 16 * mt + fr, 16 * w + 4 * fq, acc2[mt][0] * ksc * wv[0], acc2[mt][1] * ksc * wv[1], acc2[mt][2] * ksc * wv[2], acc2[mt][3] * ksc * wv[3]); } }
      make_vt(F.P + (size_t)(R0 + 16 * w + fr) * 2048 + 512 + h * 128, VT, w, fr, fq);
    }
    __syncthreads();
    { bf16x8 vtf[4];
#pragma unroll
      for (int kk = 0; kk < 4; ++kk) vtf[kk] = ldfrag(VT, 16 * w + fr, kk, fq);
#pragma unroll
      for (int dir = 0; dir < 2; ++dir) { LAS unsigned char* KW = F.lds + (dir ? M1_KW1 : M1_KW0);
          float* cg_ = F.CKV + ((size_t)((bh * 2 + dir) * NTB + tb)) * 16384 + (size_t)(16 * w + fr) * 128 + 4 * fq;
#pragma unroll
          for (int mt = 0; mt < 8; ++mt) { f32x4 a = (f32x4){0.f, 0.f, 0.f, 0.f};
#pragma unroll
              for (int kk = 0; kk < 4; ++kk) a = mfma16(ldfrag(KW, 16 * mt + fr, kk, fq), vtf[kk], a);
              *(f32x4*)(cg_ + 16 * mt) = a; } } }
    if (tid < 256) { const int dir = tid >> 7, dk = tid & 127; LAS unsigned char* KW = F.lds + (dir ? M1_KW1 : M1_KW0) + dk * TP; float s = 0.f;
#pragma unroll
        for (int c = 0; c < 16; ++c) { const u32x4 q = *(const LAS u32x4*)(KW + 16 * c); s += (bflo(q.x) + bfhi(q.x)) + (bflo(q.y) + bfhi(q.y)) + (bflo(q.z) + bfhi(q.z)) + (bflo(q.w) + bfhi(q.w)); }
        F.cn[((size_t)((bh * 2 + dir) * NTB + tb)) * 128 + dk] = s; }
    __syncthreads();
}

__device__ __forceinline__ void pool_unit(const Ctx& F, int unit) {
    const int g = unit & 3, r = (unit >> 2) & 255, b = unit >> 10, tid = F.tid, pr = tid & 63, cgp = tid >> 6;
    const int win = 2 << g, lo = win >> 1, hi = win - 1 - lo;
    const int rlo = max(r - lo, 0), rhi = min(r + hi, GRID_ROWS - 1); const float cntr = (float)(rhi - rlo + 1);
    LAS f32x2v* vs = (LAS f32x2v*)F.lds;
    const bf16* base = F.P + (size_t)b * SEQ * 2048 + 1536 + g * 128 + 2 * pr;
#pragma unroll
    for (int cc = 0; cc < 8; ++cc) { const int c = 8 * cgp + cc; float s0 = 0.f, s1 = 0.f;
        for (int rr = rlo; rr <= rhi; ++rr) { const unsigned wv = *(const unsigned*)(base + (size_t)(rr * GW + c) * 2048); s0 += bflo(wv); s1 += bfhi(wv); }
        vs[c * 64 + pr] = (f32x2v){s0, s1}; }
    __syncthreads();
#pragma unroll
    for (int cc = 0; cc < 8; ++cc) { const int c = 8 * cgp + cc, clo = max(c - lo, 0), chi = min(c + hi, GW - 1); float s0 = 0.f, s1 = 0.f;
        for (int c2 = clo; c2 <= chi; ++c2) { const f32x2v t = vs[c2 * 64 + pr]; s0 += t.x; s1 += t.y; }
        const float inv = 1.0f / (cntr * (float)(chi - clo + 1));
        const unsigned uv = *(const unsigned*)(base + (size_t)(r * GW + c) * 2048);
        *(unsigned*)(F.MIX + (size_t)(b * SEQ + r * GW + c) * 1024 + 512 + g * 128 + 2 * pr) = pk2(s0 * inv - bflo(uv), s1 * inv - bfhi(uv)); }
    __syncthreads();
}

__device__ __forceinline__ void scan_phase(const Ctx& F) {
    const int nslots = 16 * 8192;
    for (int slot = F.bid * NTHREADS + F.tid; slot < nslots; slot += F.G * NTHREADS) {
        const int stream = slot >> 13, pe = slot & 8191, dir = stream & 1;
        float C0 = 0.f, C1 = 0.f, n0 = 0.f, n1 = 0.f, m = 0.f;
        const bool do_n = pe < 64;
        for (int c0 = 0; c0 < NTB; c0 += 10) {
            f32x2v ck[10]; float gg[10], mm[10]; f32x2v cnv[10];
#pragma unroll
            for (int i = 0; i < 10; ++i) { const int c = c0 + i, tb = dir ? (c < 2 ? 1 - c : 131 - c) : c; const size_t sidx = (size_t)stream * NTB + tb;
                ck[i] = *(const f32x2v*)(F.CKV + sidx * 16384 + 2 * pe); gg[i] = F.gsum[sidx]; mm[i] = F.mloc[sidx];
                cnv[i] = do_n ? *(const f32x2v*)(F.cn + sidx * 128 + 2 * pe) : (f32x2v){0.f, 0.f}; }
#pragma unroll
            for (int i = 0; i < 10; ++i) { const int c = c0 + i, tb = dir ? (c < 2 ? 1 - c : 131 - c) : c; const size_t sidx = (size_t)stream * NTB + tb;
                if (tb >= 2) { *(unsigned*)(F.CIN + ((size_t)stream * 128 + (tb - 2)) * 16384 + 2 * pe) = pk2(C0, C1);
                    if (do_n) *(f32x2v*)(F.nin + sidx * 128 + 2 * pe) = (f32x2v){n0, n1};
                    if (pe == 0) F.min_[sidx] = m; }
                const float mn = fmaxf(gg[i] + m, mm[i]), ao = expf(gg[i] + m - mn), an = expf(mm[i] - mn);
                C0 = ao * C0 + an * ck[i].x; C1 = ao * C1 + an * ck[i].y; n0 = ao * n0 + an * cnv[i].x; n1 = ao * n1 + an * cnv[i].y; m = mn; }
        }
    }
}

constexpr int M3_K = 0, M3_VT = TILE_B, M3_CT = 2 * TILE_B, M3_S = 3 * TILE_B, M3_MISC = 4 * TILE_B;
__device__ __forceinline__ void m3_unit(const Ctx& F, int unit) {
    const int tid = F.tid, lane = F.lane, w = F.wave, fr = lane & 15, fq = lane >> 4;
    const int j = unit & 127, bh = unit >> 7, h = bh & 3, b = bh >> 2, tb = j + 2;
    const int R0 = b * SEQ + j * 128;
    LAS unsigned char* Kt = F.lds + M3_K; LAS unsigned char* VT = F.lds + M3_VT; LAS unsigned char* CT = F.lds + M3_CT; LAS unsigned char* S = F.lds + M3_S;
    LAS float* rowterm = (LAS float*)(F.lds + M3_MISC); LAS float* colterm = rowterm + 256; LAS float* winter = rowterm + 512; LAS float* minv = rowterm + 768; LAS float* ninl = rowterm + 1024;
    for (int i = tid; i < 2048; i += NTHREADS) { const int tau = i >> 4, c8 = (i & 15) * 8; *(LAS u32x4*)(Kt + tau * TP + c8 * 2) = *(const u32x4*)(F.K + (size_t)(R0 + tau) * 512 + h * 128 + c8); }
    make_vt(F.P + (size_t)(R0 + 16 * w + fr) * 2048 + 512 + h * 128, VT, w, fr, fq);
    bf16x8 qf[4];
#pragma unroll
    for (int kk = 0; kk < 4; ++kk) qf[kk] = *(const bf16x8*)(F.Q + (size_t)(R0 + 16 * w + fr) * 512 + h * 128 + 32 * kk + 8 * fq);
    if (w < 2) { const int dir = w, tau0 = dir ? 127 - 2 * lane : 2 * lane, tau1 = dir ? tau0 - 1 : tau0 + 1;
        const float* gr = F.gates + (size_t)R0 * 16 + dir * 4 + h;
        const float ip0 = gr[tau0 * 16], ip1 = gr[tau1 * 16], lf0 = log_sigmoid(gr[tau0 * 16 + 8]), lf1 = log_sigmoid(gr[tau1 * 16 + 8]);
        const float s = lf0 + lf1; float incl = s;
#pragma unroll
        for (int o = 1; o < 64; o <<= 1) { const float t = __shfl_up(incl, o); if (lane >= o) incl += t; }
        const float b0 = incl - s + lf0, b1 = incl;
        const float ct0 = ip0 - b0, ct1 = ip1 - b1;
        float pm = fmaxf(ct0, ct1);
#pragma unroll
        for (int o = 1; o < 64; o <<= 1) { const float t = __shfl_up(pm, o); if (lane >= o) pm = fmaxf(pm, t); }
        float pmx = __shfl_up(pm, 1); if (lane == 0) pmx = -INFINITY;
        const float pm0 = fmaxf(pmx, ct0), pm1 = pm;
        const float min_ = F.min_[(size_t)(bh * 2 + dir) * NTB + tb];
        const float mt0 = fmaxf(b0 + pm0, b0 + min_), mt1 = fmaxf(b1 + pm1, b1 + min_);
        rowterm[dir * 128 + tau0] = b0 - mt0; rowterm[dir * 128 + tau1] = b1 - mt1; colterm[dir * 128 + tau0] = ct0; colterm[dir * 128 + tau1] = ct1;
        winter[dir * 128 + tau0] = expf(b0 + min_ - mt0); winter[dir * 128 + tau1] = expf(b1 + min_ - mt1); minv[dir * 128 + tau0] = expf(-mt0); minv[dir * 128 + tau1] = expf(-mt1); }
    f32x4 Hs[8];
#pragma unroll
    for (int mt = 0; mt < 8; ++mt) Hs[mt] = (f32x4){0.f, 0.f, 0.f, 0.f};
    const int t = 16 * w + fr;
#pragma unroll 1
    for (int dir = 0; dir < 2; ++dir) {
        const size_t sidx = (size_t)(bh * 2 + dir) * NTB + tb;
        { const bf16* cin = F.CIN + ((size_t)(bh * 2 + dir) * 128 + j) * 16384;
          for (int i = tid; i < 2048; i += NTHREADS) { const int dv = i >> 4, c8 = (i & 15) * 8; *(LAS u32x4*)(CT + dv * TP + c8 * 2) = *(const u32x4*)(cin + dv * 128 + c8); }
          if (tid < 128) ninl[tid] = F.nin[sidx * 128 + tid]; }
        __syncthreads();
        const float rt = rowterm[dir * 128 + t], wi = winter[dir * 128 + t], mi = minv[dir * 128 + t];
        float dsum = 0.f;
#pragma unroll
        for (int mt = 0; mt < 8; ++mt) { f32x4 a = (f32x4){0.f, 0.f, 0.f, 0.f};
#pragma unroll
            for (int kk = 0; kk < 4; ++kk) a = mfma16(ldfrag(Kt, 16 * mt + fr, kk, fq), qf[kk], a);
            const int s0 = 16 * mt + 4 * fq; const f32x4 ct = *(const LAS f32x4*)(colterm + dir * 128 + s0); float o[4];
#pragma unroll
            for (int e = 0; e < 4; ++e) { const int s = s0 + e; const bool ok = dir ? (s >= t) : (s <= t); o[e] = ok ? a[e] * expf(rt + ct[e]) : 0.f; dsum += o[e]; }
            st4(S, t, s0, o[0], o[1], o[2], o[3]); }
        dsum += __shfl_xor(dsum, 16); dsum += __shfl_xor(dsum, 32);
        float qn = 0.f;
#pragma unroll
        for (int kk = 0; kk < 4; ++kk)
#pragma unroll
            for (int e = 0; e < 8; ++e) qn += __uint_as_float(((unsigned)(unsigned short)qf[kk][e]) << 16) * ninl[32 * kk + 8 * fq + e];
        qn += __shfl_xor(qn, 16); qn += __shfl_xor(qn, 32);
        const float den = wi * qn + dsum, rden = 1.0f / fmaxf(fabsf(den), mi);
        LDS_WAIT(); asm volatile("" ::: "memory");
        bf16x8 sf[4];
#pragma unroll
        for (int kk = 0; kk < 4; ++kk) sf[kk] = ldfrag(S, t, kk, fq);
#pragma unroll
        for (int mt = 0; mt < 8; ++mt) { f32x4 a = (f32x4){0.f, 0.f, 0.f, 0.f}, c = a;
#pragma unroll
            for (int kk = 0; kk < 4; ++kk) { a = mfma16(ldfrag(VT, 16 * mt + fr, kk, fq), sf[kk], a); c = mfma16(ldfrag(CT, 16 * mt + fr, kk, fq), qf[kk], c); }
            Hs[mt] = Hs[mt] + (a + c * wi) * rden; }
        __syncthreads();
    }
    float ss = 0.f;
#pragma unroll
    for (int mt = 0; mt < 8; ++mt) ss += (Hs[mt][0] * Hs[mt][0] + Hs[mt][1] * Hs[mt][1]) + (Hs[mt][2] * Hs[mt][2] + Hs[mt][3] * Hs[mt][3]);
    ss += __shfl_xor(ss, 16); ss += __shfl_xor(ss, 32);
    const float rr = rsqrtf(ss * (1.0f / HD) + EPS);
    const bf16* orow = F.P + (size_t)(R0 + t) * 2048 + 1024 + h * 128 + 4 * fq; bf16* mrow = F.MIX + (size_t)(R0 + t) * 1024 + h * 128 + 4 * fq;
#pragma unroll
    for (int mt = 0; mt < 8; ++mt) { const u32x2 ow = *(const u32x2*)(orow + 16 * mt); const f32x4 hn = *(const f32x4*)(F.hnorm + h * 128 + 16 * mt + 4 * fq);
        const float o0 = bflo(ow.x), o1 = bfhi(ow.x), o2 = bflo(ow.y), o3 = bfhi(ow.y);
        u32x2 r; r.x = pk2(Hs[mt][0] * rr * hn[0] / (1.0f + expf(-o0)), Hs[mt][1] * rr * hn[1] / (1.0f + expf(-o1)));
        r.y = pk2(Hs[mt][2] * rr * hn[2] / (1.0f + expf(-o2)), Hs[mt][3] * rr * hn[3] / (1.0f + expf(-o3)));
        *(u32x2*)(mrow + 16 * mt) = r; }
}

constexpr int N_PHASES = 14;
__global__ void __launch_bounds__(NTHREADS, 2) fwd_kernel(Args args) {
    extern __shared__ __attribute__((aligned(16))) unsigned char lds_raw[];
    Ctx F;
    F.lds = (LAS unsigned char*)lds_raw;
    F.tid = threadIdx.x; F.lane = F.tid & 63; F.wave = __builtin_amdgcn_readfirstlane(F.tid >> 6); F.G = gridDim.x; F.bid = blockIdx.x;
    F.x = args.in[0]; F.c = args.in[1]; F.ctx = args.in[2]; F.cctx = args.in[3]; F.wmod = args.in[4]; F.bmod = args.in[5]; F.npre = args.in[6]; F.npost = args.in[7];
    F.fwin = args.in[8]; F.fwout = args.in[9]; F.win = args.in[10]; F.wout = args.in[11]; F.convw = args.in[12]; F.convb = args.in[13]; F.wq = args.in[14]; F.wk = args.in[15];
    F.ibias = args.in[16]; F.fbias = args.in[17]; F.hnorm = args.in[18]; F.poolw = args.in[19]; F.pscale = args.in[20];
    F.out = args.out; F.ws = args.ws; unsigned char* ws = args.ws;
    F.mod = (float*)(ws + WS_MOD); F.wqt = (bf16*)(ws + WS_WQT); F.wkt = (bf16*)(ws + WS_WKT); F.mloc = (float*)(ws + WS_MLOC); F.gsum = (float*)(ws + WS_G); F.min_ = (float*)(ws + WS_MIN);
    F.cn = (float*)(ws + WS_CN); F.nin = (float*)(ws + WS_NIN); F.gates = (float*)(ws + WS_GATES);
    F.W1 = (bf16*)(ws + WS_W1); F.W2 = (bf16*)(ws + WS_W2); F.WIN = (bf16*)(ws + WS_WIN); F.WOUT = (bf16*)(ws + WS_WOUT); F.Y = (bf16*)(ws + WS_Y); F.Z = (bf16*)(ws + WS_Z);
    F.H = (bf16*)(ws + WS_H); F.P = (bf16*)(ws + WS_P); F.Q = (bf16*)(ws + WS_Q); F.K = (bf16*)(ws + WS_K); F.CIN = (bf16*)(ws + WS_CIN); F.MIX = (bf16*)(ws + WS_MIX); F.CKV = (float*)(ws + WS_CKV);
    const int lo = args.ph_lo, hi = args.ph_hi;
    cg::grid_group grid = cg::this_grid();
#define IN(k) (lo <= (k) && (k) < hi)
#define SEAM(k) do { if (IN(k) && IN((k) + 1)) grid.sync(); } while (0)

    if (IN(0)) { p0_prologue(F); } SEAM(0);
    if (IN(1)) { row_phase<false, false, true>(F, MT, F.x, F.ctx, 0.f, 0); } SEAM(1);
    if (IN(2)) { pg8::Gemm g{F.Y, F.W1, MT, 2 * FF, DM}; pg8::StaticOrder S; S.init(MT, 2 * FF, F.G, F.bid); pg8::EpiSwiglu E{F.H, FF};
        pg8::gemm_phase<pg8::EpiSwiglu, pg8::StaticOrder, true, true>(F.lds, g, S, E); } SEAM(2);
    if (IN(3)) { pg8::Gemm g{F.H, F.W2, MT, DM, FF}; pg8::StaticOrder S; S.init(MT, DM, F.G, F.bid); pg8::EpiStore E{F.Z, DM};
        pg8::gemm_phase<pg8::EpiStore, pg8::StaticOrder, true, true>(F.lds, g, S, E); } SEAM(3);
    if (IN(4)) { row_phase<true, true, true>(F, MT, F.x, F.ctx, 0.5f, 1); } SEAM(4);
    if (IN(5)) { pg8::Gemm g{F.Y, F.WIN, MT, 2304, DM}; pg8::StaticOrder S; S.init(MT, 2304, F.G, F.bid); pg8::EpiInProj E{F.P, F.gates, F.ibias, F.fbias};
        pg8::gemm_phase<pg8::EpiInProj, pg8::StaticOrder, true, true>(F.lds, g, S, E); } SEAM(5);
    if (IN(6)) { for (int u = F.bid; u < NB * NH * NTB; u += F.G) m1_unit(F, u);
                 for (int u = F.bid; u < NB * GRID_ROWS * 4; u += F.G) pool_unit(F, u); } SEAM(6);
    if (IN(7)) { scan_phase(F); } SEAM(7);
    if (IN(8)) { for (int u = F.bid; u < NB * NH * 128; u += F.G) m3_unit(F, u); } SEAM(8);
    if (IN(9)) { pg8::Gemm g{F.MIX, F.WOUT, ML, DM, DM}; pg8::StaticOrder S; S.init(ML, DM, F.G, F.bid); pg8::EpiStore E{F.Z, DM};
        pg8::gemm_phase<pg8::EpiStore, pg8::StaticOrder, true, true>(F.lds, g, S, E); } SEAM(9);
    if (IN(10)) { row_phase<true, true, true>(F, ML, F.out, F.ctx, 1.0f, 2); } SEAM(10);
    if (IN(11)) { pg8::Gemm g{F.Y, F.W1 + (size_t)2 * FF * DM, ML, 2 * FF, DM}; pg8::StaticOrder S; S.init(ML, 2 * FF, F.G, F.bid); pg8::EpiSwiglu E{F.H, FF};
        pg8::gemm_phase<pg8::EpiSwiglu, pg8::StaticOrder, true, true>(F.lds, g, S, E); } SEAM(11);
    if (IN(12)) { pg8::Gemm g{F.H, F.W2 + (size_t)DM * FF, ML, DM, FF}; pg8::StaticOrder S; S.init(ML, DM, F.G, F.bid); pg8::EpiStore E{F.Z, DM};
        pg8::gemm_phase<pg8::EpiStore, pg8::StaticOrder, true, true>(F.lds, g, S, E); } SEAM(12);
    if (IN(13)) { row_phase<true, true, false>(F, ML, F.out, F.ctx, 0.5f, 3); }
#undef IN
#undef SEAM
}

#ifndef N_LAUNCHES
#define N_LAUNCHES 1
#endif
extern "C" void kernel_launch(void* const* d_in, const int* in_sizes, int n_in, void* d_out, int out_size, void* d_ws, size_t ws_size, hipStream_t stream) {
    static int grid = 0;
    if (grid == 0) {
        if (n_in != 21 || in_sizes[0] != ML * DM || out_size != ML * DM || ws_size < WS_END) { fprintf(stderr, "kernel_launch: unexpected shapes (n_in %d, in0 %d, out %d, ws %zu)\n", n_in, n_in > 0 ? in_sizes[0] : -1, out_size, ws_size); grid = -1; return; }
        int dev = 0, cus = 0, per_cu = 0;
        (void)hipGetDevice(&dev); (void)hipDeviceGetAttribute(&cus, hipDeviceAttributeMultiprocessorCount, dev);
        (void)hipFuncSetAttribute((const void*)fwd_kernel, hipFuncAttributeMaxDynamicSharedMemorySize, LDS_BYTES);
        (void)hipOccupancyMaxActiveBlocksPerMultiprocessor(&per_cu, (const void*)fwd_kernel, NTHREADS, LDS_BYTES);
        (void)hipGetLastError();
        if (per_cu < 1) { fprintf(stderr, "kernel_launch: occupancy query says %d blocks per CU\n", per_cu); grid = -1; return; }
        grid = cus;
    }
    if (grid < 0) return;
    Args a{};
    for (int i = 0; i < 21; ++i) a.in[i] = (const float*)d_in[i];
    a.out = (float*)d_out; a.ws = (unsigned char*)d_ws;
    if (N_LAUNCHES == 1) {
        a.ph_lo = 0; a.ph_hi = N_PHASES; void* kargs[] = {&a};
        hipError_t e = hipLaunchCooperativeKernel((const void*)fwd_kernel, dim3(grid), dim3(NTHREADS), kargs, LDS_BYTES, stream);
        if (e != hipSuccess) fprintf(stderr, "cooperative launch failed: %s (grid %d)\n", hipGetErrorString(e), grid);
    } else {
        for (int p = 0; p < N_PHASES; ++p) { a.ph_lo = p; a.ph_hi = p + 1; hipLaunchKernelGGL(fwd_kernel, dim3(grid), dim3(NTHREADS), LDS_BYTES, stream, a); }
    }
}
```

```cpp
#include <hip/hip_runtime.h>
#include <hip/hip_cooperative_groups.h>
#include <cstdio>
#include <cstdint>
namespace cg = cooperative_groups;
namespace pg8 {
#define PG8_LAS __attribute__((address_space(3)))
typedef unsigned short bf16_t;
typedef short bf16x8 __attribute__((ext_vector_type(8)));
typedef float f32x4 __attribute__((ext_vector_type(4)));
typedef unsigned u32x4 __attribute__((ext_vector_type(4)));
constexpr int BM = 256, BK = 64, HALF = 128, HTB = HALF * BK * 2  , STAGE_BYTES = 8 * HTB, NXCD = 8, WGM = 8;

__host__ __device__ __forceinline__ int lds_byte(int r, int c) { const int st = (r >> 4) * 2 + (c >> 5), rr = r & 15, cc = c & 31, ob = rr * 64 + cc * 2; return st * 1024 + (ob ^ (((ob >> 9) & 1) << 5)); }
__host__ __device__ __forceinline__ void stage_rc(int b, int& R, int& C) { const int st = b / 1024, sb = b % 1024, swz = sb ^ (((sb >> 9) & 1) << 5); R = (st >> 1) * 16 + swz / 64; C = (st & 1) * 32 + (swz % 64) / 2; }
__host__ __device__ __forceinline__ int perm32(int rho) { const int n = rho >> 4, i = rho & 15; return 8 * (i >> 2) + 4 * n + (i & 3); }

struct Unit { int pm, pn; };
struct Gemm { const bf16_t* A; const bf16_t* Bt; int M, N, K; };

struct StaticOrder {
    int nM, nN, nwg, G, c;
    __host__ __device__ void init(int M, int N, int G_, int c_) { nM = M / BM; nN = N / BM; nwg = nM * nN; G = G_; c = c_; }
    __host__ __device__ bool next(int i, Unit& u) const {
        const long L = (long)i * G + c; if (L >= nwg) return false;
        int wgid = (int)L; { const int q = nwg / NXCD, r = nwg % NXCD, xcd = wgid % NXCD, off = wgid / NXCD; wgid = (xcd < r ? xcd * (q + 1) : r * (q + 1) + (xcd - r) * q) + off; }
        const int nig = WGM * nN, gid = wgid / nig, fm = gid * WGM, gsz = (nM - fm) < WGM ? (nM - fm) : WGM;
        u.pm = fm + ((wgid % nig) % gsz); u.pn = (wgid % nig) / gsz; return true;
    }
    __device__ __forceinline__ void a_ready(const Unit&) const {}
    __device__ __forceinline__ void done(const Unit&) const {}
};
__device__ __forceinline__ unsigned cvt_pk_bf16(float lo, float hi) { unsigned r; asm volatile("v_cvt_pk_bf16_f32 %0, %1, %2" : "=v"(r) : "v"(lo), "v"(hi)); return r; }
typedef float f32x2 __attribute__((ext_vector_type(2)));
typedef unsigned u32x2 __attribute__((ext_vector_type(2)));
struct EpiStore {
    static constexpr bool PERM = true, AFTER_DRAIN = false;
    bf16_t* O; int ldc;
    __device__ __forceinline__ void operator()(const f32x4 (&acc)[2][2][4][2], const Unit& u, int wr, int wc, int fr, int fq) const {
        const int row0 = u.pm * BM + wr * 64 + fr, col0 = u.pn * BM + wc * 32 + 8 * fq;
#pragma unroll
        for (int ai = 0; ai < 2; ++ai)
#pragma unroll
            for (int m = 0; m < 4; ++m) { bf16_t* rowp = O + (size_t)(row0 + ai * HALF + m * 16) * ldc + col0;
#pragma unroll
                for (int bj = 0; bj < 2; ++bj) { const f32x4 v0 = acc[ai][bj][m][0], v1 = acc[ai][bj][m][1];
                    u32x4 w; w.x = cvt_pk_bf16(v0[0], v0[1]); w.y = cvt_pk_bf16(v0[2], v0[3]); w.z = cvt_pk_bf16(v1[0], v1[1]); w.w = cvt_pk_bf16(v1[2], v1[3]);
                    *(u32x4*)(rowp + bj * HALF) = w; } }
    }
};
__device__ __forceinline__ float silu_mul(float a, float b) { return a * b * __builtin_amdgcn_rcpf(1.0f + __builtin_amdgcn_exp2f(a * -1.4426950408889634f)); }
struct EpiSwiglu {
    static constexpr bool PERM = true, AFTER_DRAIN = false;
    bf16_t* O; int ldc;
    __device__ __forceinline__ void operator()(const f32x4 (&acc)[2][2][4][2], const Unit& u, int wr, int wc, int fr, int fq) const {
        const int row0 = u.pm * BM + wr * 64 + fr, col0 = u.pn * HALF + wc * 32 + 8 * fq;
#pragma unroll
        for (int ai = 0; ai < 2; ++ai)
#pragma unroll
            for (int m = 0; m < 4; ++m) { bf16_t* rowp = O + (size_t)(row0 + ai * HALF + m * 16) * ldc + col0;
                const f32x4 a0 = acc[ai][0][m][0], a1 = acc[ai][0][m][1], b0 = acc[ai][1][m][0], b1 = acc[ai][1][m][1];
                u32x4 w; w.x = cvt_pk_bf16(silu_mul(a0[0], b0[0]), silu_mul(a0[1], b0[1])); w.y = cvt_pk_bf16(silu_mul(a0[2], b0[2]), silu_mul(a0[3], b0[3]));
                w.z = cvt_pk_bf16(silu_mul(a1[0], b1[0]), silu_mul(a1[1], b1[1])); w.w = cvt_pk_bf16(silu_mul(a1[2], b1[2]), silu_mul(a1[3], b1[3]));
                *(u32x4*)rowp = w; }
    }
};
struct EpiInProj {
    static constexpr bool PERM = true, AFTER_DRAIN = false;
    bf16_t* P; float* gates; const float* ib; const float* fb;
    __device__ __forceinline__ void operator()(const f32x4 (&acc)[2][2][4][2], const Unit& u, int wr, int wc, int fr, int fq) const {
        const int row0 = u.pm * BM + wr * 64 + fr;
        if (u.pn < 8) {
            const int col0 = u.pn * BM + wc * 32 + 8 * fq;
#pragma unroll
            for (int ai = 0; ai < 2; ++ai)
#pragma unroll
                for (int m = 0; m < 4; ++m) { bf16_t* rowp = P + (size_t)(row0 + ai * HALF + m * 16) * 2048 + col0;
#pragma unroll
                    for (int bj = 0; bj < 2; ++bj) { const f32x4 v0 = acc[ai][bj][m][0], v1 = acc[ai][bj][m][1];
                        u32x4 w; w.x = cvt_pk_bf16(v0[0], v0[1]); w.y = cvt_pk_bf16(v0[2], v0[3]); w.z = cvt_pk_bf16(v1[0], v1[1]); w.w = cvt_pk_bf16(v1[2], v1[3]);
                        *(u32x4*)(rowp + bj * HALF) = w; } }
        } else if (wc == 0 && fq < 2) {
            const float* bp = (fq == 0) ? ib : fb;
            const f32x4 bv0 = *(const f32x4*)bp, bv1 = *(const f32x4*)(bp + 4);
#pragma unroll
            for (int ai = 0; ai < 2; ++ai)
#pragma unroll
                for (int m = 0; m < 4; ++m) { float* gp = gates + (size_t)(row0 + ai * HALF + m * 16) * 16 + 8 * fq;
                    *(f32x4*)gp = acc[ai][0][m][0] + bv0; *(f32x4*)(gp + 4) = acc[ai][0][m][1] + bv1; }
        }
    }
};
template <class Epi, class Sched, bool ALIGN_EPI = false, bool SP2 = false>
__device__ __forceinline__ void gemm_phase(PG8_LAS unsigned char* lds, const Gemm g, const Sched& S, const Epi& E) {
    const int tid = threadIdx.x, wid = __builtin_amdgcn_readfirstlane(tid >> 6), lane = tid & 63, wr = wid >> 2, wc = wid & 3, fr = lane & 15, fq = lane >> 4;
    const int K = g.K, nt = K / BK;
    unsigned voffA[2], voffB[2];
#pragma unroll
    for (int i = 0; i < 2; ++i) { int R, C; stage_rc(tid * 16 + i * 8192, R, C); const int Rb = Epi::PERM ? ((R & ~31) + perm32(R & 31)) : R;
        voffA[i] = (unsigned)(R * K + C) * 2u; voffB[i] = (unsigned)(Rb * K + C) * 2u; }
    const size_t kstep = (size_t)(BK * 2);
    const size_t hstep = (size_t)HALF * K * 2;
    const size_t tstep = 2 * hstep;
    const unsigned ldsw = (unsigned)wid * 1024u;
    const int aoff = lds_byte(wr * 64 + fr, fq * 8), boff = lds_byte(wc * 32 + fr, fq * 8);
#define PG8_SA(b, h) (((b) * 2 + (h)) * HTB)
#define PG8_SB(b, h) ((4 + (b) * 2 + (h)) * HTB)
#define PG8_STAGE(bufoff, gbase, voff) do { _Pragma("unroll") for (int _i = 0; _i < 2; ++_i) \
        __builtin_amdgcn_global_load_lds((const unsigned*)((const char*)(gbase) + (voff)[_i]), (PG8_LAS unsigned*)(lds + (bufoff) + ldsw + _i * 8192), 16, 0, 0); } while (0)
#define PG8_LDA(dst, b, h) do { _Pragma("unroll") for (int m = 0; m < 4; ++m) _Pragma("unroll") for (int k = 0; k < 2; ++k) dst[m][k] = *(const PG8_LAS bf16x8*)(lds + PG8_SA(b, h) + aoff + m * 2048 + k * 1024); } while (0)
#define PG8_LDB(dst, b, h) do { _Pragma("unroll") for (int n = 0; n < 2; ++n) _Pragma("unroll") for (int k = 0; k < 2; ++k) dst[n][k] = *(const PG8_LAS bf16x8*)(lds + PG8_SB(b, h) + boff + n * 2048 + k * 1024); } while (0)
#define PG8_MMA(ai, bj, At, Bt) do { __builtin_amdgcn_s_setprio(1); _Pragma("unroll") for (int m = 0; m < 4; ++m) _Pragma("unroll") for (int n = 0; n < 2; ++n) _Pragma("unroll") for (int k = 0; k < 2; ++k) \
        acc[ai][bj][m][n] = __builtin_amdgcn_mfma_f32_16x16x32_bf16(Bt[n][k], At[m][k], acc[ai][bj][m][n], 0, 0, 0); __builtin_amdgcn_s_setprio(0); } while (0)
#define PG8_WAIT_V(n) asm volatile("s_waitcnt vmcnt(" #n ")" ::: "memory")
#define PG8_WAIT_L(n) asm volatile("s_waitcnt lgkmcnt(" #n ")" ::: "memory")
#define PG8_BAR __builtin_amdgcn_s_barrier()
#define PG8_SCHED __builtin_amdgcn_sched_barrier(0)
    Unit cur, nxt; int ui = 0;
    if (!S.next(0, cur)) return;
    f32x4 acc[2][2][4][2];
#pragma unroll
    for (int a = 0; a < 2; ++a)
#pragma unroll
        for (int b = 0; b < 2; ++b)
#pragma unroll
            for (int m = 0; m < 4; ++m)
#pragma unroll
                for (int n = 0; n < 2; ++n) acc[a][b][m][n] = (f32x4){0.f, 0.f, 0.f, 0.f};
    bf16x8 At[4][2], B0[2][2], B1[2][2];
    const char* cA = (const char*)g.A + (size_t)cur.pm * tstep; const char* cB = (const char*)g.Bt + (size_t)cur.pn * tstep;
    S.a_ready(cur);
    if constexpr (SP2) {
        PG8_STAGE(PG8_SB(0, 0), cB, voffB); PG8_STAGE(PG8_SB(0, 1), cB + hstep, voffB); PG8_STAGE(PG8_SA(0, 0), cA, voffA); PG8_STAGE(PG8_SA(0, 1), cA + hstep, voffA);
        if (wr == 1) PG8_BAR;
        PG8_WAIT_V(2); PG8_BAR;
        PG8_STAGE(PG8_SB(1, 0), cB + kstep, voffB); PG8_STAGE(PG8_SA(1, 0), cA + kstep, voffA); PG8_STAGE(PG8_SB(1, 1), cB + hstep + kstep, voffB);
        PG8_WAIT_V(6); PG8_BAR;
    } else {
        PG8_STAGE(PG8_SB(0, 0), cB, voffB); PG8_STAGE(PG8_SA(0, 0), cA, voffA); PG8_STAGE(PG8_SB(0, 1), cB + hstep, voffB); PG8_STAGE(PG8_SA(0, 1), cA + hstep, voffA);
        if (wr == 1) PG8_BAR;
        PG8_WAIT_V(4); PG8_BAR;
        PG8_STAGE(PG8_SB(1, 0), cB + kstep, voffB); PG8_STAGE(PG8_SA(1, 0), cA + kstep, voffA); PG8_STAGE(PG8_SB(1, 1), cB + hstep + kstep, voffB);
        PG8_WAIT_V(6); PG8_BAR;
    }
    for (;;) {
        const bool has_next = S.next(ui + 1, nxt);
        const char* nA = has_next ? (const char*)g.A + (size_t)nxt.pm * tstep : cA; const char* nB = has_next ? (const char*)g.Bt + (size_t)nxt.pn * tstep : cB;
        for (int t = 0; t < nt; t += 2) {
            const bool last = (t == nt - 2);
            const char* a1 = cA + (size_t)(t + 1) * kstep;
            const char* a2 = last ? nA : cA + (size_t)(t + 2) * kstep; const char* b2 = last ? nB : cB + (size_t)(t + 2) * kstep;
            const char* a3 = a2 + kstep; const char* b3 = b2 + kstep;
            if (last && has_next) S.a_ready(nxt);
            if constexpr (SP2) {
            PG8_LDB(B0, 0, 0); PG8_LDB(B1, 0, 1); PG8_SCHED; PG8_LDA(At, 0, 0); PG8_STAGE(PG8_SA(1, 1), a1 + hstep, voffA);
            PG8_WAIT_V(8); PG8_WAIT_L(0); PG8_BAR; PG8_MMA(0, 0, At, B0); PG8_MMA(0, 1, At, B1); PG8_BAR; PG8_SCHED;
            PG8_LDA(At, 0, 1); PG8_STAGE(PG8_SB(0, 0), b2, voffB); PG8_STAGE(PG8_SB(0, 1), b2 + hstep, voffB); PG8_STAGE(PG8_SA(0, 0), a2, voffA);
            PG8_WAIT_V(8); PG8_WAIT_L(0); PG8_BAR; PG8_MMA(1, 0, At, B0); PG8_MMA(1, 1, At, B1); PG8_BAR; PG8_SCHED;
            PG8_LDB(B0, 1, 0); PG8_LDB(B1, 1, 1); PG8_SCHED; PG8_LDA(At, 1, 0); PG8_STAGE(PG8_SA(0, 1), a2 + hstep, voffA);
            PG8_WAIT_V(8); PG8_WAIT_L(0); PG8_BAR; PG8_MMA(0, 0, At, B0); PG8_MMA(0, 1, At, B1); PG8_BAR; PG8_SCHED;
            PG8_LDA(At, 1, 1); PG8_STAGE(PG8_SB(1, 0), b3, voffB); PG8_STAGE(PG8_SB(1, 1), b3 + hstep, voffB); PG8_STAGE(PG8_SA(1, 0), a3, voffA);
            PG8_WAIT_V(8); PG8_WAIT_L(0); PG8_BAR; PG8_MMA(1, 0, At, B0); PG8_MMA(1, 1, At, B1); PG8_BAR; PG8_SCHED;
            } else {
            PG8_LDB(B0, 0, 0); PG8_SCHED; PG8_LDA(At, 0, 0); PG8_STAGE(PG8_SA(1, 1), a1 + hstep, voffA);
            PG8_WAIT_L(8); PG8_BAR; PG8_WAIT_L(0); PG8_MMA(0, 0, At, B0); PG8_BAR; PG8_SCHED;
            PG8_LDB(B1, 0, 1); PG8_STAGE(PG8_SB(0, 0), b2, voffB);
            PG8_BAR; PG8_WAIT_L(0); PG8_MMA(0, 1, At, B1); PG8_BAR;
            PG8_LDA(At, 0, 1); PG8_STAGE(PG8_SA(0, 0), a2, voffA);
            PG8_BAR; PG8_WAIT_L(0); PG8_MMA(1, 0, At, B0); PG8_BAR; PG8_SCHED;
            PG8_STAGE(PG8_SB(0, 1), b2 + hstep, voffB);
            PG8_WAIT_V(6); PG8_BAR; PG8_MMA(1, 1, At, B1); PG8_BAR;
            PG8_LDB(B0, 1, 0); PG8_SCHED; PG8_LDA(At, 1, 0); PG8_STAGE(PG8_SA(0, 1), a2 + hstep, voffA);
            PG8_WAIT_L(8); PG8_BAR; PG8_WAIT_L(0); PG8_MMA(0, 0, At, B0); PG8_BAR; PG8_SCHED;
            PG8_LDB(B1, 1, 1); PG8_STAGE(PG8_SB(1, 0), b3, voffB);
            PG8_BAR; PG8_WAIT_L(0); PG8_MMA(0, 1, At, B1); PG8_BAR;
            PG8_LDA(At, 1, 1); PG8_STAGE(PG8_SA(1, 0), a3, voffA);
            PG8_BAR; PG8_WAIT_L(0); PG8_MMA(1, 0, At, B0); PG8_BAR; PG8_SCHED;
            PG8_STAGE(PG8_SB(1, 1), b3 + hstep, voffB);
            PG8_WAIT_V(6); PG8_BAR; PG8_MMA(1, 1, At, B1); PG8_BAR;
            }
        }
        if constexpr (ALIGN_EPI) { if (wr == 0) PG8_BAR; }
        if constexpr (!Epi::AFTER_DRAIN) { E(acc, cur, wr, wc, fr, fq); S.done(cur); }
        if (!has_next) break;
#pragma unroll
        for (int a = 0; a < 2; ++a)
#pragma unroll
            for (int b = 0; b < 2; ++b)
#pragma unroll
                for (int m = 0; m < 4; ++m)
#pragma unroll
                    for (int n = 0; n < 2; ++n) acc[a][b][m][n] = (f32x4){0.f, 0.f, 0.f, 0.f};
        cur = nxt; cA = nA; cB = nB; ++ui;
        if constexpr (ALIGN_EPI) { if (wr == 1) PG8_BAR; }
    }
    PG8_WAIT_V(0);
    if constexpr (!ALIGN_EPI) { if (wr == 0) PG8_BAR; }
    PG8_BAR;
    if constexpr (Epi::AFTER_DRAIN) { E.fused(acc, cur, wr, wc, fr, fq, lds, wid, lane); S.done(cur); }
#undef PG8_SA
#undef PG8_SB
#undef PG8_STAGE
#undef PG8_LDA
#undef PG8_LDB
#undef PG8_MMA
#undef PG8_WAIT_V
#undef PG8_WAIT_L
#undef PG8_BAR
#undef PG8_SCHED
}
}
constexpr int DM = 1024, SEQ = 16384, NB = 2, CTXL = 256, FF = 2816, NMOD = 9;
constexpr int ML = NB * SEQ, MC = NB * CTXL, MT = ML + MC;
constexpr int NH = 4, HD = 128, MW = 512, GW = 64, GRID_ROWS = SEQ / GW;
constexpr int NTB = 130;
constexpr float EPS = 1e-6f;
constexpr int NWAVES = 8, NTHREADS = 512;

constexpr size_t MiB = 1u << 20, KiB = 1024;
constexpr size_t WS_CTL = 0;
constexpr size_t WS_MOD = 1 * MiB;
constexpr size_t WS_WQT = 1 * MiB + 256 * KiB;
constexpr size_t WS_WKT = 1 * MiB + 512 * KiB;
constexpr size_t WS_MLOC = 1 * MiB + 768 * KiB;
constexpr size_t WS_G = WS_MLOC + 16 * KiB;
constexpr size_t WS_MIN = WS_G + 16 * KiB;
constexpr size_t WS_CN = 2 * MiB;
constexpr size_t WS_NIN = 3 * MiB + 256 * KiB;
constexpr size_t WS_GATES = 5 * MiB;
constexpr size_t WS_W1 = 8 * MiB;
constexpr size_t WS_W2 = 30 * MiB;
constexpr size_t WS_WIN = 41 * MiB;
constexpr size_t WS_WOUT = 46 * MiB;
constexpr size_t WS_Y = 48 * MiB;
constexpr size_t WS_Z = 113 * MiB;
constexpr size_t WS_CKV = 48 * MiB;
constexpr size_t WS_H = 178 * MiB;
constexpr size_t WS_P = 178 * MiB;
constexpr size_t WS_Q = 308 * MiB;
constexpr size_t WS_K = WS_Q + (size_t)MT * 512 * 2;
constexpr size_t WS_CIN = 373 * MiB;
constexpr size_t WS_MIX = 437 * MiB;
constexpr size_t WS_END = 501 * MiB;
static_assert(WS_K + (size_t)MT * 512 * 2 <= WS_CIN && WS_Z + (size_t)MT * 1024 * 2 <= WS_H && WS_CKV + (size_t)16 * 130 * 65536 <= WS_H && WS_P + (size_t)MT * 2048 * 2 <= WS_Q, "ws map");
static_assert(WS_GATES + (size_t)MT * 64 <= WS_W1 && WS_NIN + 16 * 130 * 512 <= WS_GATES && WS_CN + 16 * 130 * 512 <= WS_NIN, "ws map small");
constexpr size_t CTL_ZERO_BYTES = 64 * KiB;

constexpr int LDS_BYTES = 160 * 1024;

#define LAS __attribute__((address_space(3)))
typedef unsigned short bf16;
typedef short bf16x8 __attribute__((ext_vector_type(8)));
typedef float f32x4 __attribute__((ext_vector_type(4)));
typedef float f32x2v __attribute__((ext_vector_type(2)));
typedef unsigned u32x4 __attribute__((ext_vector_type(4)));
typedef unsigned u32x2 __attribute__((ext_vector_type(2)));
#define LDS_WAIT() asm volatile("s_waitcnt lgkmcnt(0)" ::: "memory")

__device__ __forceinline__ unsigned f2bf(float f) { unsigned u = __builtin_bit_cast(unsigned, f); return (u + 0x7fffu + ((u >> 16) & 1u)) >> 16; }
__device__ __forceinline__ unsigned pk2(float lo, float hi) { return f2bf(lo) | (f2bf(hi) << 16); }
__device__ __forceinline__ float bflo(unsigned w) { return __uint_as_float(w << 16); }
__device__ __forceinline__ float bfhi(unsigned w) { return __uint_as_float(w & 0xffff0000u); }
__device__ __forceinline__ float wave_sum(float v) {
#pragma unroll
    for (int o = 1; o < 64; o <<= 1) v += __shfl_xor(v, o);
    return v;
}
__device__ __forceinline__ float wave_max(float v) {
#pragma unroll
    for (int o = 1; o < 64; o <<= 1) v = fmaxf(v, __shfl_xor(v, o));
    return v;
}
__device__ __forceinline__ float log_sigmoid(float x) { return fminf(x, 0.f) - log1pf(expf(-fabsf(x))); }
__device__ __forceinline__ f32x4 mfma16(bf16x8 a, bf16x8 b, f32x4 c) { return __builtin_amdgcn_mfma_f32_16x16x32_bf16(a, b, c, 0, 0, 0); }

struct Args { const float* in[21]; float* out; unsigned char* ws; int ph_lo, ph_hi; };

struct Ctx {
    LAS unsigned char* lds;
    int tid, lane, wave, G, bid;
    const float *x, *c, *ctx, *cctx, *wmod, *bmod, *npre, *npost, *fwin, *fwout, *win, *wout, *convw, *convb, *wq, *wk, *ibias, *fbias, *hnorm, *poolw, *pscale;
    float* out; unsigned char* ws;
    float* mod; bf16 *wqt, *wkt; float *mloc, *gsum, *min_, *cn, *nin, *gates;
    bf16 *W1, *W2, *WIN, *WOUT, *Y, *Z, *H, *P, *Q, *K, *CIN, *MIX; float* CKV;
};

constexpr int TP0_SCR = 16384;
constexpr int P0_SC_OFF = 131072, P0_RED_OFF = 131072 + 12288;

__device__ __forceinline__ void tr_store(LAS float* scr, bf16* WT, int K, int n0, int k0, int lane) {
    const int c = lane & 7;
#pragma unroll
    for (int j = 0; j < 4; ++j) { const int n = (lane >> 3) + 8 * j; const LAS float* s = scr + (8 * c) * 33 + n;
        u32x4 o; o.x = pk2(s[0 * 33], s[1 * 33]); o.y = pk2(s[2 * 33], s[3 * 33]); o.z = pk2(s[4 * 33], s[5 * 33]); o.w = pk2(s[6 * 33], s[7 * 33]);
        *(u32x4*)(WT + (size_t)(n0 + n) * K + k0 + 8 * c) = o; }
}
__device__ __forceinline__ void tr_item(const float* W, int ldw, bf16* WT, int K, int n0, int srccol, int k0, LAS float* scr, int lane) {
#pragma unroll 8
    for (int i = 0; i < 32; ++i) { const int kk = 2 * i + (lane >> 5); scr[kk * 33 + (lane & 31)] = (srccol >= 0) ? W[(size_t)(k0 + kk) * ldw + srccol] : 0.f; }
    LDS_WAIT(); asm volatile("" ::: "memory");
    tr_store(scr, WT, K, n0, k0, lane);
    LDS_WAIT(); asm volatile("" ::: "memory");
}

constexpr int IT_W1 = 16 * 176, IT_W2 = 44 * 32, IT_WIN = 16 * 72, IT_WO = 8 * 32, IT_WE = 8 * 32, IT_QK = 8;
constexpr int IT_TOTAL = 2 * IT_W1 + 2 * IT_W2 + IT_WIN + IT_WO + IT_WE + 8 * IT_QK;

__device__ __forceinline__ void p0_wave_item(const Ctx& F, int it, LAS float* scr) {
    const int lane = F.lane, ln = lane & 31;
    int r = it;
    if (r < 2 * IT_W1) { const int f = r / IT_W1; r -= f * IT_W1; const int kb = r / 176, nb = r % 176, n0 = 32 * nb, pn = n0 >> 8, i = (n0 & 255) + ln;
        const int src = (i < 128) ? 128 * pn + i : FF + 128 * pn + (i - 128);
        tr_item(F.fwin + (size_t)f * DM * 2 * FF, 2 * FF, F.W1 + (size_t)f * 2 * FF * DM, DM, n0, src, 64 * kb, scr, lane); return; }
    r -= 2 * IT_W1;
    if (r < 2 * IT_W2) { const int f = r / IT_W2; r -= f * IT_W2; const int kb = r / 32, nb = r % 32;
        tr_item(F.fwout + (size_t)f * FF * DM, DM, F.W2 + (size_t)f * DM * FF, FF, 32 * nb, 32 * nb + ln, 64 * kb, scr, lane); return; }
    r -= 2 * IT_W2;
    if (r < IT_WIN) { const int kb = r / 72, nb = r % 72, n = 32 * nb + ln;
        const int src = (n < 1536) ? n : (n < 2048) ? n + 16 : (n < 2064) ? n - 512 : -1;
        tr_item(F.win, 2064, F.WIN, DM, 32 * nb, src, 64 * kb, scr, lane); return; }
    r -= IT_WIN;
    if (r < IT_WO) { const int kb = r / 32, nb = r % 32;
        tr_item(F.wout, DM, F.WOUT, DM, 32 * nb, 32 * nb + ln, 64 * kb, scr, lane); return; }
    r -= IT_WO;
    if (r < IT_WE) { const int kb = r / 32, nb = r % 32, g = kb >> 1, kk0 = 64 * (kb & 1), n0 = 32 * nb, hf = lane >> 5;
        const float* pw = F.poolw + (size_t)g * 128 * 128; const float* ps = F.pscale + g * 128; const float* wo = F.wout + (size_t)(512 + g * 128) * DM + n0 + ln;
        for (int i = 0; i < 32; ++i) { const int kk = kk0 + 2 * i + hf; float a = 0.f;
#pragma unroll 8
            for (int e = 0; e < 128; ++e) a += pw[kk * 128 + e] * ps[e] * wo[(size_t)e * DM];
            scr[(2 * i + hf) * 33 + ln] = a; }
        LDS_WAIT(); asm volatile("" ::: "memory");
        tr_store(scr, F.WOUT, DM, n0, 512 + 64 * kb, lane);
        LDS_WAIT(); asm volatile("" ::: "memory"); return; }
    r -= IT_WE;
    { const int which = r / (4 * IT_QK); r -= which * 4 * IT_QK; const int h = r / IT_QK; r -= h * IT_QK; const int kb = r / 4, nb = r % 4;
      const float* W = (which ? F.wk : F.wq) + (size_t)h * 128 * 128; bf16* WT = (which ? F.wkt : F.wqt) + (size_t)h * 128 * 128;
      tr_item(W, 128, WT, 128, 32 * nb, 32 * nb + ln, 64 * kb, scr, lane); }
}

__device__ __forceinline__ void p0_prologue(const Ctx& F) {
    LAS float* scl = (LAS float*)(F.lds + P0_SC_OFF); LAS float* red = (LAS float*)(F.lds + P0_RED_OFF);
    for (int j = F.bid; j < 144; j += F.G) {
        for (int i = F.tid; i < 3072; i += NTHREADS) { const int b = i >> 10, k = i & 1023; const float v = (b < 2) ? F.c[b * DM + k] : F.cctx[k]; scl[i] = v / (1.0f + expf(-v)); }
        __syncthreads();
        const int col = 64 * j + F.lane, k0 = 128 * F.wave; float a0 = 0.f, a1 = 0.f, a2 = 0.f;
#pragma unroll 16
        for (int kk = 0; kk < 128; ++kk) { const float wv = F.wmod[(size_t)(k0 + kk) * (NMOD * DM) + col]; a0 += scl[k0 + kk] * wv; a1 += scl[1024 + k0 + kk] * wv; a2 += scl[2048 + k0 + kk] * wv; }
        red[(F.wave * 3 + 0) * 64 + F.lane] = a0; red[(F.wave * 3 + 1) * 64 + F.lane] = a1; red[(F.wave * 3 + 2) * 64 + F.lane] = a2;
        __syncthreads();
        if (F.tid < 192) { const int b = F.tid >> 6, l = F.tid & 63; float s = 0.f;
#pragma unroll
            for (int w = 0; w < 8; ++w) s += red[(w * 3 + b) * 64 + l];
            F.mod[b * (NMOD * DM) + 64 * j + l] = s + F.bmod[64 * j + l]; }
        __syncthreads();
    }
    LAS float* scr = (LAS float*)(F.lds + F.wave * TP0_SCR);
    const int gw = F.bid * NWAVES + F.wave, NGW = F.G * NWAVES;
    for (int it = gw; it < IT_TOTAL; it += NGW) p0_wave_item(F, it, scr);
}

template <bool HAS_Z, bool WRITE_X, bool WRITE_Y>
__device__ __forceinline__ void row_phase(const Ctx& F, int nrows, const float* xlat, const float* xctx, float resw, int jsub) {
    const int gw = F.bid * NWAVES + F.wave, NGW = F.G * NWAVES, lane = F.lane;
    for (int r = gw; r < nrows; r += NGW) {
        const int mb = (r < ML) ? (r >> 14) : 2;
        const float* xr = (r < ML) ? xlat + (size_t)r * DM : xctx + (size_t)(r - ML) * DM;
        f32x4 v[4];
#pragma unroll
        for (int j = 0; j < 4; ++j) v[j] = *(const f32x4*)(xr + 4 * lane + 256 * j);
        if (HAS_Z) {
            const int js = jsub - 1; const bf16* zr = F.Z + (size_t)r * DM; f32x4 z[4]; float ss = 0.f;
#pragma unroll
            for (int j = 0; j < 4; ++j) { const u32x2 w = *(const u32x2*)(zr + 4 * lane + 256 * j); z[j] = (f32x4){bflo(w.x), bfhi(w.x), bflo(w.y), bfhi(w.y)};
                ss += (z[j].x * z[j].x + z[j].y * z[j].y) + (z[j].z * z[j].z + z[j].w * z[j].w); }
            const float rz = resw * rsqrtf(wave_sum(ss) * (1.0f / DM) + EPS);
            const float* gate = F.mod + (size_t)mb * (NMOD * DM) + (3 * js + 2) * DM; const float* gp = F.npost + js * DM;
#pragma unroll
            for (int j = 0; j < 4; ++j) { const f32x4 ga = *(const f32x4*)(gate + 4 * lane + 256 * j), gg = *(const f32x4*)(gp + 4 * lane + 256 * j); v[j] = v[j] + (z[j] * rz) * ga * gg; }
            if (WRITE_X && r < ML) {
#pragma unroll
                for (int j = 0; j < 4; ++j) *(f32x4*)(F.out + (size_t)r * DM + 4 * lane + 256 * j) = v[j];
            }
        }
        if (WRITE_Y) {
            float ss = 0.f;
#pragma unroll
            for (int j = 0; j < 4; ++j) ss += (v[j].x * v[j].x + v[j].y * v[j].y) + (v[j].z * v[j].z + v[j].w * v[j].w);
            const float rr = rsqrtf(wave_sum(ss) * (1.0f / DM) + EPS);
            const float* sh = F.mod + (size_t)mb * (NMOD * DM) + (3 * jsub) * DM; const float* sc = sh + DM; const float* gp = F.npre + jsub * DM;
            bf16* yr = F.Y + (size_t)r * DM;
#pragma unroll
            for (int j = 0; j < 4; ++j) { const f32x4 s4 = *(const f32x4*)(sh + 4 * lane + 256 * j), c4 = *(const f32x4*)(sc + 4 * lane + 256 * j), g4 = *(const f32x4*)(gp + 4 * lane + 256 * j);
                const f32x4 y = (v[j] * rr) * g4 * (c4 + 1.0f) + s4; u32x2 w; w.x = pk2(y.x, y.y); w.y = pk2(y.z, y.w); *(u32x2*)(yr + 4 * lane + 256 * j) = w; }
        }
    }
}

constexpr int TP = 272, TILE_B = 128 * TP;
__device__ __forceinline__ bf16x8 ldfrag(LAS unsigned char* tile, int row, int kk, int fq) { return *(const LAS bf16x8*)(tile + row * TP + (32 * kk + 8 * fq) * 2); }
__device__ __forceinline__ void st4(LAS unsigned char* tile, int row, int col, float a, float b, float c, float d) { u32x2 w; w.x = pk2(a, b); w.y = pk2(c, d); *(LAS u32x2*)(tile + row * TP + col * 2) = w; }
__device__ __forceinline__ bf16x8 ident_frag(int nt, int fr, int fq) { const int jj = 16 * (nt & 1) + fr - 8 * fq; bf16x8 f;
#pragma unroll
    for (int j = 0; j < 8; ++j) f[j] = (j == jj) ? (short)0x3F80 : (short)0;
    return f; }
__device__ __forceinline__ void make_vt(const bf16* vrow  , LAS unsigned char* VT, int w, int fr, int fq) {
#pragma unroll
    for (int nt = 0; nt < 8; ++nt) { const bf16x8 vf = *(const bf16x8*)(vrow + 32 * (nt >> 1) + 8 * fq);
        const f32x4 a = mfma16(vf, ident_frag(nt, fr, fq), (f32x4){0.f, 0.f, 0.f, 0.f});
        st4(VT, 16 * nt + fr, 16 * w + 4 * fq, a[0], a[1], a[2], a[3]); }
}

constexpr int M1_U = 0, M1_KW0 = TILE_B, M1_KW1 = 2 * TILE_B, M1_VT = 3 * TILE_B, M1_WGT = 4 * TILE_B;
__device__ __forceinline__ void m1_unit(const Ctx& F, int unit) {
    const int tid = F.tid, lane = F.lane, w = F.wave, fr = lane & 15, fq = lane >> 4;
    const int tb = unit % NTB, bh = unit / NTB, h = bh & 3, b = bh >> 2;
    const bool isctx = tb < 2;
    const int R0 = isctx ? ML + b * CTXL + tb * 128 : b * SEQ + (tb - 2) * 128, t0 = isctx ? tb * 128 : (tb - 2) * 128, L = isctx ? CTXL : SEQ;
    LAS unsigned char* U = F.lds + M1_U; LAS unsigned char* VT = F.lds + M1_VT; LAS float* wgt = (LAS float*)(F.lds + M1_WGT);
    for (int i = tid; i < 2048; i += NTHREADS) { const int tau = i >> 4, ch8 = (i & 15) * 8, ch = h * 128 + ch8;
        const bf16* p = F.P + (size_t)(R0 + tau) * 2048 + ch;
        const u32x4 cu = *(const u32x4*)p; u32x4 pv = (u32x4){0u, 0u, 0u, 0u}, nx = pv;
        if (t0 + tau > 0) pv = *(const u32x4*)(p - 2048);
        if (t0 + tau < L - 1) nx = *(const u32x4*)(p + 2048);
        float o[8];
#pragma unroll
        for (int e = 0; e < 8; ++e) { const unsigned wc_ = cu[e >> 1], wp = pv[e >> 1], wn = nx[e >> 1];
            const float xc = (e & 1) ? bfhi(wc_) : bflo(wc_), xp = (e & 1) ? bfhi(wp) : bflo(wp), xn = (e & 1) ? bfhi(wn) : bflo(wn);
            const float val = F.convb[ch + e] + xp * F.convw[ch + e] + xc * F.convw[MW + ch + e] + xn * F.convw[2 * MW + ch + e];
            o[e] = val / (1.0f + expf(-val)); }
        u32x4 ow; ow.x = pk2(o[0], o[1]); ow.y = pk2(o[2], o[3]); ow.z = pk2(o[4], o[5]); ow.w = pk2(o[6], o[7]);
        *(LAS u32x4*)(U + tau * TP + ch8 * 2) = ow; }
    if (w < 2) { const int dir = w, tau0 = dir ? 127 - 2 * lane : 2 * lane, tau1 = dir ? tau0 - 1 : tau0 + 1;
        const float* gr = F.gates + (size_t)R0 * 16 + dir * 4 + h;
        const float ip0 = gr[tau0 * 16], ip1 = gr[tau1 * 16], lf0 = log_sigmoid(gr[tau0 * 16 + 8]), lf1 = log_sigmoid(gr[tau1 * 16 + 8]);
        const float s = lf0 + lf1; float incl = s;
#pragma unroll
        for (int o = 1; o < 64; o <<= 1) { const float t = __shfl_up(incl, o); if (lane >= o) incl += t; }
        const float b0 = incl - s + lf0, b1 = incl, g = __shfl(incl, 63);
        const float a0 = g - b0 + ip0, a1 = g - b1 + ip1, ml = wave_max(fmaxf(a0, a1));
        wgt[dir * 128 + tau0] = expf(a0 - ml); wgt[dir * 128 + tau1] = expf(a1 - ml);
        if (lane == 0) { const int sidx = (bh * 2 + dir) * NTB + tb; F.mloc[sidx] = ml; F.gsum[sidx] = g; } }
    __syncthreads();
    { bf16x8 uf[4];
#pragma unroll
      for (int kk = 0; kk < 4; ++kk) uf[kk] = ldfrag(U, 16 * w + fr, kk, fq);
      const size_t grow = (size_t)(R0 + 16 * w + fr) * 512 + h * 128 + 4 * fq;
      { f32x4 acc[8];
#pragma unroll
        for (int mt = 0; mt < 8; ++mt) { acc[mt] = (f32x4){0.f, 0.f, 0.f, 0.f};
#pragma unroll
            for (int kk = 0; kk < 4; ++kk) { const bf16x8 wf = *(const bf16x8*)(F.wqt + (size_t)(h * 128 + 16 * mt + fr) * 128 + 32 * kk + 8 * fq); acc[mt] = mfma16(wf, uf[kk], acc[mt]); } }
#pragma unroll
        for (int mt = 0; mt < 8; ++mt) { u32x2 o; o.x = pk2(acc[mt][0], acc[mt][1]); o.y = pk2(acc[mt][2], acc[mt][3]); *(u32x2*)(F.Q + grow + 16 * mt) = o; } }
      { f32x4 acc[8], acc2[8]; const float ksc = 0.08838834764831845f;
#pragma unroll
        for (int mt = 0; mt < 8; ++mt) { acc[mt] = (f32x4){0.f, 0.f, 0.f, 0.f}; acc2[mt] = acc[mt];
#pragma unroll
            for (int kk = 0; kk < 4; ++kk) { const bf16x8 wf = *(const bf16x8*)(F.wkt + (size_t)(h * 128 + 16 * mt + fr) * 128 + 32 * kk + 8 * fq);
                acc[mt] = mfma16(wf, uf[kk], acc[mt]); acc2[mt] = mfma16(uf[kk], wf, acc2[mt]); } }
#pragma unroll
        for (int mt = 0; mt < 8; ++mt) { u32x2 o; o.x = pk2(acc[mt][0] * ksc, acc[mt][1] * ksc); o.y = pk2(acc[mt][2] * ksc, acc[mt][3] * ksc); *(u32x2*)(F.K + grow + 16 * mt) = o; }
#pragma unroll
        for (int dir = 0; dir < 2; ++dir) { LAS unsigned char* KW = F.lds + (dir ? M1_KW1 : M1_KW0); const f32x4 wv = *(const LAS f32x4*)(wgt + dir * 128 + 16 * w + 4 * fq);
#pragma unroll
            for (int mt = 0; mt < 8; ++mt) st4(KW, 16 * mt + fr, 16 * w + 4 * fq, acc2[mt][0] * ksc * wv[0], acc2[mt][1] * ksc * wv[1], acc2[mt][2] * ksc * wv[2], acc2[mt][3] * ksc * wv[3]); } }
      make_vt(F.P + (size_t)(R0 + 16 * w + fr) * 2048 + 512 + h * 128, VT, w, fr, fq);
    }
    __syncthreads();
    { bf16x8 vtf[4];
#pragma unroll
      for (int kk = 0; kk < 4; ++kk) vtf[kk] = ldfrag(VT, 16 * w + fr, kk, fq);
#pragma unroll
      for (int dir = 0; dir < 2; ++dir) { LAS unsigned char* KW = F.lds + (dir ? M1_KW1 : M1_KW0);
          float* cg_ = F.CKV + ((size_t)((bh * 2 + dir) * NTB + tb)) * 16384 + (size_t)(16 * w + fr) * 128 + 4 * fq;
#pragma unroll
          for (int mt = 0; mt < 8; ++mt) { f32x4 a = (f32x4){0.f, 0.f, 0.f, 0.f};
#pragma unroll
              for (int kk = 0; kk < 4; ++kk) a = mfma16(ldfrag(KW, 16 * mt + fr, kk, fq), vtf[kk], a);
              *(f32x4*)(cg_ + 16 * mt) = a; } } }
    if (tid < 256) { const int dir = tid >> 7, dk = tid & 127; LAS unsigned char* KW = F.lds + (dir ? M1_KW1 : M1_KW0) + dk * TP; float s = 0.f;
#pragma unroll
        for (int c = 0; c < 16; ++c) { const u32x4 q = *(const LAS u32x4*)(KW + 16 * c); s += (bflo(q.x) + bfhi(q.x)) + (bflo(q.y) + bfhi(q.y)) + (bflo(q.z) + bfhi(q.z)) + (bflo(q.w) + bfhi(q.w)); }
        F.cn[((size_t)((bh * 2 + dir) * NTB + tb)) * 128 + dk] = s; }
    __syncthreads();
}

__device__ __forceinline__ void pool_unit(const Ctx& F, int unit) {
    const int g = unit & 3, r = (unit >> 2) & 255, b = unit >> 10, tid = F.tid, pr = tid & 63, cgp = tid >> 6;
    const int win = 2 << g, lo = win >> 1, hi = win - 1 - lo;
    const int rlo = max(r - lo, 0), rhi = min(r + hi, GRID_ROWS - 1); const float cntr = (float)(rhi - rlo + 1);
    LAS f32x2v* vs = (LAS f32x2v*)F.lds;
    const bf16* base = F.P + (size_t)b * SEQ * 2048 + 1536 + g * 128 + 2 * pr;
#pragma unroll
    for (int cc = 0; cc < 8; ++cc) { const int c = 8 * cgp + cc; float s0 = 0.f, s1 = 0.f;
        for (int rr = rlo; rr <= rhi; ++rr) { const unsigned wv = *(const unsigned*)(base + (size_t)(rr * GW + c) * 2048); s0 += bflo(wv); s1 += bfhi(wv); }
        vs[c * 64 + pr] = (f32x2v){s0, s1}; }
    __syncthreads();
#pragma unroll
    for (int cc = 0; cc < 8; ++cc) { const int c = 8 * cgp + cc, clo = max(c - lo, 0), chi = min(c + hi, GW - 1); float s0 = 0.f, s1 = 0.f;
        for (int c2 = clo; c2 <= chi; ++c2) { const f32x2v t = vs[c2 * 64 + pr]; s0 += t.x; s1 += t.y; }
        const float inv = 1.0f / (cntr * (float)(chi - clo + 1));
        const unsigned uv = *(const unsigned*)(base + (size_t)(r * GW + c) * 2048);
        *(unsigned*)(F.MIX + (size_t)(b * SEQ + r * GW + c) * 1024 + 512 + g * 128 + 2 * pr) = pk2(s0 * inv - bflo(uv), s1 * inv - bfhi(uv)); }
    __syncthreads();
}

__device__ __forceinline__ void scan_phase(const Ctx& F) {
    const int nslots = 16 * 8192;
    for (int slot = F.bid * NTHREADS + F.tid; slot < nslots; slot += F.G * NTHREADS) {
        const int stream = slot >> 13, pe = slot & 8191, dir = stream & 1;
        float C0 = 0.f, C1 = 0.f, n0 = 0.f, n1 = 0.f, m = 0.f;
        const bool do_n = pe < 64;
        for (int c0 = 0; c0 < NTB; c0 += 10) {
            f32x2v ck[10]; float gg[10], mm[10]; f32x2v cnv[10];
#pragma unroll
            for (int i = 0; i < 10; ++i) { const int c = c0 + i, tb = dir ? (c < 2 ? 1 - c : 131 - c) : c; const size_t sidx = (size_t)stream * NTB + tb;
                ck[i] = *(const f32x2v*)(F.CKV + sidx * 16384 + 2 * pe); gg[i] = F.gsum[sidx]; mm[i] = F.mloc[sidx];
                cnv[i] = do_n ? *(const f32x2v*)(F.cn + sidx * 128 + 2 * pe) : (f32x2v){0.f, 0.f}; }
#pragma unroll
            for (int i = 0; i < 10; ++i) { const int c = c0 + i, tb = dir ? (c < 2 ? 1 - c : 131 - c) : c; const size_t sidx = (size_t)stream * NTB + tb;
                if (tb >= 2) { *(unsigned*)(F.CIN + ((size_t)stream * 128 + (tb - 2)) * 16384 + 2 * pe) = pk2(C0, C1);
                    if (do_n) *(f32x2v*)(F.nin + sidx * 128 + 2 * pe) = (f32x2v){n0, n1};
                    if (pe == 0) F.min_[sidx] = m; }
                const float mn = fmaxf(gg[i] + m, mm[i]), ao = expf(gg[i] + m - mn), an = expf(mm[i] - mn);
                C0 = ao * C0 + an * ck[i].x; C1 = ao * C1 + an * ck[i].y; n0 = ao * n0 + an * cnv[i].x; n1 = ao * n1 + an * cnv[i].y; m = mn; }
        }
    }
}

constexpr int M3_K = 0, M3_VT = TILE_B, M3_CT = 2 * TILE_B, M3_S = 3 * TILE_B, M3_MISC = 4 * TILE_B;
__device__ __forceinline__ void m3_unit(const Ctx& F, int unit) {
    const int tid = F.tid, lane = F.lane, w = F.wave, fr = lane & 15, fq = lane >> 4;
    const int j = unit & 127, bh = unit >> 7, h = bh & 3, b = bh >> 2, tb = j + 2;
    const int R0 = b * SEQ + j * 128;
    LAS unsigned char* Kt = F.lds + M3_K; LAS unsigned char* VT = F.lds + M3_VT; LAS unsigned char* CT = F.lds + M3_CT; LAS unsigned char* S = F.lds + M3_S;
    LAS float* rowterm = (LAS float*)(F.lds + M3_MISC); LAS float* colterm = rowterm + 256; LAS float* winter = rowterm + 512; LAS float* minv = rowterm + 768; LAS float* ninl = rowterm + 1024;
    for (int i = tid; i < 2048; i += NTHREADS) { const int tau = i >> 4, c8 = (i & 15) * 8; *(LAS u32x4*)(Kt + tau * TP + c8 * 2) = *(const u32x4*)(F.K + (size_t)(R0 + tau) * 512 + h * 128 + c8); }
    make_vt(F.P + (size_t)(R0 + 16 * w + fr) * 2048 + 512 + h * 128, VT, w, fr, fq);
    bf16x8 qf[4];
#pragma unroll
    for (int kk = 0; kk < 4; ++kk) qf[kk] = *(const bf16x8*)(F.Q + (size_t)(R0 + 16 * w + fr) * 512 + h * 128 + 32 * kk + 8 * fq);
    if (w < 2) { const int dir = w, tau0 = dir ? 127 - 2 * lane : 2 * lane, tau1 = dir ? tau0 - 1 : tau0 + 1;
        const float* gr = F.gates + (size_t)R0 * 16 + dir * 4 + h;
        const float ip0 = gr[tau0 * 16], ip1 = gr[tau1 * 16], lf0 = log_sigmoid(gr[tau0 * 16 + 8]), lf1 = log_sigmoid(gr[tau1 * 16 + 8]);
        const float s = lf0 + lf1; float incl = s;
#pragma unroll
        for (int o = 1; o < 64; o <<= 1) { const float t = __shfl_up(incl, o); if (lane >= o) incl += t; }
        const float b0 = incl - s + lf0, b1 = incl;
        const float ct0 = ip0 - b0, ct1 = ip1 - b1;
        float pm = fmaxf(ct0, ct1);
#pragma unroll
        for (int o = 1; o < 64; o <<= 1) { const float t = __shfl_up(pm, o); if (lane >= o) pm = fmaxf(pm, t); }
        float pmx = __shfl_up(pm, 1); if (lane == 0) pmx = -INFINITY;
        const float pm0 = fmaxf(pmx, ct0), pm1 = pm;
        const float min_ = F.min_[(size_t)(bh * 2 + dir) * NTB + tb];
        const float mt0 = fmaxf(b0 + pm0, b0 + min_), mt1 = fmaxf(b1 + pm1, b1 + min_);
        rowterm[dir * 128 + tau0] = b0 - mt0; rowterm[dir * 128 + tau1] = b1 - mt1; colterm[dir * 128 + tau0] = ct0; colterm[dir * 128 + tau1] = ct1;
        winter[dir * 128 + tau0] = expf(b0 + min_ - mt0); winter[dir * 128 + tau1] = expf(b1 + min_ - mt1); minv[dir * 128 + tau0] = expf(-mt0); minv[dir * 128 + tau1] = expf(-mt1); }
    f32x4 Hs[8];
#pragma unroll
    for (int mt = 0; mt < 8; ++mt) Hs[mt] = (f32x4){0.f, 0.f, 0.f, 0.f};
    const int t = 16 * w + fr;
#pragma unroll 1
    for (int dir = 0; dir < 2; ++dir) {
        const size_t sidx = (size_t)(bh * 2 + dir) * NTB + tb;
        { const bf16* cin = F.CIN + ((size_t)(bh * 2 + dir) * 128 + j) * 16384;
          for (int i = tid; i < 2048; i += NTHREADS) { const int dv = i >> 4, c8 = (i & 15) * 8; *(LAS u32x4*)(CT + dv * TP + c8 * 2) = *(const u32x4*)(cin + dv * 128 + c8); }
          if (tid < 128) ninl[tid] = F.nin[sidx * 128 + tid]; }
        __syncthreads();
        const float rt = rowterm[dir * 128 + t], wi = winter[dir * 128 + t], mi = minv[dir * 128 + t];
        float dsum = 0.f;
#pragma unroll
        for (int mt = 0; mt < 8; ++mt) { f32x4 a = (f32x4){0.f, 0.f, 0.f, 0.f};
#pragma unroll
            for (int kk = 0; kk < 4; ++kk) a = mfma16(ldfrag(Kt, 16 * mt + fr, kk, fq), qf[kk], a);
            const int s0 = 16 * mt + 4 * fq; const f32x4 ct = *(const LAS f32x4*)(colterm + dir * 128 + s0); float o[4];
#pragma unroll
            for (int e = 0; e < 4; ++e) { const int s = s0 + e; const bool ok = dir ? (s >= t) : (s <= t); o[e] = ok ? a[e] * expf(rt + ct[e]) : 0.f; dsum += o[e]; }
            st4(S, t, s0, o[0], o[1], o[2], o[3]); }
        dsum += __shfl_xor(dsum, 16); dsum += __shfl_xor(dsum, 32);
        float qn = 0.f;
#pragma unroll
        for (int kk = 0; kk < 4; ++kk)
#pragma unroll
            for (int e = 0; e < 8; ++e) qn += __uint_as_float(((unsigned)(unsigned short)qf[kk][e]) << 16) * ninl[32 * kk + 8 * fq + e];
        qn += __shfl_xor(qn, 16); qn += __shfl_xor(qn, 32);
        const float den = wi * qn + dsum, rden = 1.0f / fmaxf(fabsf(den), mi);
        LDS_WAIT(); asm volatile("" ::: "memory");
        bf16x8 sf[4];
#pragma unroll
        for (int kk = 0; kk < 4; ++kk) sf[kk] = ldfrag(S, t, kk, fq);
#pragma unroll
        for (int mt = 0; mt < 8; ++mt) { f32x4 a = (f32x4){0.f, 0.f, 0.f, 0.f}, c = a;
#pragma unroll
            for (int kk = 0; kk < 4; ++kk) { a = mfma16(ldfrag(VT, 16 * mt + fr, kk, fq), sf[kk], a); c = mfma16(ldfrag(CT, 16 * mt + fr, kk, fq), qf[kk], c); }
            Hs[mt] = Hs[mt] + (a + c * wi) * rden; }
        __syncthreads();
    }
    float ss = 0.f;
#pragma unroll
    for (int mt = 0; mt < 8; ++mt) ss += (Hs[mt][0] * Hs[mt][0] + Hs[mt][1] * Hs[mt][1]) + (Hs[mt][2] * Hs[mt][2] + Hs[mt][3] * Hs[mt][3]);
    ss += __shfl_xor(ss, 16); ss += __shfl_xor(ss, 32);
    const float rr = rsqrtf(ss * (1.0f / HD) + EPS);
    const bf16* orow = F.P + (size_t)(R0 + t) * 2048 + 1024 + h * 128 + 4 * fq; bf16* mrow = F.MIX + (size_t)(R0 + t) * 1024 + h * 128 + 4 * fq;
#pragma unroll
    for (int mt = 0; mt < 8; ++mt) { const u32x2 ow = *(const u32x2*)(orow + 16 * mt); const f32x4 hn = *(const f32x4*)(F.hnorm + h * 128 + 16 * mt + 4 * fq);
        const float o0 = bflo(ow.x), o1 = bfhi(ow.x), o2 = bflo(ow.y), o3 = bfhi(ow.y);
        u32x2 r; r.x = pk2(Hs[mt][0] * rr * hn[0] / (1.0f + expf(-o0)), Hs[mt][1] * rr * hn[1] / (1.0f + expf(-o1)));
        r.y = pk2(Hs[mt][2] * rr * hn[2] / (1.0f + expf(-o2)), Hs[mt][3] * rr * hn[3] / (1.0f + expf(-o3)));
        *(u32x2*)(mrow + 16 * mt) = r; }
}

#define XB_TMO      128
#define XB_XCNT(j)  (256  + 64 * (j))
#define XB_XSUB(j)  (1280 + 64 * (j))
#define XB_XGEN(j)  (2304 + 64 * (j))
#define XB_TOP      3328
#define XB_TOPGEN   3392
#define XCD_BAR_WORDS 3456
#define XB_SPIN_CAP (1u << 18)

__device__ __forceinline__ unsigned xb_ld(unsigned* p)              { return __hip_atomic_load(p, __ATOMIC_RELAXED, __HIP_MEMORY_SCOPE_AGENT); }
__device__ __forceinline__ unsigned xb_add(unsigned* p, unsigned v) { return __hip_atomic_fetch_add(p, v, __ATOMIC_RELAXED, __HIP_MEMORY_SCOPE_AGENT); }
__device__ __forceinline__ unsigned xb_xcc_id() { return (unsigned)__builtin_amdgcn_s_getreg((3 << 11) | 20) & 0xFu; }
#define XB_SPIN(cond, bar) do { unsigned _sp = 0; while (cond) { __builtin_amdgcn_s_sleep(1); \
    if ((++_sp & 255u) == 0u) { if (xb_ld(&(bar)[XB_TMO])) break; if (_sp > XB_SPIN_CAP) { atomicAdd(&(bar)[XB_TMO], 1u); break; } } } } while (0)

struct XcdBarrier {
    unsigned* bar; unsigned x;
    volatile LAS unsigned* st;
};

__device__ __forceinline__ XcdBarrier xcd_barrier_post(unsigned* bar, volatile LAS unsigned* st) {
    XcdBarrier b; b.bar = bar; b.x = xb_xcc_id(); b.st = st;
    if (threadIdx.x == 0) (void)xb_add(&bar[XB_XCNT(b.x)], 1u);
    return b;
}
__device__ __forceinline__ void xcd_barrier_complete(unsigned* bar, unsigned x, unsigned& nloc, unsigned& nx) {
    const unsigned G = gridDim.x * gridDim.y * gridDim.z;
    unsigned sum, cnt, mine, sp = 0u;
    for (;;) {
        sum = 0u; cnt = 0u; mine = 0u;
#pragma unroll
        for (unsigned j = 0; j < 16; ++j) { const unsigned c = xb_ld(&bar[XB_XCNT(j)]); sum += c; cnt += (c > 0u) ? 1u : 0u; mine = (j == x) ? c : mine; }
        if (sum == G) break;
        __builtin_amdgcn_s_sleep(1);
        if ((++sp & 255u) == 0u) { if (xb_ld(&bar[XB_TMO])) break; if (sp > XB_SPIN_CAP) { atomicAdd(&bar[XB_TMO], 1u); break; } }
    }
    nloc = mine > 0u ? mine : 1u; nx = cnt > 0u ? cnt : 1u;
}

__device__ __forceinline__ void xcd_barrier(const XcdBarrier& b) {
    asm volatile("s_waitcnt vmcnt(0)" ::: "memory");
    __syncthreads();
    if (threadIdx.x == 0) {
        unsigned* bar = b.bar;
        __builtin_amdgcn_s_waitcnt(0);
        unsigned nloc = b.st[0], nx = b.st[1];
        if (nloc == 0u) { xcd_barrier_complete(bar, b.x, nloc, nx); b.st[0] = nloc; b.st[1] = nx; }
        const unsigned old = xb_add(&bar[XB_XSUB(b.x)], 1u);
        const unsigned gen = old / nloc;
        if (old + 1u == (gen + 1u) * nloc) {
            __builtin_amdgcn_fence(__ATOMIC_RELEASE, "agent");
            asm volatile("s_waitcnt vmcnt(0)" ::: "memory");
            const unsigned og = xb_add(&bar[XB_TOP], 1u);
            const unsigned tg = og / nx;
            if (og + 1u == (tg + 1u) * nx) xb_add(&bar[XB_TOPGEN], 1u);
            else XB_SPIN(xb_ld(&bar[XB_TOPGEN]) == tg, bar);
            __builtin_amdgcn_fence(__ATOMIC_ACQUIRE, "agent");
            xb_add(&bar[XB_XGEN(b.x)], 1u);
            asm volatile("s_waitcnt vmcnt(0)" ::: "memory");
        } else {
            XB_SPIN(xb_ld(&bar[XB_XGEN(b.x)]) == gen, bar);
            __builtin_amdgcn_fence(__ATOMIC_ACQUIRE, "agent");
            asm volatile("s_waitcnt vmcnt(0)" ::: "memory");
        }
    }
    __syncthreads();
}

constexpr int N_PHASES = 14;
__global__ void __launch_bounds__(NTHREADS, 2) fwd_kernel(Args args) {
    extern __shared__ __attribute__((aligned(16))) unsigned char lds_raw[];
    Ctx F;
    F.lds = (LAS unsigned char*)lds_raw;
    F.tid = threadIdx.x; F.lane = F.tid & 63; F.wave = __builtin_amdgcn_readfirstlane(F.tid >> 6); F.G = gridDim.x; F.bid = blockIdx.x;
    F.x = args.in[0]; F.c = args.in[1]; F.ctx = args.in[2]; F.cctx = args.in[3]; F.wmod = args.in[4]; F.bmod = args.in[5]; F.npre = args.in[6]; F.npost = args.in[7];
    F.fwin = args.in[8]; F.fwout = args.in[9]; F.win = args.in[10]; F.wout = args.in[11]; F.convw = args.in[12]; F.convb = args.in[13]; F.wq = args.in[14]; F.wk = args.in[15];
    F.ibias = args.in[16]; F.fbias = args.in[17]; F.hnorm = args.in[18]; F.poolw = args.in[19]; F.pscale = args.in[20];
    F.out = args.out; F.ws = args.ws; unsigned char* ws = args.ws;
    F.mod = (float*)(ws + WS_MOD); F.wqt = (bf16*)(ws + WS_WQT); F.wkt = (bf16*)(ws + WS_WKT); F.mloc = (float*)(ws + WS_MLOC); F.gsum = (float*)(ws + WS_G); F.min_ = (float*)(ws + WS_MIN);
    F.cn = (float*)(ws + WS_CN); F.nin = (float*)(ws + WS_NIN); F.gates = (float*)(ws + WS_GATES);
    F.W1 = (bf16*)(ws + WS_W1); F.W2 = (bf16*)(ws + WS_W2); F.WIN = (bf16*)(ws + WS_WIN); F.WOUT = (bf16*)(ws + WS_WOUT); F.Y = (bf16*)(ws + WS_Y); F.Z = (bf16*)(ws + WS_Z);
    F.H = (bf16*)(ws + WS_H); F.P = (bf16*)(ws + WS_P); F.Q = (bf16*)(ws + WS_Q); F.K = (bf16*)(ws + WS_K); F.CIN = (bf16*)(ws + WS_CIN); F.MIX = (bf16*)(ws + WS_MIX); F.CKV = (float*)(ws + WS_CKV);
    const int lo = args.ph_lo, hi = args.ph_hi;
    cg::grid_group grid = cg::this_grid();
    volatile LAS unsigned* bst = (volatile LAS unsigned*)(F.lds + LDS_BYTES - 64);
    if (F.tid < 16) bst[F.tid] = 0u;
    __syncthreads();
    XcdBarrier bar; bar.bar = (unsigned*)(ws + WS_CTL) + 1024; bar.x = 0; bar.st = bst;
    if (hi - lo > 1) bar = xcd_barrier_post((unsigned*)(ws + WS_CTL) + 1024, bst);
#ifndef PROBE_MASK
#define PROBE_MASK 0
#endif
#define IN(k) (lo <= (k) && (k) < hi)
#define REPS(k) for (int rep_ = 0; rep_ < (((PROBE_MASK >> (k)) & 1) ? 2 : 1); ++rep_)
#define SEAM(k) do { if (IN(k) && IN((k) + 1)) { if ((k) == 0) grid.sync(); else xcd_barrier(bar); } } while (0)

    if (IN(0)) REPS(0) { p0_prologue(F); } SEAM(0);
    if (IN(1)) REPS(1) { row_phase<false, false, true>(F, MT, F.x, F.ctx, 0.f, 0); } SEAM(1);
    if (IN(2)) REPS(2) { pg8::Gemm g{F.Y, F.W1, MT, 2 * FF, DM}; pg8::StaticOrder S; S.init(MT, 2 * FF, F.G, F.bid); pg8::EpiSwiglu E{F.H, FF};
        pg8::gemm_phase<pg8::EpiSwiglu, pg8::StaticOrder, true, true>(F.lds, g, S, E); } SEAM(2);
    if (IN(3)) REPS(3) { pg8::Gemm g{F.H, F.W2, MT, DM, FF}; pg8::StaticOrder S; S.init(MT, DM, F.G, F.bid); pg8::EpiStore E{F.Z, DM};
        pg8::gemm_phase<pg8::EpiStore, pg8::StaticOrder, true, true>(F.lds, g, S, E); } SEAM(3);
    if (IN(4)) REPS(4) { row_phase<true, true, true>(F, MT, F.x, F.ctx, 0.5f, 1); } SEAM(4);
    if (IN(5)) REPS(5) { pg8::Gemm g{F.Y, F.WIN, MT, 2304, DM}; pg8::StaticOrder S; S.init(MT, 2304, F.G, F.bid); pg8::EpiInProj E{F.P, F.gates, F.ibias, F.fbias};
        pg8::gemm_phase<pg8::EpiInProj, pg8::StaticOrder, true, true>(F.lds, g, S, E); } SEAM(5);
    if (IN(6)) REPS(6) { for (int u = F.bid; u < NB * NH * NTB; u += F.G) m1_unit(F, u);
                 for (int u = F.bid; u < NB * GRID_ROWS * 4; u += F.G) pool_unit(F, u); } SEAM(6);
    if (IN(7)) REPS(7) { scan_phase(F); } SEAM(7);
    if (IN(8)) REPS(8) { for (int u = F.bid; u < NB * NH * 128; u += F.G) m3_unit(F, u); } SEAM(8);
    if (IN(9)) REPS(9) { pg8::Gemm g{F.MIX, F.WOUT, ML, DM, DM}; pg8::StaticOrder S; S.init(ML, DM, F.G, F.bid); pg8::EpiStore E{F.Z, DM};
        pg8::gemm_phase<pg8::EpiStore, pg8::StaticOrder, true, true>(F.lds, g, S, E); } SEAM(9);
    if (IN(10)) REPS(10) { row_phase<true, true, true>(F, ML, F.out, F.ctx, 1.0f, 2); } SEAM(10);
    if (IN(11)) REPS(11) { pg8::Gemm g{F.Y, F.W1 + (size_t)2 * FF * DM, ML, 2 * FF, DM}; pg8::StaticOrder S; S.init(ML, 2 * FF, F.G, F.bid); pg8::EpiSwiglu E{F.H, FF};
        pg8::gemm_phase<pg8::EpiSwiglu, pg8::StaticOrder, true, true>(F.lds, g, S, E); } SEAM(11);
    if (IN(12)) REPS(12) { pg8::Gemm g{F.H, F.W2 + (size_t)DM * FF, ML, DM, FF}; pg8::StaticOrder S; S.init(ML, DM, F.G, F.bid); pg8::EpiStore E{F.Z, DM};
        pg8::gemm_phase<pg8::EpiStore, pg8::StaticOrder, true, true>(F.lds, g, S, E); } SEAM(12);
    if (IN(13)) REPS(13) { row_phase<true, true, false>(F, ML, F.out, F.ctx, 0.5f, 3); }
#undef IN
#undef SEAM
}

#ifndef N_LAUNCHES
#define N_LAUNCHES 1
#endif
extern "C" void kernel_launch(void* const* d_in, const int* in_sizes, int n_in, void* d_out, int out_size, void* d_ws, size_t ws_size, hipStream_t stream) {
    static int grid = 0;
    if (grid == 0) {
        if (n_in != 21 || in_sizes[0] != ML * DM || out_size != ML * DM || ws_size < WS_END) { fprintf(stderr, "kernel_launch: unexpected shapes (n_in %d, in0 %d, out %d, ws %zu)\n", n_in, n_in > 0 ? in_sizes[0] : -1, out_size, ws_size); grid = -1; return; }
        int dev = 0, cus = 0, per_cu = 0;
        (void)hipGetDevice(&dev); (void)hipDeviceGetAttribute(&cus, hipDeviceAttributeMultiprocessorCount, dev);
        (void)hipFuncSetAttribute((const void*)fwd_kernel, hipFuncAttributeMaxDynamicSharedMemorySize, LDS_BYTES);
        (void)hipOccupancyMaxActiveBlocksPerMultiprocessor(&per_cu, (const void*)fwd_kernel, NTHREADS, LDS_BYTES);
        (void)hipGetLastError();
        if (per_cu < 1) { fprintf(stderr, "kernel_launch: occupancy query says %d blocks per CU\n", per_cu); grid = -1; return; }
        grid = cus;
    }
    if (grid < 0) return;
    Args a{};
    for (int i = 0; i < 21; ++i) a.in[i] = (const float*)d_in[i];
    a.out = (float*)d_out; a.ws = (unsigned char*)d_ws;
    if (N_LAUNCHES == 1) {
        (void)hipMemsetAsync((char*)d_ws + WS_CTL, 0, CTL_ZERO_BYTES, stream);
        a.ph_lo = 0; a.ph_hi = N_PHASES; void* kargs[] = {&a};
        hipError_t e = hipLaunchCooperativeKernel((const void*)fwd_kernel, dim3(grid), dim3(NTHREADS), kargs, LDS_BYTES, stream);
        if (e != hipSuccess) fprintf(stderr, "cooperative launch failed: %s (grid %d)\n", hipGetErrorString(e), grid);
    } else {
        for (int p = 0; p < N_PHASES; ++p) { a.ph_lo = p; a.ph_hi = p + 1; hipLaunchKernelGGL(fwd_kernel, dim3(grid), dim3(NTHREADS), LDS_BYTES, stream, a); }
    }
}
```

```cpp
#include <hip/hip_runtime.h>
#include <hip/hip_cooperative_groups.h>
#include <cstdio>
#include <cstdint>
namespace cg = cooperative_groups;
#define PROBE_MASK 0
namespace pg8 {
#define PG8_LAS __attribute__((address_space(3)))
typedef unsigned short bf16_t;
typedef short bf16x8 __attribute__((ext_vector_type(8)));
typedef float f32x4 __attribute__((ext_vector_type(4)));
typedef unsigned u32x4 __attribute__((ext_vector_type(4)));
constexpr int BM = 256, BK = 64, HALF = 128, HTB = HALF * BK * 2  , STAGE_BYTES = 8 * HTB, NXCD = 8, WGM = 8;

__host__ __device__ __forceinline__ int lds_byte(int r, int c) { const int st = (r >> 4) * 2 + (c >> 5), rr = r & 15, cc = c & 31, ob = rr * 64 + cc * 2; return st * 1024 + (ob ^ (((ob >> 9) & 1) << 5)); }
__host__ __device__ __forceinline__ void stage_rc(int b, int& R, int& C) { const int st = b / 1024, sb = b % 1024, swz = sb ^ (((sb >> 9) & 1) << 5); R = (st >> 1) * 16 + swz / 64; C = (st & 1) * 32 + (swz % 64) / 2; }
__host__ __device__ __forceinline__ int perm32(int rho) { const int n = rho >> 4, i = rho & 15; return 8 * (i >> 2) + 4 * n + (i & 3); }

struct Unit { int pm, pn; };
struct Gemm { const bf16_t* A; const bf16_t* Bt; int M, N, K; };

struct StaticOrder {
    int nM, nN, nwg, G, c;
    __host__ __device__ void init(int M, int N, int G_, int c_) { nM = M / BM; nN = N / BM; nwg = nM * nN; G = G_; c = c_; }
    __host__ __device__ bool next(int i, Unit& u) const {
        const long L = (long)i * G + c; if (L >= nwg) return false;
        int wgid = (int)L; { const int q = nwg / NXCD, r = nwg % NXCD, xcd = wgid % NXCD, off = wgid / NXCD; wgid = (xcd < r ? xcd * (q + 1) : r * (q + 1) + (xcd - r) * q) + off; }
        const int nig = WGM * nN, gid = wgid / nig, fm = gid * WGM, gsz = (nM - fm) < WGM ? (nM - fm) : WGM;
        u.pm = fm + ((wgid % nig) % gsz); u.pn = (wgid % nig) / gsz; return true;
    }
    __device__ __forceinline__ void a_ready(const Unit&) const {}
    __device__ __forceinline__ void done(const Unit&) const {}
};
__device__ __forceinline__ unsigned cvt_pk_bf16(float lo, float hi) { unsigned r; asm volatile("v_cvt_pk_bf16_f32 %0, %1, %2" : "=v"(r) : "v"(lo), "v"(hi)); return r; }
typedef float f32x2 __attribute__((ext_vector_type(2)));
typedef unsigned u32x2 __attribute__((ext_vector_type(2)));
struct EpiStore {
    static constexpr bool PERM = true, AFTER_DRAIN = false;
    bf16_t* O; int ldc;
    __device__ __forceinline__ void operator()(const f32x4 (&acc)[2][2][4][2], const Unit& u, int wr, int wc, int fr, int fq) const {
        const int row0 = u.pm * BM + wr * 64 + fr, col0 = u.pn * BM + wc * 32 + 8 * fq;
#pragma unroll
        for (int ai = 0; ai < 2; ++ai)
#pragma unroll
            for (int m = 0; m < 4; ++m) { bf16_t* rowp = O + (size_t)(row0 + ai * HALF + m * 16) * ldc + col0;
#pragma unroll
                for (int bj = 0; bj < 2; ++bj) { const f32x4 v0 = acc[ai][bj][m][0], v1 = acc[ai][bj][m][1];
                    u32x4 w; w.x = cvt_pk_bf16(v0[0], v0[1]); w.y = cvt_pk_bf16(v0[2], v0[3]); w.z = cvt_pk_bf16(v1[0], v1[1]); w.w = cvt_pk_bf16(v1[2], v1[3]);
                    *(u32x4*)(rowp + bj * HALF) = w; } }
    }
};
__device__ __forceinline__ float silu_mul(float a, float b) { return a * b * __builtin_amdgcn_rcpf(1.0f + __builtin_amdgcn_exp2f(a * -1.4426950408889634f)); }
struct EpiSwiglu {
    static constexpr bool PERM = true, AFTER_DRAIN = false;
    bf16_t* O; int ldc;
    __device__ __forceinline__ void operator()(const f32x4 (&acc)[2][2][4][2], const Unit& u, int wr, int wc, int fr, int fq) const {
        const int row0 = u.pm * BM + wr * 64 + fr, col0 = u.pn * HALF + wc * 32 + 8 * fq;
#pragma unroll
        for (int ai = 0; ai < 2; ++ai)
#pragma unroll
            for (int m = 0; m < 4; ++m) { bf16_t* rowp = O + (size_t)(row0 + ai * HALF + m * 16) * ldc + col0;
                const f32x4 a0 = acc[ai][0][m][0], a1 = acc[ai][0][m][1], b0 = acc[ai][1][m][0], b1 = acc[ai][1][m][1];
                u32x4 w; w.x = cvt_pk_bf16(silu_mul(a0[0], b0[0]), silu_mul(a0[1], b0[1])); w.y = cvt_pk_bf16(silu_mul(a0[2], b0[2]), silu_mul(a0[3], b0[3]));
                w.z = cvt_pk_bf16(silu_mul(a1[0], b1[0]), silu_mul(a1[1], b1[1])); w.w = cvt_pk_bf16(silu_mul(a1[2], b1[2]), silu_mul(a1[3], b1[3]));
                *(u32x4*)rowp = w; }
    }
};
struct EpiInProj {
    static constexpr bool PERM = true, AFTER_DRAIN = false;
    bf16_t* P; float* gates; const float* ib; const float* fb;
    __device__ __forceinline__ void operator()(const f32x4 (&acc)[2][2][4][2], const Unit& u, int wr, int wc, int fr, int fq) const {
        const int row0 = u.pm * BM + wr * 64 + fr;
        if (u.pn < 8) {
            const int col0 = u.pn * BM + wc * 32 + 8 * fq;
#pragma unroll
            for (int ai = 0; ai < 2; ++ai)
#pragma unroll
                for (int m = 0; m < 4; ++m) { bf16_t* rowp = P + (size_t)(row0 + ai * HALF + m * 16) * 2048 + col0;
#pragma unroll
                    for (int bj = 0; bj < 2; ++bj) { const f32x4 v0 = acc[ai][bj][m][0], v1 = acc[ai][bj][m][1];
                        u32x4 w; w.x = cvt_pk_bf16(v0[0], v0[1]); w.y = cvt_pk_bf16(v0[2], v0[3]); w.z = cvt_pk_bf16(v1[0], v1[1]); w.w = cvt_pk_bf16(v1[2], v1[3]);
                        *(u32x4*)(rowp + bj * HALF) = w; } }
        } else if (wc == 0 && fq < 2) {
            const float* bp = (fq == 0) ? ib : fb;
            const f32x4 bv0 = *(const f32x4*)bp, bv1 = *(const f32x4*)(bp + 4);
#pragma unroll
            for (int ai = 0; ai < 2; ++ai)
#pragma unroll
                for (int m = 0; m < 4; ++m) { float* gp = gates + (size_t)(row0 + ai * HALF + m * 16) * 16 + 8 * fq;
                    *(f32x4*)gp = acc[ai][0][m][0] + bv0; *(f32x4*)(gp + 4) = acc[ai][0][m][1] + bv1; }
        }
    }
};
template <class Epi, class Sched, bool ALIGN_EPI = false, bool SP2 = false>
__device__ __forceinline__ void gemm_phase(PG8_LAS unsigned char* lds, const Gemm g, const Sched& S, const Epi& E) {
    const int tid = threadIdx.x, wid = __builtin_amdgcn_readfirstlane(tid >> 6), lane = tid & 63, wr = wid >> 2, wc = wid & 3, fr = lane & 15, fq = lane >> 4;
    const int K = g.K, nt = K / BK;
    unsigned voffA[2], voffB[2];
#pragma unroll
    for (int i = 0; i < 2; ++i) { int R, C; stage_rc(tid * 16 + i * 8192, R, C); const int Rb = Epi::PERM ? ((R & ~31) + perm32(R & 31)) : R;
        voffA[i] = (unsigned)(R * K + C) * 2u; voffB[i] = (unsigned)(Rb * K + C) * 2u; }
    const size_t kstep = (size_t)(BK * 2);
    const size_t hstep = (size_t)HALF * K * 2;
    const size_t tstep = 2 * hstep;
    const unsigned ldsw = (unsigned)wid * 1024u;
    const int aoff = lds_byte(wr * 64 + fr, fq * 8), boff = lds_byte(wc * 32 + fr, fq * 8);
#define PG8_SA(b, h) (((b) * 2 + (h)) * HTB)
#define PG8_SB(b, h) ((4 + (b) * 2 + (h)) * HTB)
#define PG8_STAGE(bufoff, gbase, voff) do { _Pragma("unroll") for (int _i = 0; _i < 2; ++_i) \
        __builtin_amdgcn_global_load_lds((const unsigned*)((const char*)(gbase) + (voff)[_i]), (PG8_LAS unsigned*)(lds + (bufoff) + ldsw + _i * 8192), 16, 0, 0); } while (0)
#define PG8_LDA(dst, b, h) do { _Pragma("unroll") for (int m = 0; m < 4; ++m) _Pragma("unroll") for (int k = 0; k < 2; ++k) dst[m][k] = *(const PG8_LAS bf16x8*)(lds + PG8_SA(b, h) + aoff + m * 2048 + k * 1024); } while (0)
#define PG8_LDB(dst, b, h) do { _Pragma("unroll") for (int n = 0; n < 2; ++n) _Pragma("unroll") for (int k = 0; k < 2; ++k) dst[n][k] = *(const PG8_LAS bf16x8*)(lds + PG8_SB(b, h) + boff + n * 2048 + k * 1024); } while (0)
#define PG8_MMA(ai, bj, At, Bt) do { __builtin_amdgcn_s_setprio(1); _Pragma("unroll") for (int m = 0; m < 4; ++m) _Pragma("unroll") for (int n = 0; n < 2; ++n) _Pragma("unroll") for (int k = 0; k < 2; ++k) \
        acc[ai][bj][m][n] = __builtin_amdgcn_mfma_f32_16x16x32_bf16(Bt[n][k], At[m][k], acc[ai][bj][m][n], 0, 0, 0); __builtin_amdgcn_s_setprio(0); } while (0)
#define PG8_WAIT_V(n) asm volatile("s_waitcnt vmcnt(" #n ")" ::: "memory")
#define PG8_WAIT_L(n) asm volatile("s_waitcnt lgkmcnt(" #n ")" ::: "memory")
#define PG8_BAR __builtin_amdgcn_s_barrier()
#define PG8_SCHED __builtin_amdgcn_sched_barrier(0)
    Unit cur, nxt; int ui = 0;
    if (!S.next(0, cur)) return;
    f32x4 acc[2][2][4][2];
#pragma unroll
    for (int a = 0; a < 2; ++a)
#pragma unroll
        for (int b = 0; b < 2; ++b)
#pragma unroll
            for (int m = 0; m < 4; ++m)
#pragma unroll
                for (int n = 0; n < 2; ++n) acc[a][b][m][n] = (f32x4){0.f, 0.f, 0.f, 0.f};
    bf16x8 At[4][2], B0[2][2], B1[2][2];
    const char* cA = (const char*)g.A + (size_t)cur.pm * tstep; const char* cB = (const char*)g.Bt + (size_t)cur.pn * tstep;
    S.a_ready(cur);
    if constexpr (SP2) {
        PG8_STAGE(PG8_SB(0, 0), cB, voffB); PG8_STAGE(PG8_SB(0, 1), cB + hstep, voffB); PG8_STAGE(PG8_SA(0, 0), cA, voffA); PG8_STAGE(PG8_SA(0, 1), cA + hstep, voffA);
        if (wr == 1) PG8_BAR;
        PG8_WAIT_V(2); PG8_BAR;
        PG8_STAGE(PG8_SB(1, 0), cB + kstep, voffB); PG8_STAGE(PG8_SA(1, 0), cA + kstep, voffA); PG8_STAGE(PG8_SB(1, 1), cB + hstep + kstep, voffB);
        PG8_WAIT_V(6); PG8_BAR;
    } else {
        PG8_STAGE(PG8_SB(0, 0), cB, voffB); PG8_STAGE(PG8_SA(0, 0), cA, voffA); PG8_STAGE(PG8_SB(0, 1), cB + hstep, voffB); PG8_STAGE(PG8_SA(0, 1), cA + hstep, voffA);
        if (wr == 1) PG8_BAR;
        PG8_WAIT_V(4); PG8_BAR;
        PG8_STAGE(PG8_SB(1, 0), cB + kstep, voffB); PG8_STAGE(PG8_SA(1, 0), cA + kstep, voffA); PG8_STAGE(PG8_SB(1, 1), cB + hstep + kstep, voffB);
        PG8_WAIT_V(6); PG8_BAR;
    }
    for (;;) {
        const bool has_next = S.next(ui + 1, nxt);
        const char* nA = has_next ? (const char*)g.A + (size_t)nxt.pm * tstep : cA; const char* nB = has_next ? (const char*)g.Bt + (size_t)nxt.pn * tstep : cB;
        for (int t = 0; t < nt; t += 2) {
            const bool last = (t == nt - 2);
            const char* a1 = cA + (size_t)(t + 1) * kstep;
            const char* a2 = last ? nA : cA + (size_t)(t + 2) * kstep; const char* b2 = last ? nB : cB + (size_t)(t + 2) * kstep;
            const char* a3 = a2 + kstep; const char* b3 = b2 + kstep;
            if (last && has_next) S.a_ready(nxt);
            if constexpr (SP2) {
            PG8_LDB(B0, 0, 0); PG8_LDB(B1, 0, 1); PG8_SCHED; PG8_LDA(At, 0, 0); PG8_STAGE(PG8_SA(1, 1), a1 + hstep, voffA);
            PG8_WAIT_V(8); PG8_WAIT_L(0); PG8_BAR; PG8_MMA(0, 0, At, B0); PG8_MMA(0, 1, At, B1); PG8_BAR; PG8_SCHED;
            PG8_LDA(At, 0, 1); PG8_STAGE(PG8_SB(0, 0), b2, voffB); PG8_STAGE(PG8_SB(0, 1), b2 + hstep, voffB); PG8_STAGE(PG8_SA(0, 0), a2, voffA);
            PG8_WAIT_V(8); PG8_WAIT_L(0); PG8_BAR; PG8_MMA(1, 0, At, B0); PG8_MMA(1, 1, At, B1); PG8_BAR; PG8_SCHED;
            PG8_LDB(B0, 1, 0); PG8_LDB(B1, 1, 1); PG8_SCHED; PG8_LDA(At, 1, 0); PG8_STAGE(PG8_SA(0, 1), a2 + hstep, voffA);
            PG8_WAIT_V(8); PG8_WAIT_L(0); PG8_BAR; PG8_MMA(0, 0, At, B0); PG8_MMA(0, 1, At, B1); PG8_BAR; PG8_SCHED;
            PG8_LDA(At, 1, 1); PG8_STAGE(PG8_SB(1, 0), b3, voffB); PG8_STAGE(PG8_SB(1, 1), b3 + hstep, voffB); PG8_STAGE(PG8_SA(1, 0), a3, voffA);
            PG8_WAIT_V(8); PG8_WAIT_L(0); PG8_BAR; PG8_MMA(1, 0, At, B0); PG8_MMA(1, 1, At, B1); PG8_BAR; PG8_SCHED;
            } else {
            PG8_LDB(B0, 0, 0); PG8_SCHED; PG8_LDA(At, 0, 0); PG8_STAGE(PG8_SA(1, 1), a1 + hstep, voffA);
            PG8_WAIT_L(8); PG8_BAR; PG8_WAIT_L(0); PG8_MMA(0, 0, At, B0); PG8_BAR; PG8_SCHED;
            PG8_LDB(B1, 0, 1); PG8_STAGE(PG8_SB(0, 0), b2, voffB);
            PG8_BAR; PG8_WAIT_L(0); PG8_MMA(0, 1, At, B1); PG8_BAR;
            PG8_LDA(At, 0, 1); PG8_STAGE(PG8_SA(0, 0), a2, voffA);
            PG8_BAR; PG8_WAIT_L(0); PG8_MMA(1, 0, At, B0); PG8_BAR; PG8_SCHED;
            PG8_STAGE(PG8_SB(0, 1), b2 + hstep, voffB);
            PG8_WAIT_V(6); PG8_BAR; PG8_MMA(1, 1, At, B1); PG8_BAR;
            PG8_LDB(B0, 1, 0); PG8_SCHED; PG8_LDA(At, 1, 0); PG8_STAGE(PG8_SA(0, 1), a2 + hstep, voffA);
            PG8_WAIT_L(8); PG8_BAR; PG8_WAIT_L(0); PG8_MMA(0, 0, At, B0); PG8_BAR; PG8_SCHED;
            PG8_LDB(B1, 1, 1); PG8_STAGE(PG8_SB(1, 0), b3, voffB);
            PG8_BAR; PG8_WAIT_L(0); PG8_MMA(0, 1, At, B1); PG8_BAR;
            PG8_LDA(At, 1, 1); PG8_STAGE(PG8_SA(1, 0), a3, voffA);
            PG8_BAR; PG8_WAIT_L(0); PG8_MMA(1, 0, At, B0); PG8_BAR; PG8_SCHED;
            PG8_STAGE(PG8_SB(1, 1), b3 + hstep, voffB);
            PG8_WAIT_V(6); PG8_BAR; PG8_MMA(1, 1, At, B1); PG8_BAR;
            }
        }
        if constexpr (ALIGN_EPI) { if (wr == 0) PG8_BAR; }
        if constexpr (!Epi::AFTER_DRAIN) { E(acc, cur, wr, wc, fr, fq); S.done(cur); }
        if (!has_next) break;
#pragma unroll
        for (int a = 0; a < 2; ++a)
#pragma unroll
            for (int b = 0; b < 2; ++b)
#pragma unroll
                for (int m = 0; m < 4; ++m)
#pragma unroll
                    for (int n = 0; n < 2; ++n) acc[a][b][m][n] = (f32x4){0.f, 0.f, 0.f, 0.f};
        cur = nxt; cA = nA; cB = nB; ++ui;
        if constexpr (ALIGN_EPI) { if (wr == 1) PG8_BAR; }
    }
    PG8_WAIT_V(0);
    if constexpr (!ALIGN_EPI) { if (wr == 0) PG8_BAR; }
    PG8_BAR;
    if constexpr (Epi::AFTER_DRAIN) { E.fused(acc, cur, wr, wc, fr, fq, lds, wid, lane); S.done(cur); }
#undef PG8_SA
#undef PG8_SB
#undef PG8_STAGE
#undef PG8_LDA
#undef PG8_LDB
#undef PG8_MMA
#undef PG8_WAIT_V
#undef PG8_WAIT_L
#undef PG8_BAR
#undef PG8_SCHED
}
}
constexpr int DM = 1024, SEQ = 16384, NB = 2, CTXL = 256, FF = 2816, NMOD = 9;
constexpr int ML = NB * SEQ, MC = NB * CTXL, MT = ML + MC;
constexpr int NH = 4, HD = 128, MW = 512, GW = 64, GRID_ROWS = SEQ / GW;
constexpr int NTB = 130;
constexpr float EPS = 1e-6f;
constexpr int NWAVES = 8, NTHREADS = 512;

constexpr size_t MiB = 1u << 20, KiB = 1024;
constexpr size_t WS_CTL = 0;
constexpr size_t WS_MOD = 1 * MiB;
constexpr size_t WS_WQT = 1 * MiB + 256 * KiB;
constexpr size_t WS_WKT = 1 * MiB + 512 * KiB;
constexpr size_t WS_MLOC = 1 * MiB + 768 * KiB;
constexpr size_t WS_G = WS_MLOC + 16 * KiB;
constexpr size_t WS_MIN = WS_G + 16 * KiB;
constexpr size_t WS_CN = 2 * MiB;
constexpr size_t WS_NIN = 3 * MiB + 256 * KiB;
constexpr size_t WS_GATES = 5 * MiB;
constexpr size_t WS_W1 = 8 * MiB;
constexpr size_t WS_W2 = 30 * MiB;
constexpr size_t WS_WIN = 41 * MiB;
constexpr size_t WS_WOUT = 46 * MiB;
constexpr size_t WS_Y = 48 * MiB;
constexpr size_t WS_Z = 113 * MiB;
constexpr size_t WS_CKV = 48 * MiB;
constexpr size_t WS_H = 178 * MiB;
constexpr size_t WS_P = 178 * MiB;
constexpr size_t WS_Q = 308 * MiB;
constexpr size_t WS_K = WS_Q + (size_t)MT * 512 * 2;
constexpr size_t WS_CIN = 373 * MiB;
constexpr size_t WS_MIX = 437 * MiB;
constexpr size_t WS_GB = 501 * MiB;
constexpr size_t WS_END = 505 * MiB;
static_assert(WS_K + (size_t)MT * 512 * 2 <= WS_CIN && WS_Z + (size_t)MT * 1024 * 2 <= WS_H && WS_CKV + (size_t)16 * 130 * 65536 <= WS_H && WS_P + (size_t)MT * 2048 * 2 <= WS_Q, "ws map");
static_assert(WS_GATES + (size_t)MT * 64 <= WS_W1 && WS_NIN + 16 * 130 * 512 <= WS_GATES && WS_CN + 16 * 130 * 512 <= WS_NIN, "ws map small");
constexpr size_t CTL_ZERO_BYTES = 64 * KiB;

constexpr int LDS_BYTES = 160 * 1024;

#define LAS __attribute__((address_space(3)))
typedef unsigned short bf16;
typedef short bf16x8 __attribute__((ext_vector_type(8)));
typedef float f32x4 __attribute__((ext_vector_type(4)));
typedef float f32x2v __attribute__((ext_vector_type(2)));
typedef unsigned u32x4 __attribute__((ext_vector_type(4)));
typedef unsigned u32x2 __attribute__((ext_vector_type(2)));
#define LDS_WAIT() asm volatile("s_waitcnt lgkmcnt(0)" ::: "memory")
#define LDS_BARRIER() do { asm volatile("s_waitcnt lgkmcnt(0)" ::: "memory"); __builtin_amdgcn_s_barrier(); asm volatile("" ::: "memory"); } while (0)

__device__ __forceinline__ unsigned f2bf(float f) { unsigned u = __builtin_bit_cast(unsigned, f); return (u + 0x7fffu + ((u >> 16) & 1u)) >> 16; }
__device__ __forceinline__ unsigned pk2(float lo, float hi) { return f2bf(lo) | (f2bf(hi) << 16); }
__device__ __forceinline__ float bflo(unsigned w) { return __uint_as_float(w << 16); }
__device__ __forceinline__ float bfhi(unsigned w) { return __uint_as_float(w & 0xffff0000u); }
__device__ __forceinline__ float wave_sum(float v) {
#pragma unroll
    for (int o = 1; o < 64; o <<= 1) v += __shfl_xor(v, o);
    return v;
}
__device__ __forceinline__ float wave_max(float v) {
#pragma unroll
    for (int o = 1; o < 64; o <<= 1) v = fmaxf(v, __shfl_xor(v, o));
    return v;
}
__device__ __forceinline__ float log_sigmoid(float x) { return fminf(x, 0.f) - log1pf(expf(-fabsf(x))); }
__device__ __forceinline__ f32x4 mfma16(bf16x8 a, bf16x8 b, f32x4 c) { return __builtin_amdgcn_mfma_f32_16x16x32_bf16(a, b, c, 0, 0, 0); }

__device__ __forceinline__ unsigned opaque(unsigned x) { asm volatile("" : "+v"(x)); return x; }
template <class T> __device__ __forceinline__ T ldg(const void* ubase, unsigned boff) { return *(const T*)((const char*)ubase + boff); }
template <class T> __device__ __forceinline__ void stg(void* ubase, unsigned boff, T v) { *(T*)((char*)ubase + boff) = v; }

struct Args { const float* in[21]; float* out; unsigned char* ws; int ph_lo, ph_hi, probe, pad; };

struct Ctx {
    LAS unsigned char* lds;
    int tid, lane, wave, G, bid, probe;
    const float *x, *c, *ctx, *cctx, *wmod, *bmod, *npre, *npost, *fwin, *fwout, *win, *wout, *convw, *convb, *wq, *wk, *ibias, *fbias, *hnorm, *poolw, *pscale;
    float* out; unsigned char* ws;
    float* mod; bf16 *wqt, *wkt; float *mloc, *gsum, *min_, *cn, *nin, *gates, *gb;
    bf16 *W1, *W2, *WIN, *WOUT, *Y, *Z, *H, *P, *Q, *K, *CIN, *MIX, *CKV;
};

constexpr int TP0_SCR = 16384;
constexpr int P0_SC_OFF = 131072, P0_RED_OFF = 131072 + 12288;

__device__ __forceinline__ void tr_store(LAS float* scr, bf16* WT, int K, int n0, int k0, int lane) {
    const int c = lane & 7;
#pragma unroll
    for (int j = 0; j < 4; ++j) { const int n = (lane >> 3) + 8 * j; const LAS float* s = scr + (8 * c) * 33 + n;
        u32x4 o; o.x = pk2(s[0 * 33], s[1 * 33]); o.y = pk2(s[2 * 33], s[3 * 33]); o.z = pk2(s[4 * 33], s[5 * 33]); o.w = pk2(s[6 * 33], s[7 * 33]);
        *(u32x4*)(WT + (size_t)(n0 + n) * K + k0 + 8 * c) = o; }
}
__device__ __forceinline__ void tr_item(const float* W, int ldw, bf16* WT, int K, int n0, int srccol, int k0, LAS float* scr, int lane) {
    float tv[32]; const int sc_ = (srccol >= 0) ? srccol : 0;
#pragma unroll
    for (int i = 0; i < 32; ++i) tv[i] = W[(size_t)(k0 + 2 * i + (lane >> 5)) * ldw + sc_];
#pragma unroll
    for (int i = 0; i < 32; ++i) scr[(2 * i + (lane >> 5)) * 33 + (lane & 31)] = (srccol >= 0) ? tv[i] : 0.f;
    LDS_WAIT(); asm volatile("" ::: "memory");
    tr_store(scr, WT, K, n0, k0, lane);
    LDS_WAIT(); asm volatile("" ::: "memory");
}

constexpr int IT_W1 = 16 * 176, IT_W2 = 44 * 32, IT_WIN = 16 * 72, IT_WO = 8 * 32, IT_WE = 8 * 32, IT_QK = 8;
constexpr int IT_TOTAL = 2 * IT_W1 + 2 * IT_W2 + IT_WIN + IT_WO + IT_WE + 8 * IT_QK;

__device__ __forceinline__ void p0_wave_item(const Ctx& F, int it, LAS float* scr) {
    const int lane = F.lane, ln = lane & 31;
    int r = it;
    if (r < 2 * IT_W1) { const int f = r / IT_W1; r -= f * IT_W1; const int kb = r / 176, nb = r % 176, n0 = 32 * nb, pn = n0 >> 8, i = (n0 & 255) + ln;
        const int src = (i < 128) ? 128 * pn + i : FF + 128 * pn + (i - 128);
        tr_item(F.fwin + (size_t)f * DM * 2 * FF, 2 * FF, F.W1 + (size_t)f * 2 * FF * DM, DM, n0, src, 64 * kb, scr, lane); return; }
    r -= 2 * IT_W1;
    if (r < 2 * IT_W2) { const int f = r / IT_W2; r -= f * IT_W2; const int kb = r / 32, nb = r % 32;
        tr_item(F.fwout + (size_t)f * FF * DM, DM, F.W2 + (size_t)f * DM * FF, FF, 32 * nb, 32 * nb + ln, 64 * kb, scr, lane); return; }
    r -= 2 * IT_W2;
    if (r < IT_WIN) { const int kb = r / 72, nb = r % 72, n = 32 * nb + ln;
        const int src = (n < 1536) ? n : (n < 2048) ? n + 16 : (n < 2064) ? n - 512 : -1;
        tr_item(F.win, 2064, F.WIN, DM, 32 * nb, src, 64 * kb, scr, lane); return; }
    r -= IT_WIN;
    if (r < IT_WO) { const int kb = r / 32, nb = r % 32;
        tr_item(F.wout, DM, F.WOUT, DM, 32 * nb, 32 * nb + ln, 64 * kb, scr, lane); return; }
    r -= IT_WO;
    if (r < IT_WE) { const int kb = r / 32, nb = r % 32, g = kb >> 1, kk0 = 64 * (kb & 1), n0 = 32 * nb, fr = lane & 15, fq = lane >> 4;
        const float* pw = F.poolw + (size_t)g * 128 * 128 + (size_t)(kk0 + fr) * 128; const float* ps = F.pscale + g * 128; const float* wo = F.wout + (size_t)(512 + g * 128) * DM + n0 + fr;
        f32x4 acc[4][2];
#pragma unroll
        for (int mt = 0; mt < 4; ++mt) { acc[mt][0] = (f32x4){0.f, 0.f, 0.f, 0.f}; acc[mt][1] = acc[mt][0]; }
#pragma unroll 4
        for (int ks = 0; ks < 32; ++ks) { const int e = 4 * ks + fq; const float pse = ps[e]; const float b0 = wo[(size_t)e * DM], b1 = wo[(size_t)e * DM + 16];
#pragma unroll
            for (int mt = 0; mt < 4; ++mt) { const float a = pw[(size_t)(16 * mt) * 128 + e] * pse;
                acc[mt][0] = __builtin_amdgcn_mfma_f32_16x16x4f32(a, b0, acc[mt][0], 0, 0, 0); acc[mt][1] = __builtin_amdgcn_mfma_f32_16x16x4f32(a, b1, acc[mt][1], 0, 0, 0); } }
#pragma unroll
        for (int mt = 0; mt < 4; ++mt)
#pragma unroll
            for (int nt = 0; nt < 2; ++nt)
#pragma unroll
                for (int e = 0; e < 4; ++e) scr[(16 * mt + 4 * fq + e) * 33 + 16 * nt + fr] = acc[mt][nt][e];
        LDS_WAIT(); asm volatile("" ::: "memory");
        tr_store(scr, F.WOUT, DM, n0, 512 + 64 * kb, lane);
        LDS_WAIT(); asm volatile("" ::: "memory"); return; }
    r -= IT_WE;
    { const int which = r / (4 * IT_QK); r -= which * 4 * IT_QK; const int h = r / IT_QK; r -= h * IT_QK; const int kb = r / 4, nb = r % 4;
      const float* W = (which ? F.wk : F.wq) + (size_t)h * 128 * 128; bf16* WT = (which ? F.wkt : F.wqt) + (size_t)h * 128 * 128;
      tr_item(W, 128, WT, 128, 32 * nb, 32 * nb + ln, 64 * kb, scr, lane); }
}

__device__ __forceinline__ void p0_prologue(const Ctx& F) {
    LAS float* scl = (LAS float*)(F.lds + P0_SC_OFF); LAS float* red = (LAS float*)(F.lds + P0_RED_OFF);
    for (int j = F.bid; j < 144; j += F.G) {
        for (int i = F.tid; i < 3072; i += NTHREADS) { const int b = i >> 10, k = i & 1023; const float v = (b < 2) ? F.c[b * DM + k] : F.cctx[k]; scl[i] = v / (1.0f + expf(-v)); }
        __syncthreads();
        const int col = 64 * j + F.lane, k0 = 128 * F.wave; float a0 = 0.f, a1 = 0.f, a2 = 0.f;
#pragma unroll 32
        for (int kk = 0; kk < 128; ++kk) { const float wv = F.wmod[(size_t)(k0 + kk) * (NMOD * DM) + col]; a0 += scl[k0 + kk] * wv; a1 += scl[1024 + k0 + kk] * wv; a2 += scl[2048 + k0 + kk] * wv; }
        red[(F.wave * 3 + 0) * 64 + F.lane] = a0; red[(F.wave * 3 + 1) * 64 + F.lane] = a1; red[(F.wave * 3 + 2) * 64 + F.lane] = a2;
        __syncthreads();
        if (F.tid < 192) { const int b = F.tid >> 6, l = F.tid & 63; float s = 0.f;
#pragma unroll
            for (int w = 0; w < 8; ++w) s += red[(w * 3 + b) * 64 + l];
            F.mod[b * (NMOD * DM) + 64 * j + l] = s + F.bmod[64 * j + l]; }
        __syncthreads();
    }
    LAS float* scr = (LAS float*)(F.lds + F.wave * TP0_SCR);
    const int gw = F.bid * NWAVES + F.wave, NGW = F.G * NWAVES;
    for (int it = gw; it < IT_TOTAL; it += NGW) p0_wave_item(F, it, scr);
}

template <bool HAS_Z, bool WRITE_X, bool WRITE_Y>
__device__ __forceinline__ void row_phase(const Ctx& F, int nrows, const float* xlat, const float* xctx, float resw, int jsub) {
    const int gw = F.bid * NWAVES + F.wave, NGW = F.G * NWAVES, lane = F.lane;
    for (int r = gw; r < nrows; r += NGW) {
        const int mb = (r < ML) ? (r >> 14) : 2;
        const float* xr = (r < ML) ? xlat + (size_t)r * DM : xctx + (size_t)(r - ML) * DM;
        f32x4 v[4];
#pragma unroll
        for (int j = 0; j < 4; ++j) v[j] = *(const f32x4*)(xr + 4 * lane + 256 * j);
        if (HAS_Z) {
            const int js = jsub - 1; const bf16* zr = F.Z + (size_t)r * DM; f32x4 z[4]; float ss = 0.f;
#pragma unroll
            for (int j = 0; j < 4; ++j) { const u32x2 w = *(const u32x2*)(zr + 4 * lane + 256 * j); z[j] = (f32x4){bflo(w.x), bfhi(w.x), bflo(w.y), bfhi(w.y)};
                ss += (z[j].x * z[j].x + z[j].y * z[j].y) + (z[j].z * z[j].z + z[j].w * z[j].w); }
            const float rz = resw * rsqrtf(wave_sum(ss) * (1.0f / DM) + EPS);
            const float* gate = F.mod + (size_t)mb * (NMOD * DM) + (3 * js + 2) * DM; const float* gp = F.npost + js * DM;
#pragma unroll
            for (int j = 0; j < 4; ++j) { const f32x4 ga = *(const f32x4*)(gate + 4 * lane + 256 * j), gg = *(const f32x4*)(gp + 4 * lane + 256 * j); v[j] = v[j] + (z[j] * rz) * ga * gg; }
            if (WRITE_X && r < ML) {
#pragma unroll
                for (int j = 0; j < 4; ++j) *(f32x4*)(F.out + (size_t)r * DM + 4 * lane + 256 * j) = v[j];
            }
        }
        if (WRITE_Y) {
            float ss = 0.f;
#pragma unroll
            for (int j = 0; j < 4; ++j) ss += (v[j].x * v[j].x + v[j].y * v[j].y) + (v[j].z * v[j].z + v[j].w * v[j].w);
            const float rr = rsqrtf(wave_sum(ss) * (1.0f / DM) + EPS);
            const float* sh = F.mod + (size_t)mb * (NMOD * DM) + (3 * jsub) * DM; const float* sc = sh + DM; const float* gp = F.npre + jsub * DM;
            bf16* yr = F.Y + (size_t)r * DM;
#pragma unroll
            for (int j = 0; j < 4; ++j) { const f32x4 s4 = *(const f32x4*)(sh + 4 * lane + 256 * j), c4 = *(const f32x4*)(sc + 4 * lane + 256 * j), g4 = *(const f32x4*)(gp + 4 * lane + 256 * j);
                const f32x4 y = (v[j] * rr) * g4 * (c4 + 1.0f) + s4; u32x2 w; w.x = pk2(y.x, y.y); w.y = pk2(y.z, y.w); *(u32x2*)(yr + 4 * lane + 256 * j) = w; }
        }
    }
}

constexpr int TP = 272, TILE_B = 128 * TP;
__device__ __forceinline__ bf16x8 ldfrag(LAS unsigned char* tile, int row, int kk, int fq) { return *(const LAS bf16x8*)(tile + row * TP + (32 * kk + 8 * fq) * 2); }
__device__ __forceinline__ void st4(LAS unsigned char* tile, int row, int col, float a, float b, float c, float d) { u32x2 w; w.x = pk2(a, b); w.y = pk2(c, d); *(LAS u32x2*)(tile + row * TP + col * 2) = w; }
__device__ __forceinline__ bf16x8 ident_frag(int nt, int fr, int fq) { const int jj = 16 * (nt & 1) + fr - 8 * fq; bf16x8 f;
#pragma unroll
    for (int j = 0; j < 8; ++j) f[j] = (j == jj) ? (short)0x3F80 : (short)0;
    return f; }
constexpr float LOG2E = 1.4426950408889634f, LN2 = 0.6931471805599453f;
__device__ __forceinline__ float fexp(float x) { return __builtin_amdgcn_exp2f(x * LOG2E); }
__device__ __forceinline__ float fsigmoid(float x) { return __builtin_amdgcn_rcpf(1.0f + fexp(-x)); }
__device__ __forceinline__ float flog_sigmoid(float x) { return fminf(x, 0.f) - LN2 * __builtin_amdgcn_logf(1.0f + fexp(-fabsf(x))); }
struct GateScan { float ip0, ip1, b0, b1, g; int tau0, tau1; };
__device__ __forceinline__ GateScan gate_scan(const float* gates, int R0, int dir, int h, int lane) {
    GateScan r; r.tau0 = dir ? 127 - 2 * lane : 2 * lane; r.tau1 = dir ? r.tau0 - 1 : r.tau0 + 1;
    const float* gr = gates + (size_t)R0 * 16 + dir * 4 + h;
    r.ip0 = gr[r.tau0 * 16]; r.ip1 = gr[r.tau1 * 16];
    const float lf0 = flog_sigmoid(gr[r.tau0 * 16 + 8]), lf1 = flog_sigmoid(gr[r.tau1 * 16 + 8]);
    const float s = lf0 + lf1; float incl = s;
#pragma unroll
    for (int o = 1; o < 64; o <<= 1) { const float t = __shfl_up(incl, o); if (lane >= o) incl += t; }
    r.b0 = incl - s + lf0; r.b1 = incl; r.g = __shfl(incl, 63);
    return r;
}
__device__ __forceinline__ void make_vt(const bf16* vrow  , LAS unsigned char* VT, int w, int fr, int fq) {
#pragma unroll
    for (int nt = 0; nt < 8; ++nt) { const bf16x8 vf = *(const bf16x8*)(vrow + 32 * (nt >> 1) + 8 * fq);
        const f32x4 a = mfma16(vf, ident_frag(nt, fr, fq), (f32x4){0.f, 0.f, 0.f, 0.f});
        st4(VT, 16 * nt + fr, 16 * w + 4 * fq, a[0], a[1], a[2], a[3]); }
}

constexpr int M1_U = 0, M1_KW0 = TILE_B, M1_KW1 = 2 * TILE_B, M1_VT = 3 * TILE_B, M1_WGT = 4 * TILE_B;
__device__ __forceinline__ void m1_unit(const Ctx& F, int unit) {
    const int tid = F.tid, lane = F.lane, w = F.wave, fr = lane & 15, fq = lane >> 4;
    const int tb = unit % NTB, bh = unit / NTB, h = bh & 3, b = bh >> 2;
    const bool isctx = tb < 2;
    const int R0 = isctx ? ML + b * CTXL + tb * 128 : b * SEQ + (tb - 2) * 128, t0 = isctx ? tb * 128 : (tb - 2) * 128, L = isctx ? CTXL : SEQ;
    LAS unsigned char* U = F.lds + M1_U; LAS unsigned char* VT = F.lds + M1_VT; LAS float* wgt = (LAS float*)(F.lds + M1_WGT);
    bf16x8 wqf[4], wkf[4], vf[8];
#pragma unroll
    for (int kk = 0; kk < 4; ++kk) { wqf[kk] = *(const bf16x8*)(F.wqt + (size_t)(h * 128 + 16 * w + fr) * 128 + 32 * kk + 8 * fq); wkf[kk] = *(const bf16x8*)(F.wkt + (size_t)(h * 128 + 16 * w + fr) * 128 + 32 * kk + 8 * fq); }
#pragma unroll
    for (int tt = 0; tt < 8; ++tt) vf[tt] = *(const bf16x8*)(F.P + (size_t)(R0 + 16 * tt + fr) * 2048 + 512 + h * 128 + 32 * (w >> 1) + 8 * fq);
    { const int ch8 = (tid & 15) * 8, ch = h * 128 + ch8;
      f32x4 cw[3][2], cb[2];
#pragma unroll
      for (int jj = 0; jj < 3; ++jj) { cw[jj][0] = *(const f32x4*)(F.convw + jj * MW + ch); cw[jj][1] = *(const f32x4*)(F.convw + jj * MW + ch + 4); }
      cb[0] = *(const f32x4*)(F.convb + ch); cb[1] = *(const f32x4*)(F.convb + ch + 4);
#pragma unroll
      for (int it = 0; it < 4; ++it) { const int tau = (tid >> 4) + 32 * it;
        const bf16* p = F.P + (size_t)(R0 + tau) * 2048 + ch;
        const bool hp = (t0 + tau > 0), hn_ = (t0 + tau < L - 1);
        const u32x4 cu = *(const u32x4*)p; u32x4 pv = *(const u32x4*)(hp ? p - 2048 : p), nx = *(const u32x4*)(hn_ ? p + 2048 : p);
        pv.x = hp ? pv.x : 0u; pv.y = hp ? pv.y : 0u; pv.z = hp ? pv.z : 0u; pv.w = hp ? pv.w : 0u; nx.x = hn_ ? nx.x : 0u; nx.y = hn_ ? nx.y : 0u; nx.z = hn_ ? nx.z : 0u; nx.w = hn_ ? nx.w : 0u;
        float o[8];
#pragma unroll
        for (int e = 0; e < 8; ++e) { const unsigned wc_ = cu[e >> 1], wp = pv[e >> 1], wn = nx[e >> 1];
            const float xc = (e & 1) ? bfhi(wc_) : bflo(wc_), xp = (e & 1) ? bfhi(wp) : bflo(wp), xn = (e & 1) ? bfhi(wn) : bflo(wn);
            const float val = cb[e >> 2][e & 3] + xp * cw[0][e >> 2][e & 3] + xc * cw[1][e >> 2][e & 3] + xn * cw[2][e >> 2][e & 3];
            o[e] = val * fsigmoid(val); }
        u32x4 ow; ow.x = pk2(o[0], o[1]); ow.y = pk2(o[2], o[3]); ow.z = pk2(o[4], o[5]); ow.w = pk2(o[6], o[7]);
        *(LAS u32x4*)(U + tau * TP + ch8 * 2) = ow; } }
    if (w < 2) { const int dir = w; const GateScan gs = gate_scan(F.gates, R0, dir, h, lane);
        const float a0 = gs.g - gs.b0 + gs.ip0, a1 = gs.g - gs.b1 + gs.ip1, ml = wave_max(fmaxf(a0, a1));
        wgt[dir * 128 + gs.tau0] = fexp(a0 - ml); wgt[dir * 128 + gs.tau1] = fexp(a1 - ml);
        const int sidx = (bh * 2 + dir) * NTB + tb;
        if (lane == 0) { F.mloc[sidx] = ml; F.gsum[sidx] = gs.g; }
        const float c0 = gs.ip0 - gs.b0, c1 = gs.ip1 - gs.b1;
        float pm = fmaxf(c0, c1);
#pragma unroll
        for (int o = 1; o < 64; o <<= 1) { const float t = __shfl_up(pm, o); if (lane >= o) pm = fmaxf(pm, t); }
        float pmx = __shfl_up(pm, 1); if (lane == 0) pmx = -INFINITY;
        float* gbp = F.gb + (size_t)sidx * 384;
        gbp[gs.tau0] = gs.b0; gbp[gs.tau1] = gs.b1; gbp[128 + gs.tau0] = c0; gbp[128 + gs.tau1] = c1; gbp[256 + gs.tau0] = fmaxf(pmx, c0); gbp[256 + gs.tau1] = pm; }
    LDS_BARRIER();
    { const bf16x8 idf = ident_frag(w, fr, fq); const float ksc = 0.08838834764831845f;
      const size_t gcol = (size_t)h * 128 + 16 * w + 4 * fq;
#pragma unroll
      for (int tt = 0; tt < 8; ++tt) { bf16x8 uf[4];
#pragma unroll
          for (int kk = 0; kk < 4; ++kk) uf[kk] = ldfrag(U, 16 * tt + fr, kk, fq);
          f32x4 q = (f32x4){0.f, 0.f, 0.f, 0.f}, k = q, k2 = q;
#pragma unroll
          for (int kk = 0; kk < 4; ++kk) { q = mfma16(wqf[kk], uf[kk], q); k = mfma16(wkf[kk], uf[kk], k); k2 = mfma16(uf[kk], wkf[kk], k2); }
          const size_t go = (size_t)(R0 + 16 * tt + fr) * 512 + gcol;
          { u32x2 o; o.x = pk2(q[0], q[1]); o.y = pk2(q[2], q[3]); *(u32x2*)(F.Q + go) = o; }
          { u32x2 o; o.x = pk2(k[0] * ksc, k[1] * ksc); o.y = pk2(k[2] * ksc, k[3] * ksc); *(u32x2*)(F.K + go) = o; }
#pragma unroll
          for (int dir = 0; dir < 2; ++dir) { const f32x4 wv = *(const LAS f32x4*)(wgt + dir * 128 + 16 * tt + 4 * fq);
              st4(F.lds + (dir ? M1_KW1 : M1_KW0), 16 * w + fr, 16 * tt + 4 * fq, k2[0] * ksc * wv[0], k2[1] * ksc * wv[1], k2[2] * ksc * wv[2], k2[3] * ksc * wv[3]); }
          const f32x4 a = mfma16(vf[tt], idf, (f32x4){0.f, 0.f, 0.f, 0.f});
          st4(VT, 16 * w + fr, 16 * tt + 4 * fq, a[0], a[1], a[2], a[3]); } }
    LDS_BARRIER();
    { bf16x8 vtf[4];
#pragma unroll
      for (int kk = 0; kk < 4; ++kk) vtf[kk] = ldfrag(VT, 16 * w + fr, kk, fq);
#pragma unroll
      for (int dir = 0; dir < 2; ++dir) { LAS unsigned char* KW = F.lds + (dir ? M1_KW1 : M1_KW0);
          bf16* cg_ = F.CKV + ((size_t)((bh * 2 + dir) * NTB + tb)) * 16384 + (size_t)(16 * w + fr) * 128 + 4 * fq;
#pragma unroll
          for (int mt = 0; mt < 8; ++mt) { f32x4 a = (f32x4){0.f, 0.f, 0.f, 0.f};
#pragma unroll
              for (int kk = 0; kk < 4; ++kk) a = mfma16(ldfrag(KW, 16 * mt + fr, kk, fq), vtf[kk], a);
              u32x2 o; o.x = pk2(a[0], a[1]); o.y = pk2(a[2], a[3]); *(u32x2*)(cg_ + 16 * mt) = o; } } }
    if (tid < 256) { const int dir = tid >> 7, dk = tid & 127; LAS unsigned char* KW = F.lds + (dir ? M1_KW1 : M1_KW0) + dk * TP; float s_ = 0.f;
#pragma unroll
        for (int c = 0; c < 16; ++c) { const u32x4 q = *(const LAS u32x4*)(KW + 16 * c); s_ += (bflo(q.x) + bfhi(q.x)) + (bflo(q.y) + bfhi(q.y)) + (bflo(q.z) + bfhi(q.z)) + (bflo(q.w) + bfhi(q.w)); }
        F.cn[((size_t)((bh * 2 + dir) * NTB + tb)) * 128 + dk] = s_; }
}

template <int G_>
__device__ __forceinline__ void pool_unit_t(const Ctx& F, int b, int r) {
    constexpr int win = 2 << G_, lo = win >> 1, hi = win - 1 - lo;
    const int tid = F.tid, pr = tid & 63, cgp = tid >> 6;
    const int rlo = max(r - lo, 0), rhi = min(r + hi, GRID_ROWS - 1); const float cntr = (float)(rhi - rlo + 1);
    LAS f32x2v* vs = (LAS f32x2v*)F.lds;
    const bf16* base = F.P + (size_t)b * SEQ * 2048 + 1536 + G_ * 128 + 2 * pr;
    float s0[8], s1[8];
#pragma unroll
    for (int cc = 0; cc < 8; ++cc) { s0[cc] = 0.f; s1[cc] = 0.f; }
    constexpr int RB = win < 4 ? win : 4;
#pragma unroll 1
    for (int i0 = 0; i0 < win; i0 += RB) {
#pragma unroll
        for (int i = 0; i < RB; ++i) { const int rr = r - lo + i0 + i; const bool ok = (rr >= 0) && (rr < GRID_ROWS); const int rc = min(max(rr, 0), GRID_ROWS - 1);
#pragma unroll
            for (int cc = 0; cc < 8; ++cc) { unsigned wv = *(const unsigned*)(base + (size_t)(rc * GW + 8 * cgp + cc) * 2048); wv = ok ? wv : 0u; s0[cc] += bflo(wv); s1[cc] += bfhi(wv); } } }
    unsigned ctr[8];
#pragma unroll
    for (int cc = 0; cc < 8; ++cc) { ctr[cc] = *(const unsigned*)(base + (size_t)(r * GW + 8 * cgp + cc) * 2048); vs[(8 * cgp + cc) * 64 + pr] = (f32x2v){s0[cc], s1[cc]}; }
    LDS_BARRIER();
#pragma unroll
    for (int cc = 0; cc < 8; ++cc) { const int c = 8 * cgp + cc, clo = max(c - lo, 0), chi = min(c + hi, GW - 1); float t0 = 0.f, t1 = 0.f;
#pragma unroll
        for (int i = 0; i < win; ++i) { const int c2 = c - lo + i; const bool ok = (c2 >= 0) && (c2 < GW); const f32x2v t = vs[min(max(c2, 0), GW - 1) * 64 + pr]; t0 += ok ? t.x : 0.f; t1 += ok ? t.y : 0.f; }
        const float inv = 1.0f / (cntr * (float)(chi - clo + 1));
        *(unsigned*)(F.MIX + (size_t)(b * SEQ + r * GW + c) * 1024 + 512 + G_ * 128 + 2 * pr) = pk2(t0 * inv - bflo(ctr[cc]), t1 * inv - bfhi(ctr[cc])); }
    LDS_BARRIER();
}
__device__ __forceinline__ void pool_unit(const Ctx& F, int unit) {
    const int k = unit / GRID_ROWS, r = unit % GRID_ROWS, b = k >> 2, g = (r + k) & 3;
    if (g == 0) pool_unit_t<0>(F, b, r); else if (g == 1) pool_unit_t<1>(F, b, r); else if (g == 2) pool_unit_t<2>(F, b, r); else pool_unit_t<3>(F, b, r);
}

__device__ __forceinline__ void scan_phase(const Ctx& F) {
    const int nslots = 16 * 8192;
    for (int slot = F.bid * NTHREADS + F.tid; slot < nslots; slot += F.G * NTHREADS) {
        const int stream = slot >> 13, pe = slot & 8191, dir = stream & 1;
        float C0 = 0.f, C1 = 0.f, n0 = 0.f, n1 = 0.f, m = 0.f;
        const bool do_n = pe < 64;
        for (int c0 = 0; c0 < NTB; c0 += 10) {
            unsigned ck[10]; float gg[10], mm[10]; f32x2v cnv[10];
#pragma unroll
            for (int i = 0; i < 10; ++i) { const int c = c0 + i, tb = dir ? (c < 2 ? 1 - c : 131 - c) : c; const size_t sidx = (size_t)stream * NTB + tb;
                ck[i] = *(const unsigned*)(F.CKV + sidx * 16384 + 2 * pe); gg[i] = F.gsum[sidx]; mm[i] = F.mloc[sidx];
                cnv[i] = do_n ? *(const f32x2v*)(F.cn + sidx * 128 + 2 * pe) : (f32x2v){0.f, 0.f}; }
#pragma unroll
            for (int i = 0; i < 10; ++i) { const int c = c0 + i, tb = dir ? (c < 2 ? 1 - c : 131 - c) : c; const size_t sidx = (size_t)stream * NTB + tb;
                if (tb >= 2) { *(unsigned*)(F.CIN + ((size_t)stream * 128 + (tb - 2)) * 16384 + 2 * pe) = pk2(C0, C1);
                    if (do_n) *(f32x2v*)(F.nin + sidx * 128 + 2 * pe) = (f32x2v){n0, n1};
                    if (pe == 0) F.min_[sidx] = m; }
                const float mn = fmaxf(gg[i] + m, mm[i]), ao = expf(gg[i] + m - mn), an = expf(mm[i] - mn);
                C0 = ao * C0 + an * bflo(ck[i]); C1 = ao * C1 + an * bfhi(ck[i]); n0 = ao * n0 + an * cnv[i].x; n1 = ao * n1 + an * cnv[i].y; m = mn; }
        }
    }
}

constexpr int M3_K = 0, M3_VT = TILE_B, M3_CT0 = 2 * TILE_B, M3_CT1 = 3 * TILE_B, M3_MISC = 4 * TILE_B;
constexpr int M3_UNITS = NB * NH * 128;
struct M3Pre { u32x4 kr[4], c0r[4], c1r[4]; };
__device__ __forceinline__ void m3_decode(int unit, int& bh, int& j) { bh = unit & 7; j = unit >> 3; }
__device__ __forceinline__ void m3_load(const Ctx& F, int unit, M3Pre& P) {
    const int tid = F.tid;
    int bh, j; m3_decode(unit, bh, j); const int h = bh & 3, b = bh >> 2, R0 = b * SEQ + j * 128;
    const bf16* cin0 = F.CIN + ((size_t)(bh * 2 + 0) * 128 + j) * 16384; const bf16* cin1 = F.CIN + ((size_t)(bh * 2 + 1) * 128 + j) * 16384;
    const bf16* kb = F.K + (size_t)R0 * 512 + h * 128;
    const unsigned row0 = tid >> 4, c8 = (tid & 15) * 8;
    const unsigned ok_ = opaque((row0 * 512 + c8) * 2), oc_ = opaque((row0 * 128 + c8) * 2);
#pragma unroll
    for (int it = 0; it < 4; ++it) { P.kr[it] = ldg<u32x4>(kb + (size_t)it * 32 * 512, ok_);
        P.c0r[it] = ldg<u32x4>(cin0 + (size_t)it * 32 * 128, oc_); P.c1r[it] = ldg<u32x4>(cin1 + (size_t)it * 32 * 128, oc_); }
}
__device__ __forceinline__ void m3_phase(const Ctx& F) {
    const int tid = F.tid, lane = F.lane, w = F.wave, fr = lane & 15, fq = lane >> 4;
    LAS unsigned char* Kt = F.lds + M3_K; LAS unsigned char* VT = F.lds + M3_VT;
    LAS float* rt2 = (LAS float*)(F.lds + M3_MISC); LAS float* ct2 = rt2 + 256; LAS float* winter = rt2 + 512; LAS float* minv = rt2 + 768; LAS float* ninl = rt2 + 1024;
    int unit = F.bid; if (unit >= M3_UNITS) return;
    M3Pre cur; m3_load(F, unit, cur);
    const int t = 16 * w + fr;
#pragma unroll 1
    for (;;) {
        int bh, j; m3_decode(unit, bh, j); const int h = bh & 3, b = bh >> 2, R0 = b * SEQ + j * 128;
        bf16x8 qf[4], vr[4];
        { const bf16* vb = F.P + (size_t)R0 * 2048 + 512 + h * 128; const bf16* qb = F.Q + (size_t)R0 * 512 + h * 128; const unsigned tr = opaque(16 * w + fr);
#pragma unroll
          for (int kk = 0; kk < 4; ++kk) { vr[kk] = ldg<bf16x8>(vb, (tr * 2048 + 8 * fq + 32 * kk) * 2); qf[kk] = ldg<bf16x8>(qb, (tr * 512 + 32 * kk + 8 * fq) * 2); } }
        float g_b, g_c, g_pm, g_min, g_nin;
        { const unsigned t2 = tid & 255, dir = t2 >> 7, tau = t2 & 127; const size_t s0 = (size_t)(bh * 2) * NTB + j + 2;
          const unsigned so = opaque(dir * NTB);
          g_b = ldg<float>(F.gb + s0 * 384, (so * 384 + tau) * 4); g_c = ldg<float>(F.gb + s0 * 384, (so * 384 + 128 + tau) * 4); g_pm = ldg<float>(F.gb + s0 * 384, (so * 384 + 256 + tau) * 4);
          g_min = ldg<float>(F.min_ + s0, so * 4); g_nin = ldg<float>(F.nin + s0 * 128, (so * 128 + tau) * 4); }
        LDS_BARRIER();
        { LAS unsigned char* wb = F.lds + opaque((tid >> 4) * TP + (tid & 15) * 16);
#pragma unroll
          for (int it = 0; it < 4; ++it) { *(LAS u32x4*)(wb + M3_K + it * 32 * TP) = cur.kr[it]; *(LAS u32x4*)(wb + M3_CT0 + it * 32 * TP) = cur.c0r[it]; *(LAS u32x4*)(wb + M3_CT1 + it * 32 * TP) = cur.c1r[it]; } }
        { const int fr_o = (int)opaque((unsigned)fr);
#pragma unroll
          for (int nt = 0; nt < 8; ++nt) { const f32x4 a = mfma16(vr[nt >> 1], ident_frag(nt, fr_o, fq), (f32x4){0.f, 0.f, 0.f, 0.f}); st4(VT, 16 * nt + fr_o, 16 * w + 4 * fq, a[0], a[1], a[2], a[3]); } }
        if (tid < 256) { const float mt_ = g_b + fmaxf(g_pm, g_min); LAS float* mb = (LAS float*)(F.lds + M3_MISC + opaque(tid * 4));
            mb[1024] = g_nin; mb[0] = (g_b - mt_) * LOG2E; mb[256] = g_c * LOG2E; mb[512] = fexp(g_b + g_min - mt_); mb[768] = fexp(-mt_); }
        const int unext = unit + F.G; const bool has_next = unext < M3_UNITS;
        m3_load(F, has_next ? unext : unit, cur);
        LDS_BARRIER();
        const unsigned fb16 = opaque(fr * TP + fq * 16), fb8 = opaque(fr * TP + fq * 8);
        const int dlt = (int)opaque((unsigned)(t - 4 * fq));
        f32x4 Hs[8];
#pragma unroll 1
        for (int prb = 0; prb <= ((F.probe >> 16) & 1); ++prb) {
#pragma unroll
        for (int mt = 0; mt < 8; ++mt) Hs[mt] = (f32x4){0.f, 0.f, 0.f, 0.f};
#pragma unroll 1
        for (int dir = 0; dir < 2; ++dir) {
            LAS unsigned char* CT = F.lds + (dir ? M3_CT1 : M3_CT0);
            const float rt = rt2[dir * 128 + t], wi = winter[dir * 128 + t], mi = minv[dir * 128 + t];
            const int sgn = dir ? -1 : 1, dl2 = (int)opaque((unsigned)(sgn * dlt));
            f32x4 acc[8];
#pragma unroll
            for (int mt = 0; mt < 8; ++mt) acc[mt] = (f32x4){0.f, 0.f, 0.f, 0.f};
#pragma unroll
            for (int kk = 0; kk < 4; ++kk) { bf16x8 kf[8];
#pragma unroll
                for (int mt = 0; mt < 8; ++mt) kf[mt] = *(const LAS bf16x8*)(Kt + fb16 + 16 * mt * TP + 64 * kk);
#pragma unroll
                for (int mt = 0; mt < 8; ++mt) acc[mt] = mfma16(kf[mt], qf[kk], acc[mt]); }
            float dsum = 0.f; u32x2 sp[8];
#pragma unroll
            for (int mt = 0; mt < 8; ++mt) { const f32x4 ct = *(const LAS f32x4*)(ct2 + dir * 128 + 16 * mt + 4 * fq); float o[4];
#pragma unroll
                for (int e = 0; e < 4; ++e) { const bool ok = sgn * (16 * mt + e) <= dl2; o[e] = ok ? acc[mt][e] * __builtin_amdgcn_exp2f(rt + ct[e]) : 0.f; dsum += o[e]; }
                sp[mt].x = pk2(o[0], o[1]); sp[mt].y = pk2(o[2], o[3]); }
            dsum += __shfl_xor(dsum, 16); dsum += __shfl_xor(dsum, 32);
            float qn = 0.f;
#pragma unroll
            for (int kk = 0; kk < 4; ++kk)
#pragma unroll
                for (int e = 0; e < 8; ++e) qn += __uint_as_float(((unsigned)(unsigned short)qf[kk][e]) << 16) * ninl[dir * 128 + 32 * kk + 8 * fq + e];
            qn += __shfl_xor(qn, 16); qn += __shfl_xor(qn, 32);
            const float den = wi * qn + dsum, rden = 1.0f / fmaxf(fabsf(den), mi);
#pragma unroll
            for (int mt = 0; mt < 8; ++mt) acc[mt] = (f32x4){0.f, 0.f, 0.f, 0.f};
#pragma unroll
            for (int kk = 0; kk < 4; ++kk) { bf16x8 cf[8];
#pragma unroll
                for (int mt = 0; mt < 8; ++mt) cf[mt] = *(const LAS bf16x8*)(CT + fb16 + 16 * mt * TP + 64 * kk);
#pragma unroll
                for (int mt = 0; mt < 8; ++mt) acc[mt] = mfma16(cf[mt], qf[kk], acc[mt]); }
#pragma unroll
            for (int mt = 0; mt < 8; ++mt) acc[mt] = acc[mt] * wi;
#pragma unroll
            for (int kk = 0; kk < 4; ++kk) {
                if (dir ? (2 * kk + 1 >= w) : (2 * kk <= w)) { u32x2 lo[8], hi[8];
                    const u32x4 bv = (u32x4){sp[2 * kk].x, sp[2 * kk].y, sp[2 * kk + 1].x, sp[2 * kk + 1].y};
#pragma unroll
                    for (int mt = 0; mt < 8; ++mt) { const LAS unsigned char* vp = VT + fb8 + 16 * mt * TP + 64 * kk; lo[mt] = *(const LAS u32x2*)vp; hi[mt] = *(const LAS u32x2*)(vp + 32); }
#pragma unroll
                    for (int mt = 0; mt < 8; ++mt) { const u32x4 av = (u32x4){lo[mt].x, lo[mt].y, hi[mt].x, hi[mt].y};
                        acc[mt] = mfma16(__builtin_bit_cast(bf16x8, av), __builtin_bit_cast(bf16x8, bv), acc[mt]); } } }
#pragma unroll
            for (int mt = 0; mt < 8; ++mt) Hs[mt] = Hs[mt] + acc[mt] * rden;
        }
        }
        f32x4 hn[8]; u32x2 ogr[8]; const unsigned t_o = opaque((unsigned)t), fq_o = opaque((unsigned)fq);
#pragma unroll
        for (int mt = 0; mt < 8; ++mt) { hn[mt] = ldg<f32x4>(F.hnorm + h * 128 + 16 * mt, (4 * fq_o) * 4); ogr[mt] = ldg<u32x2>(F.P + (size_t)R0 * 2048 + 1024 + h * 128 + 16 * mt, (t_o * 2048 + 4 * fq_o) * 2); }
        float ss = 0.f;
#pragma unroll
        for (int mt = 0; mt < 8; ++mt) ss += (Hs[mt][0] * Hs[mt][0] + Hs[mt][1] * Hs[mt][1]) + (Hs[mt][2] * Hs[mt][2] + Hs[mt][3] * Hs[mt][3]);
        ss += __shfl_xor(ss, 16); ss += __shfl_xor(ss, 32);
        const float rr = rsqrtf(ss * (1.0f / HD) + EPS);
        bf16* mixb = F.MIX + (size_t)R0 * 1024 + h * 128;
#pragma unroll
        for (int mt = 0; mt < 8; ++mt) { const u32x2 ow = ogr[mt];
            const float o0 = bflo(ow.x), o1 = bfhi(ow.x), o2 = bflo(ow.y), o3 = bfhi(ow.y);
            u32x2 r; r.x = pk2(Hs[mt][0] * rr * hn[mt][0] * fsigmoid(o0), Hs[mt][1] * rr * hn[mt][1] * fsigmoid(o1));
            r.y = pk2(Hs[mt][2] * rr * hn[mt][2] * fsigmoid(o2), Hs[mt][3] * rr * hn[mt][3] * fsigmoid(o3));
            stg<u32x2>(mixb + 16 * mt, (t_o * 1024 + 4 * fq_o) * 2, r); }
        if (!has_next) break;
        unit = unext;
    }
}

#define XB_TMO      128
#define XB_XCNT(j)  (256  + 64 * (j))
#define XB_XSUB(j)  (1280 + 64 * (j))
#define XB_XGEN(j)  (2304 + 64 * (j))
#define XB_TOP      3328
#define XB_TOPGEN   3392
#define XCD_BAR_WORDS 3456
#define XB_SPIN_CAP (1u << 18)

__device__ __forceinline__ unsigned xb_ld(unsigned* p)              { return __hip_atomic_load(p, __ATOMIC_RELAXED, __HIP_MEMORY_SCOPE_AGENT); }
__device__ __forceinline__ unsigned xb_add(unsigned* p, unsigned v) { return __hip_atomic_fetch_add(p, v, __ATOMIC_RELAXED, __HIP_MEMORY_SCOPE_AGENT); }
__device__ __forceinline__ unsigned xb_xcc_id() { return (unsigned)__builtin_amdgcn_s_getreg((3 << 11) | 20) & 0xFu; }
#define XB_SPIN(cond, bar) do { unsigned _sp = 0; while (cond) { __builtin_amdgcn_s_sleep(1); \
    if ((++_sp & 255u) == 0u) { if (xb_ld(&(bar)[XB_TMO])) break; if (_sp > XB_SPIN_CAP) { atomicAdd(&(bar)[XB_TMO], 1u); break; } } } } while (0)

struct XcdBarrier {
    unsigned* bar; unsigned x;
    volatile LAS unsigned* st;
};

__device__ __forceinline__ XcdBarrier xcd_barrier_post(unsigned* bar, volatile LAS unsigned* st) {
    XcdBarrier b; b.bar = bar; b.x = xb_xcc_id(); b.st = st;
    if (threadIdx.x == 0) (void)xb_add(&bar[XB_XCNT(b.x)], 1u);
    return b;
}
__device__ __forceinline__ void xcd_barrier_complete(unsigned* bar, unsigned x, unsigned& nloc, unsigned& nx) {
    const unsigned G = gridDim.x * gridDim.y * gridDim.z;
    unsigned sum, cnt, mine, sp = 0u;
    for (;;) {
        sum = 0u; cnt = 0u; mine = 0u;
#pragma unroll
        for (unsigned j = 0; j < 16; ++j) { const unsigned c = xb_ld(&bar[XB_XCNT(j)]); sum += c; cnt += (c > 0u) ? 1u : 0u; mine = (j == x) ? c : mine; }
        if (sum == G) break;
        __builtin_amdgcn_s_sleep(1);
        if ((++sp & 255u) == 0u) { if (xb_ld(&bar[XB_TMO])) break; if (sp > XB_SPIN_CAP) { atomicAdd(&bar[XB_TMO], 1u); break; } }
    }
    nloc = mine > 0u ? mine : 1u; nx = cnt > 0u ? cnt : 1u;
}

__device__ __forceinline__ void xcd_barrier(const XcdBarrier& b) {
    asm volatile("s_waitcnt vmcnt(0)" ::: "memory");
    __syncthreads();
    if (threadIdx.x == 0) {
        unsigned* bar = b.bar;
        __builtin_amdgcn_s_waitcnt(0);
        unsigned nloc = b.st[0], nx = b.st[1];
        if (nloc == 0u) { xcd_barrier_complete(bar, b.x, nloc, nx); b.st[0] = nloc; b.st[1] = nx; }
        const unsigned old = xb_add(&bar[XB_XSUB(b.x)], 1u);
        const unsigned gen = old / nloc;
        if (old + 1u == (gen + 1u) * nloc) {
            __builtin_amdgcn_fence(__ATOMIC_RELEASE, "agent");
            asm volatile("s_waitcnt vmcnt(0)" ::: "memory");
            const unsigned og = xb_add(&bar[XB_TOP], 1u);
            const unsigned tg = og / nx;
            if (og + 1u == (tg + 1u) * nx) xb_add(&bar[XB_TOPGEN], 1u);
            else XB_SPIN(xb_ld(&bar[XB_TOPGEN]) == tg, bar);
            __builtin_amdgcn_fence(__ATOMIC_ACQUIRE, "agent");
            xb_add(&bar[XB_XGEN(b.x)], 1u);
            asm volatile("s_waitcnt vmcnt(0)" ::: "memory");
        } else {
            XB_SPIN(xb_ld(&bar[XB_XGEN(b.x)]) == gen, bar);
            __builtin_amdgcn_fence(__ATOMIC_ACQUIRE, "agent");
            asm volatile("s_waitcnt vmcnt(0)" ::: "memory");
        }
    }
    __syncthreads();
}

constexpr int N_PHASES = 14;
__global__ void __launch_bounds__(NTHREADS, 2) fwd_kernel(Args args) {
    extern __shared__ __attribute__((aligned(16))) unsigned char lds_raw[];
    Ctx F;
    F.lds = (LAS unsigned char*)lds_raw;
    F.tid = threadIdx.x; F.lane = F.tid & 63; F.wave = __builtin_amdgcn_readfirstlane(F.tid >> 6); F.G = gridDim.x; F.bid = blockIdx.x; F.probe = args.probe;
    F.x = args.in[0]; F.c = args.in[1]; F.ctx = args.in[2]; F.cctx = args.in[3]; F.wmod = args.in[4]; F.bmod = args.in[5]; F.npre = args.in[6]; F.npost = args.in[7];
    F.fwin = args.in[8]; F.fwout = args.in[9]; F.win = args.in[10]; F.wout = args.in[11]; F.convw = args.in[12]; F.convb = args.in[13]; F.wq = args.in[14]; F.wk = args.in[15];
    F.ibias = args.in[16]; F.fbias = args.in[17]; F.hnorm = args.in[18]; F.poolw = args.in[19]; F.pscale = args.in[20];
    F.out = args.out; F.ws = args.ws; unsigned char* ws = args.ws;
    F.mod = (float*)(ws + WS_MOD); F.wqt = (bf16*)(ws + WS_WQT); F.wkt = (bf16*)(ws + WS_WKT); F.mloc = (float*)(ws + WS_MLOC); F.gsum = (float*)(ws + WS_G); F.min_ = (float*)(ws + WS_MIN);
    F.gb = (float*)(ws + WS_GB); F.cn = (float*)(ws + WS_CN); F.nin = (float*)(ws + WS_NIN); F.gates = (float*)(ws + WS_GATES);
    F.W1 = (bf16*)(ws + WS_W1); F.W2 = (bf16*)(ws + WS_W2); F.WIN = (bf16*)(ws + WS_WIN); F.WOUT = (bf16*)(ws + WS_WOUT); F.Y = (bf16*)(ws + WS_Y); F.Z = (bf16*)(ws + WS_Z);
    F.H = (bf16*)(ws + WS_H); F.P = (bf16*)(ws + WS_P); F.Q = (bf16*)(ws + WS_Q); F.K = (bf16*)(ws + WS_K); F.CIN = (bf16*)(ws + WS_CIN); F.MIX = (bf16*)(ws + WS_MIX); F.CKV = (bf16*)(ws + WS_CKV);
    const int lo = args.ph_lo, hi = args.ph_hi;
    cg::grid_group grid = cg::this_grid();
    volatile LAS unsigned* bst = (volatile LAS unsigned*)(F.lds + LDS_BYTES - 64);
    if (F.tid < 16) bst[F.tid] = 0u;
    __syncthreads();
    XcdBarrier bar; bar.bar = (unsigned*)(ws + WS_CTL) + 1024; bar.x = 0; bar.st = bst;
    if (hi - lo > 1) bar = xcd_barrier_post((unsigned*)(ws + WS_CTL) + 1024, bst);
#ifndef PROBE_MASK
#define PROBE_MASK 0
#endif
#define IN(k) (lo <= (k) && (k) < hi)
#define REPS(k) _Pragma("unroll 1") for (int rep_ = 0; rep_ <= ((args.probe >> (k)) & 1); ++rep_)
#define SEAM(k) do { if (IN(k) && IN((k) + 1)) { if ((k) == 0) grid.sync(); else xcd_barrier(bar); } } while (0)

    if (IN(0)) REPS(0) { p0_prologue(F); } SEAM(0);
    if (IN(1)) REPS(1) { row_phase<false, false, true>(F, MT, F.x, F.ctx, 0.f, 0); } SEAM(1);
    if (IN(2)) { pg8::Gemm g{F.Y, F.W1, MT, 2 * FF, DM}; pg8::StaticOrder S; S.init(MT, 2 * FF, F.G, F.bid); pg8::EpiSwiglu E{F.H, FF};
        pg8::gemm_phase<pg8::EpiSwiglu, pg8::StaticOrder, true, true>(F.lds, g, S, E); } SEAM(2);
    if (IN(3)) { pg8::Gemm g{F.H, F.W2, MT, DM, FF}; pg8::StaticOrder S; S.init(MT, DM, F.G, F.bid); pg8::EpiStore E{F.Z, DM};
        pg8::gemm_phase<pg8::EpiStore, pg8::StaticOrder, true, true>(F.lds, g, S, E); } SEAM(3);
    if (IN(4)) { row_phase<true, true, true>(F, MT, F.x, F.ctx, 0.5f, 1); } SEAM(4);
    if (IN(5)) { pg8::Gemm g{F.Y, F.WIN, MT, 2304, DM}; pg8::StaticOrder S; S.init(MT, 2304, F.G, F.bid); pg8::EpiInProj E{F.P, F.gates, F.ibias, F.fbias};
        pg8::gemm_phase<pg8::EpiInProj, pg8::StaticOrder, true, true>(F.lds, g, S, E); } SEAM(5);
    if (IN(6)) { REPS(15) for (int u = F.bid; u < NB * NH * NTB; u += F.G) m1_unit(F, u);
                 REPS(14) for (int u = F.bid; u < NB * GRID_ROWS * 4; u += F.G) pool_unit(F, u); } SEAM(6);
    if (IN(7)) REPS(7) { scan_phase(F); } SEAM(7);
    if (IN(8)) REPS(8) { m3_phase(F); } SEAM(8);
    if (IN(9)) REPS(9) { pg8::Gemm g{F.MIX, F.WOUT, ML, DM, DM}; pg8::StaticOrder S; S.init(ML, DM, F.G, F.bid); pg8::EpiStore E{F.Z, DM};
        pg8::gemm_phase<pg8::EpiStore, pg8::StaticOrder, true, true>(F.lds, g, S, E); } SEAM(9);
    if (IN(10)) { row_phase<true, true, true>(F, ML, F.out, F.ctx, 1.0f, 2); } SEAM(10);
    if (IN(11)) { pg8::Gemm g{F.Y, F.W1 + (size_t)2 * FF * DM, ML, 2 * FF, DM}; pg8::StaticOrder S; S.init(ML, 2 * FF, F.G, F.bid); pg8::EpiSwiglu E{F.H, FF};
        pg8::gemm_phase<pg8::EpiSwiglu, pg8::StaticOrder, true, true>(F.lds, g, S, E); } SEAM(11);
    if (IN(12)) { pg8::Gemm g{F.H, F.W2 + (size_t)DM * FF, ML, DM, FF}; pg8::StaticOrder S; S.init(ML, DM, F.G, F.bid); pg8::EpiStore E{F.Z, DM};
        pg8::gemm_phase<pg8::EpiStore, pg8::StaticOrder, true, true>(F.lds, g, S, E); } SEAM(12);
    if (IN(13)) { row_phase<true, true, false>(F, ML, F.out, F.ctx, 0.5f, 3); }
#undef IN
#undef SEAM
}

#ifndef PROBE_MASK
#define PROBE_MASK 0
#endif
#ifndef N_LAUNCHES
#define N_LAUNCHES 1
#endif
extern "C" void kernel_launch(void* const* d_in, const int* in_sizes, int n_in, void* d_out, int out_size, void* d_ws, size_t ws_size, hipStream_t stream) {
    static int grid = 0;
    if (grid == 0) {
        if (n_in != 21 || in_sizes[0] != ML * DM || out_size != ML * DM || ws_size < WS_END) { fprintf(stderr, "kernel_launch: unexpected shapes (n_in %d, in0 %d, out %d, ws %zu)\n", n_in, n_in > 0 ? in_sizes[0] : -1, out_size, ws_size); grid = -1; return; }
        int dev = 0, cus = 0, per_cu = 0;
        (void)hipGetDevice(&dev); (void)hipDeviceGetAttribute(&cus, hipDeviceAttributeMultiprocessorCount, dev);
        (void)hipFuncSetAttribute((const void*)fwd_kernel, hipFuncAttributeMaxDynamicSharedMemorySize, LDS_BYTES);
        (void)hipOccupancyMaxActiveBlocksPerMultiprocessor(&per_cu, (const void*)fwd_kernel, NTHREADS, LDS_BYTES);
        (void)hipGetLastError();
        if (per_cu < 1) { fprintf(stderr, "kernel_launch: occupancy query says %d blocks per CU\n", per_cu); grid = -1; return; }
        grid = cus;
    }
    if (grid < 0) return;
    Args a{};
    for (int i = 0; i < 21; ++i) a.in[i] = (const float*)d_in[i];
    a.out = (float*)d_out; a.ws = (unsigned char*)d_ws; a.probe = PROBE_MASK;
    if (N_LAUNCHES == 1) {
        (void)hipMemsetAsync((char*)d_ws + WS_CTL, 0, CTL_ZERO_BYTES, stream);
        a.ph_lo = 0; a.ph_hi = N_PHASES; void* kargs[] = {&a};
        hipError_t e = hipLaunchCooperativeKernel((const void*)fwd_kernel, dim3(grid), dim3(NTHREADS), kargs, LDS_BYTES, stream);
        if (e != hipSuccess) fprintf(stderr, "cooperative launch failed: %s (grid %d)\n", hipGetErrorString(e), grid);
    } else {
        for (int p = 0; p < N_PHASES; ++p) { a.ph_lo = p; a.ph_hi = p + 1; hipLaunchKernelGGL(fwd_kernel, dim3(grid), dim3(NTHREADS), LDS_BYTES, stream, a); }
    }
}
```

```cpp
#include <hip/hip_runtime.h>
#include <hip/hip_cooperative_groups.h>
#include <cstdio>
#include <cstdint>
namespace cg = cooperative_groups;
namespace pg8 {
#define PG8_LAS __attribute__((address_space(3)))
typedef unsigned short bf16_t;
typedef short bf16x8 __attribute__((ext_vector_type(8)));
typedef float f32x4 __attribute__((ext_vector_type(4)));
typedef unsigned u32x4 __attribute__((ext_vector_type(4)));
constexpr int BM = 256, BK = 64, HALF = 128, HTB = HALF * BK * 2  , STAGE_BYTES = 8 * HTB, NXCD = 8, WGM = 8;

__host__ __device__ __forceinline__ int lds_byte(int r, int c) { const int st = (r >> 4) * 2 + (c >> 5), rr = r & 15, cc = c & 31, ob = rr * 64 + cc * 2; return st * 1024 + (ob ^ (((ob >> 9) & 1) << 5)); }
__host__ __device__ __forceinline__ void stage_rc(int b, int& R, int& C) { const int st = b / 1024, sb = b % 1024, swz = sb ^ (((sb >> 9) & 1) << 5); R = (st >> 1) * 16 + swz / 64; C = (st & 1) * 32 + (swz % 64) / 2; }
__host__ __device__ __forceinline__ int perm32(int rho) { const int n = rho >> 4, i = rho & 15; return 8 * (i >> 2) + 4 * n + (i & 3); }

struct Unit { int pm, pn; };
struct Gemm { const bf16_t* A; const bf16_t* Bt; int M, N, K; int a_tiled; };

struct StaticOrder {
    int nM, nN, nwg, G, c, rev;
    __host__ __device__ void init(int M, int N, int G_, int c_, int rev_ = 0) { nM = M / BM; nN = N / BM; nwg = nM * nN; G = G_; c = c_; rev = rev_; }
    __host__ __device__ bool next(int i, Unit& u) const {
        const long L = (long)i * G + c; if (L >= nwg) return false;
        int wgid = (int)L; { const int q = nwg / NXCD, r = nwg % NXCD, xcd = wgid % NXCD, off = wgid / NXCD; wgid = (xcd < r ? xcd * (q + 1) : r * (q + 1) + (xcd - r) * q) + off; }
        const int nig = WGM * nN, gid = wgid / nig, fm = gid * WGM, gsz = (nM - fm) < WGM ? (nM - fm) : WGM;
        u.pm = fm + ((wgid % nig) % gsz); u.pn = (wgid % nig) / gsz;
        if (rev == 1) u.pm = nM - 1 - u.pm; else if (rev == 2) u.pm = (u.pm < nM - 2) ? nM - 3 - u.pm : u.pm;
        return true;
    }
    __device__ __forceinline__ void a_ready(const Unit&) const {}
    __device__ __forceinline__ void done(const Unit&) const {}
};
struct GatedOrder : StaticOrder {
    unsigned* cnt; unsigned need; int pm_gate;
    __device__ __forceinline__ void a_ready(const Unit& u) const {
        if (u.pm < pm_gate) return;
        if (threadIdx.x < 64) { unsigned sp = 0;
            while ((unsigned)__builtin_amdgcn_readfirstlane(__hip_atomic_load(cnt, __ATOMIC_RELAXED, __HIP_MEMORY_SCOPE_AGENT)) < need) { __builtin_amdgcn_s_sleep(2); if (++sp > (1u << 22)) break; }
            __builtin_amdgcn_fence(__ATOMIC_ACQUIRE, "agent");
            asm volatile("s_waitcnt vmcnt(0)" ::: "memory"); }
        asm volatile("" ::: "memory"); __builtin_amdgcn_s_barrier(); asm volatile("" ::: "memory");
    }
};
__device__ __forceinline__ unsigned cvt_pk_bf16(float lo, float hi) { unsigned r; asm volatile("v_cvt_pk_bf16_f32 %0, %1, %2" : "=v"(r) : "v"(lo), "v"(hi)); return r; }
typedef float f32x2 __attribute__((ext_vector_type(2)));
typedef unsigned u32x2 __attribute__((ext_vector_type(2)));
struct EpiStore {
    static constexpr bool PERM = true, AFTER_DRAIN = false;
    bf16_t* O; int ldc;
    __device__ __forceinline__ void operator()(const f32x4 (&acc)[2][2][4][2], const Unit& u, int wr, int wc, int fr, int fq) const {
        const int row0 = u.pm * BM + wr * 64 + fr, col0 = u.pn * BM + wc * 32 + 8 * fq;
#pragma unroll
        for (int ai = 0; ai < 2; ++ai)
#pragma unroll
            for (int m = 0; m < 4; ++m) { bf16_t* rowp = O + (size_t)(row0 + ai * HALF + m * 16) * ldc + col0;
#pragma unroll
                for (int bj = 0; bj < 2; ++bj) { const f32x4 v0 = acc[ai][bj][m][0], v1 = acc[ai][bj][m][1];
                    u32x4 w; w.x = cvt_pk_bf16(v0[0], v0[1]); w.y = cvt_pk_bf16(v0[2], v0[3]); w.z = cvt_pk_bf16(v1[0], v1[1]); w.w = cvt_pk_bf16(v1[2], v1[3]);
                    *(u32x4*)(rowp + bj * HALF) = w; } }
    }
};
__device__ __forceinline__ float silu_mul(float a, float b) { return a * b * __builtin_amdgcn_rcpf(1.0f + __builtin_amdgcn_exp2f(a * -1.4426950408889634f)); }
struct EpiSwiglu {
    static constexpr bool PERM = true, AFTER_DRAIN = false;
    bf16_t* O; int ldc;
    __device__ __forceinline__ void operator()(const f32x4 (&acc)[2][2][4][2], const Unit& u, int wr, int wc, int fr, int fq) const {
        const int hcol = u.pn * HALF + wc * 32 + 8 * fq, r0 = wr * 64 + fr;
        bf16_t* slab = O + ((size_t)u.pm * (ldc / 64) + (hcol >> 6)) * (BM * 64) + (hcol & 63);
#pragma unroll
        for (int ai = 0; ai < 2; ++ai)
#pragma unroll
            for (int m = 0; m < 4; ++m) { bf16_t* rowp = slab + (size_t)(r0 + ai * HALF + m * 16) * 64;
                const f32x4 a0 = acc[ai][0][m][0], a1 = acc[ai][0][m][1], b0 = acc[ai][1][m][0], b1 = acc[ai][1][m][1];
                u32x4 w; w.x = cvt_pk_bf16(silu_mul(a0[0], b0[0]), silu_mul(a0[1], b0[1])); w.y = cvt_pk_bf16(silu_mul(a0[2], b0[2]), silu_mul(a0[3], b0[3]));
                w.z = cvt_pk_bf16(silu_mul(a1[0], b1[0]), silu_mul(a1[1], b1[1])); w.w = cvt_pk_bf16(silu_mul(a1[2], b1[2]), silu_mul(a1[3], b1[3]));
                *(u32x4*)rowp = w; }
    }
};
struct EpiInProj {
    static constexpr bool PERM = true, AFTER_DRAIN = false;
    bf16_t* P; float* gates; const float* ib; const float* fb;
    __device__ __forceinline__ void operator()(const f32x4 (&acc)[2][2][4][2], const Unit& u, int wr, int wc, int fr, int fq) const {
        const int row0 = u.pm * BM + wr * 64 + fr;
        if (u.pn < 8) {
            const int col0 = u.pn * BM + wc * 32 + 8 * fq;
#pragma unroll
            for (int ai = 0; ai < 2; ++ai)
#pragma unroll
                for (int m = 0; m < 4; ++m) { bf16_t* rowp = P + (size_t)(row0 + ai * HALF + m * 16) * 2048 + col0;
#pragma unroll
                    for (int bj = 0; bj < 2; ++bj) { const f32x4 v0 = acc[ai][bj][m][0], v1 = acc[ai][bj][m][1];
                        u32x4 w; w.x = cvt_pk_bf16(v0[0], v0[1]); w.y = cvt_pk_bf16(v0[2], v0[3]); w.z = cvt_pk_bf16(v1[0], v1[1]); w.w = cvt_pk_bf16(v1[2], v1[3]);
                        *(u32x4*)(rowp + bj * HALF) = w; } }
        } else if (wc == 0 && fq < 2) {
            const float* bp = (fq == 0) ? ib : fb;
            const f32x4 bv0 = *(const f32x4*)bp, bv1 = *(const f32x4*)(bp + 4);
#pragma unroll
            for (int ai = 0; ai < 2; ++ai)
#pragma unroll
                for (int m = 0; m < 4; ++m) { float* gp = gates + (size_t)(row0 + ai * HALF + m * 16) * 16 + 8 * fq;
                    *(f32x4*)gp = acc[ai][0][m][0] + bv0; *(f32x4*)(gp + 4) = acc[ai][0][m][1] + bv1; }
        }
    }
};
template <class Epi, class Sched, bool ALIGN_EPI = false, bool SP2 = false>
__device__ __forceinline__ void gemm_phase(PG8_LAS unsigned char* lds, const Gemm g, const Sched& S, const Epi& E) {
    const int tid = threadIdx.x, wid = __builtin_amdgcn_readfirstlane(tid >> 6), lane = tid & 63, wr = wid >> 2, wc = wid & 3, fr = lane & 15, fq = lane >> 4;
    const int K = g.K, nt = K / BK, ldA = g.a_tiled ? BK : K;
    unsigned voffA[2], voffB[2];
#pragma unroll
    for (int i = 0; i < 2; ++i) { int R, C; stage_rc(tid * 16 + i * 8192, R, C); const int Rb = Epi::PERM ? ((R & ~31) + perm32(R & 31)) : R;
        voffA[i] = (unsigned)(R * ldA + C) * 2u; voffB[i] = (unsigned)(Rb * ldA + C) * 2u; }
    const size_t kstep = (size_t)(BK * 2);
    const size_t hstep = (size_t)HALF * K * 2;
    const size_t tstep = 2 * hstep;
    const size_t kstepA = g.a_tiled ? (size_t)(BM * BK * 2) : kstep, hstepA = g.a_tiled ? (size_t)(HALF * BK * 2) : hstep, tstepA = g.a_tiled ? (size_t)(K / BK) * (BM * BK * 2) : tstep;
    const unsigned ldsw = (unsigned)wid * 1024u;
    const int aoff = lds_byte(wr * 64 + fr, fq * 8), boff = lds_byte(wc * 32 + fr, fq * 8);
#define PG8_SA(b, h) (((b) * 2 + (h)) * HTB)
#define PG8_SB(b, h) ((4 + (b) * 2 + (h)) * HTB)
#define PG8_STAGE(bufoff, gbase, voff) do { _Pragma("unroll") for (int _i = 0; _i < 2; ++_i) \
        __builtin_amdgcn_global_load_lds((const unsigned*)((const char*)(gbase) + (voff)[_i]), (PG8_LAS unsigned*)(lds + (bufoff) + ldsw + _i * 8192), 16, 0, 0); } while (0)
#define PG8_LDA(dst, b, h) do { _Pragma("unroll") for (int m = 0; m < 4; ++m) _Pragma("unroll") for (int k = 0; k < 2; ++k) dst[m][k] = *(const PG8_LAS bf16x8*)(lds + PG8_SA(b, h) + aoff + m * 2048 + k * 1024); } while (0)
#define PG8_LDB(dst, b, h) do { _Pragma("unroll") for (int n = 0; n < 2; ++n) _Pragma("unroll") for (int k = 0; k < 2; ++k) dst[n][k] = *(const PG8_LAS bf16x8*)(lds + PG8_SB(b, h) + boff + n * 2048 + k * 1024); } while (0)
#define PG8_MMA(ai, bj, At, Bt) do { __builtin_amdgcn_s_setprio(1); _Pragma("unroll") for (int m = 0; m < 4; ++m) _Pragma("unroll") for (int n = 0; n < 2; ++n) _Pragma("unroll") for (int k = 0; k < 2; ++k) \
        acc[ai][bj][m][n] = __builtin_amdgcn_mfma_f32_16x16x32_bf16(Bt[n][k], At[m][k], acc[ai][bj][m][n], 0, 0, 0); __builtin_amdgcn_s_setprio(0); } while (0)
#define PG8_WAIT_V(n) asm volatile("s_waitcnt vmcnt(" #n ")" ::: "memory")
#define PG8_WAIT_L(n) asm volatile("s_waitcnt lgkmcnt(" #n ")" ::: "memory")
#define PG8_BAR __builtin_amdgcn_s_barrier()
#define PG8_SCHED __builtin_amdgcn_sched_barrier(0)
    Unit cur, nxt; int ui = 0;
    if (!S.next(0, cur)) return;
    f32x4 acc[2][2][4][2];
#pragma unroll
    for (int a = 0; a < 2; ++a)
#pragma unroll
        for (int b = 0; b < 2; ++b)
#pragma unroll
            for (int m = 0; m < 4; ++m)
#pragma unroll
                for (int n = 0; n < 2; ++n) acc[a][b][m][n] = (f32x4){0.f, 0.f, 0.f, 0.f};
    bf16x8 At[4][2], B0[2][2], B1[2][2];
    const char* cA = (const char*)g.A + (size_t)cur.pm * tstepA; const char* cB = (const char*)g.Bt + (size_t)cur.pn * tstepA;
    S.a_ready(cur);
    if constexpr (SP2) {
        PG8_STAGE(PG8_SB(0, 0), cB, voffB); PG8_STAGE(PG8_SB(0, 1), cB + hstepA, voffB); PG8_STAGE(PG8_SA(0, 0), cA, voffA); PG8_STAGE(PG8_SA(0, 1), cA + hstepA, voffA);
        if (wr == 1) PG8_BAR;
        PG8_WAIT_V(2); PG8_BAR;
        PG8_STAGE(PG8_SB(1, 0), cB + kstepA, voffB); PG8_STAGE(PG8_SA(1, 0), cA + kstepA, voffA); PG8_STAGE(PG8_SB(1, 1), cB + hstepA + kstepA, voffB);
        PG8_WAIT_V(6); PG8_BAR;
    } else {
        PG8_STAGE(PG8_SB(0, 0), cB, voffB); PG8_STAGE(PG8_SA(0, 0), cA, voffA); PG8_STAGE(PG8_SB(0, 1), cB + hstepA, voffB); PG8_STAGE(PG8_SA(0, 1), cA + hstepA, voffA);
        if (wr == 1) PG8_BAR;
        PG8_WAIT_V(4); PG8_BAR;
        PG8_STAGE(PG8_SB(1, 0), cB + kstepA, voffB); PG8_STAGE(PG8_SA(1, 0), cA + kstepA, voffA); PG8_STAGE(PG8_SB(1, 1), cB + hstepA + kstepA, voffB);
        PG8_WAIT_V(6); PG8_BAR;
    }
    for (;;) {
        const bool has_next = S.next(ui + 1, nxt);
        const char* nA = has_next ? (const char*)g.A + (size_t)nxt.pm * tstepA : cA; const char* nB = has_next ? (const char*)g.Bt + (size_t)nxt.pn * tstepA : cB;
        for (int t = 0; t < nt; t += 2) {
            const bool last = (t == nt - 2);
            const char* a1 = cA + (size_t)(t + 1) * kstepA;
            const char* a2 = last ? nA : cA + (size_t)(t + 2) * kstepA; const char* b2 = last ? nB : cB + (size_t)(t + 2) * kstepA;
            const char* a3 = a2 + kstepA; const char* b3 = b2 + kstepA;
            if (last && has_next) S.a_ready(nxt);
            if constexpr (SP2) {
            PG8_LDB(B0, 0, 0); PG8_LDB(B1, 0, 1); PG8_SCHED; PG8_LDA(At, 0, 0); PG8_STAGE(PG8_SA(1, 1), a1 + hstepA, voffA);
            PG8_WAIT_V(8); PG8_WAIT_L(0); PG8_BAR; PG8_MMA(0, 0, At, B0); PG8_MMA(0, 1, At, B1); PG8_BAR; PG8_SCHED;
            PG8_LDA(At, 0, 1); PG8_STAGE(PG8_SB(0, 0), b2, voffB); PG8_STAGE(PG8_SB(0, 1), b2 + hstepA, voffB); PG8_STAGE(PG8_SA(0, 0), a2, voffA);
            PG8_WAIT_V(8); PG8_WAIT_L(0); PG8_BAR; PG8_MMA(1, 0, At, B0); PG8_MMA(1, 1, At, B1); PG8_BAR; PG8_SCHED;
            PG8_LDB(B0, 1, 0); PG8_LDB(B1, 1, 1); PG8_SCHED; PG8_LDA(At, 1, 0); PG8_STAGE(PG8_SA(0, 1), a2 + hstepA, voffA);
            PG8_WAIT_V(8); PG8_WAIT_L(0); PG8_BAR; PG8_MMA(0, 0, At, B0); PG8_MMA(0, 1, At, B1); PG8_BAR; PG8_SCHED;
            PG8_LDA(At, 1, 1); PG8_STAGE(PG8_SB(1, 0), b3, voffB); PG8_STAGE(PG8_SB(1, 1), b3 + hstepA, voffB); PG8_STAGE(PG8_SA(1, 0), a3, voffA);
            PG8_WAIT_V(8); PG8_WAIT_L(0); PG8_BAR; PG8_MMA(1, 0, At, B0); PG8_MMA(1, 1, At, B1); PG8_BAR; PG8_SCHED;
            } else {
            PG8_LDB(B0, 0, 0); PG8_SCHED; PG8_LDA(At, 0, 0); PG8_STAGE(PG8_SA(1, 1), a1 + hstepA, voffA);
            PG8_WAIT_L(8); PG8_BAR; PG8_WAIT_L(0); PG8_MMA(0, 0, At, B0); PG8_BAR; PG8_SCHED;
            PG8_LDB(B1, 0, 1); PG8_STAGE(PG8_SB(0, 0), b2, voffB);
            PG8_BAR; PG8_WAIT_L(0); PG8_MMA(0, 1, At, B1); PG8_BAR;
            PG8_LDA(At, 0, 1); PG8_STAGE(PG8_SA(0, 0), a2, voffA);
            PG8_BAR; PG8_WAIT_L(0); PG8_MMA(1, 0, At, B0); PG8_BAR; PG8_SCHED;
            PG8_STAGE(PG8_SB(0, 1), b2 + hstepA, voffB);
            PG8_WAIT_V(6); PG8_BAR; PG8_MMA(1, 1, At, B1); PG8_BAR;
            PG8_LDB(B0, 1, 0); PG8_SCHED; PG8_LDA(At, 1, 0); PG8_STAGE(PG8_SA(0, 1), a2 + hstepA, voffA);
            PG8_WAIT_L(8); PG8_BAR; PG8_WAIT_L(0); PG8_MMA(0, 0, At, B0); PG8_BAR; PG8_SCHED;
            PG8_LDB(B1, 1, 1); PG8_STAGE(PG8_SB(1, 0), b3, voffB);
            PG8_BAR; PG8_WAIT_L(0); PG8_MMA(0, 1, At, B1); PG8_BAR;
            PG8_LDA(At, 1, 1); PG8_STAGE(PG8_SA(1, 0), a3, voffA);
            PG8_BAR; PG8_WAIT_L(0); PG8_MMA(1, 0, At, B0); PG8_BAR; PG8_SCHED;
            PG8_STAGE(PG8_SB(1, 1), b3 + hstepA, voffB);
            PG8_WAIT_V(6); PG8_BAR; PG8_MMA(1, 1, At, B1); PG8_BAR;
            }
        }
        if constexpr (ALIGN_EPI) { if (wr == 0) PG8_BAR; }
        if constexpr (!Epi::AFTER_DRAIN) { E(acc, cur, wr, wc, fr, fq); S.done(cur); }
        if (!has_next) break;
#pragma unroll
        for (int a = 0; a < 2; ++a)
#pragma unroll
            for (int b = 0; b < 2; ++b)
#pragma unroll
                for (int m = 0; m < 4; ++m)
#pragma unroll
                    for (int n = 0; n < 2; ++n) acc[a][b][m][n] = (f32x4){0.f, 0.f, 0.f, 0.f};
        cur = nxt; cA = nA; cB = nB; ++ui;
        if constexpr (ALIGN_EPI) { if (wr == 1) PG8_BAR; }
    }
    PG8_WAIT_V(0);
    if constexpr (!ALIGN_EPI) { if (wr == 0) PG8_BAR; }
    PG8_BAR;
    if constexpr (Epi::AFTER_DRAIN) { E.fused(acc, cur, wr, wc, fr, fq, lds, wid, lane); S.done(cur); }
#undef PG8_SA
#undef PG8_SB
#undef PG8_STAGE
#undef PG8_LDA
#undef PG8_LDB
#undef PG8_MMA
#undef PG8_WAIT_V
#undef PG8_WAIT_L
#undef PG8_BAR
#undef PG8_SCHED
}
}
constexpr int DM = 1024, SEQ = 16384, NB = 2, CTXL = 256, FF = 2816, NMOD = 9;
constexpr int ML = NB * SEQ, MC = NB * CTXL, MT = ML + MC;
constexpr int NH = 4, HD = 128, MW = 512, GW = 64, GRID_ROWS = SEQ / GW;
constexpr int NTB = 130;
constexpr float EPS = 1e-6f;
constexpr int NWAVES = 8, NTHREADS = 512;

constexpr size_t MiB = 1u << 20, KiB = 1024;
constexpr size_t WS_CTL = 0;
constexpr size_t WS_MOD = 1 * MiB;
constexpr size_t WS_WQT = 1 * MiB + 256 * KiB;
constexpr size_t WS_WKT = 1 * MiB + 512 * KiB;
constexpr size_t WS_MLOC = 1 * MiB + 768 * KiB;
constexpr size_t WS_G = WS_MLOC + 16 * KiB;
constexpr size_t WS_MIN = WS_G + 16 * KiB;
constexpr size_t WS_CN = 2 * MiB;
constexpr size_t WS_NIN = 3 * MiB + 256 * KiB;
constexpr size_t WS_GATES = 5 * MiB;
constexpr size_t WS_W1 = 8 * MiB;
constexpr size_t WS_W2 = 30 * MiB;
constexpr size_t WS_WIN = 41 * MiB;
constexpr size_t WS_WOUT = 46 * MiB;
constexpr size_t WS_Y = 48 * MiB;
constexpr size_t WS_Z = 113 * MiB;
constexpr size_t WS_CKV = 48 * MiB;
constexpr size_t WS_H = 178 * MiB;
constexpr size_t WS_P = 178 * MiB;
constexpr size_t WS_Q = 308 * MiB;
constexpr size_t WS_K = WS_Q + (size_t)MT * 512 * 2;
constexpr size_t WS_CIN = 113 * MiB;
constexpr size_t WS_XB = 373 * MiB;
constexpr size_t WS_MIX = 437 * MiB;
constexpr size_t WS_GB = 501 * MiB;
constexpr size_t WS_END = 505 * MiB;
static_assert(WS_K + (size_t)MT * 512 * 2 <= WS_XB && WS_XB + (size_t)ML * 1024 * 2 <= WS_MIX && WS_CIN + (size_t)16 * 128 * 32768 <= WS_H && WS_Z + (size_t)MT * 1024 * 2 <= WS_H && WS_CKV + (size_t)16 * 130 * 65536 <= WS_H && WS_P + (size_t)MT * 2048 * 2 <= WS_Q, "ws map");
static_assert(WS_GATES + (size_t)MT * 64 <= WS_W1 && WS_NIN + 16 * 130 * 512 <= WS_GATES && WS_CN + 16 * 130 * 512 <= WS_NIN, "ws map small");
constexpr size_t CTL_ZERO_BYTES = 64 * KiB;
constexpr int CTXCNT_WORD = 8192;

constexpr int LDS_BYTES = 160 * 1024;

#define LAS __attribute__((address_space(3)))
typedef unsigned short bf16;
typedef short bf16x8 __attribute__((ext_vector_type(8)));
typedef float f32x4 __attribute__((ext_vector_type(4)));
typedef float f32x2v __attribute__((ext_vector_type(2)));
typedef unsigned u32x4 __attribute__((ext_vector_type(4)));
typedef unsigned u32x2 __attribute__((ext_vector_type(2)));
#define LDS_WAIT() asm volatile("s_waitcnt lgkmcnt(0)" ::: "memory")
#define LDS_BARRIER() do { asm volatile("s_waitcnt lgkmcnt(0)" ::: "memory"); __builtin_amdgcn_s_barrier(); asm volatile("" ::: "memory"); } while (0)

__device__ __forceinline__ unsigned f2bf(float f) { unsigned u = __builtin_bit_cast(unsigned, f); return (u + 0x7fffu + ((u >> 16) & 1u)) >> 16; }
typedef float f32x2c_t __attribute__((ext_vector_type(2))); typedef __bf16 bf16x2c_t __attribute__((ext_vector_type(2)));
__device__ __forceinline__ unsigned pk2(float lo, float hi) { const f32x2c_t v = {lo, hi}; const bf16x2c_t b = __builtin_convertvector(v, bf16x2c_t); return __builtin_bit_cast(unsigned, b); }
__device__ __forceinline__ float bflo(unsigned w) { return __uint_as_float(w << 16); }
__device__ __forceinline__ float bfhi(unsigned w) { return __uint_as_float(w & 0xffff0000u); }
__device__ __forceinline__ float wave_sum(float v) {
#pragma unroll
    for (int o = 1; o < 64; o <<= 1) v += __shfl_xor(v, o);
    return v;
}
__device__ __forceinline__ float wave_max(float v) {
#pragma unroll
    for (int o = 1; o < 64; o <<= 1) v = fmaxf(v, __shfl_xor(v, o));
    return v;
}
__device__ __forceinline__ float log_sigmoid(float x) { return fminf(x, 0.f) - log1pf(expf(-fabsf(x))); }
__device__ __forceinline__ f32x4 mfma16(bf16x8 a, bf16x8 b, f32x4 c) { return __builtin_amdgcn_mfma_f32_16x16x32_bf16(a, b, c, 0, 0, 0); }

__device__ __forceinline__ unsigned opaque(unsigned x) { asm volatile("" : "+v"(x)); return x; }
template <class T> __device__ __forceinline__ T ldg(const void* ubase, unsigned boff) { return *(const T*)((const char*)ubase + boff); }
template <class T> __device__ __forceinline__ void stg(void* ubase, unsigned boff, T v) { *(T*)((char*)ubase + boff) = v; }

struct Args { const float* in[21]; float* out; unsigned char* ws; int ph_lo, ph_hi, probe, pad; };

struct Ctx {
    LAS unsigned char* lds;
    int tid, lane, wave, G, bid, probe;
    const float *x, *c, *ctx, *cctx, *wmod, *bmod, *npre, *npost, *fwin, *fwout, *win, *wout, *convw, *convb, *wq, *wk, *ibias, *fbias, *hnorm, *poolw, *pscale;
    float* out; unsigned char* ws;
    float* mod; bf16 *wqt, *wkt; float *mloc, *gsum, *min_, *cn, *nin, *gates, *gb;
    bf16 *W1, *W2, *WIN, *WOUT, *Y, *Z, *H, *P, *Q, *K, *CIN, *MIX, *CKV, *XB;
};

constexpr int TP0_SCR = 16384;
constexpr int P0_SC_OFF = 131072, P0_RED_OFF = 131072 + 12288;

template <bool TILED>
__device__ __forceinline__ void tr_store(LAS float* scr, bf16* WT, int K, int n0, int k0, int lane) {
    const int c = lane & 7;
#pragma unroll
    for (int j = 0; j < 4; ++j) { const int n = (lane >> 3) + 8 * j; const LAS float* s = scr + (8 * c) * 33 + n;
        u32x4 o; o.x = pk2(s[0 * 33], s[1 * 33]); o.y = pk2(s[2 * 33], s[3 * 33]); o.z = pk2(s[4 * 33], s[5 * 33]); o.w = pk2(s[6 * 33], s[7 * 33]);
        const int nn = n0 + n;
        if (TILED) *(u32x4*)(WT + ((size_t)(nn >> 8) * (K >> 6) + (k0 >> 6)) * (256 * 64) + (size_t)(nn & 255) * 64 + 8 * c) = o;
        else *(u32x4*)(WT + (size_t)nn * K + k0 + 8 * c) = o; }
}
template <bool TILED>
__device__ __forceinline__ void tr_item(const float* W, int ldw, bf16* WT, int K, int n0, int srccol, int k0, LAS float* scr, int lane) {
    float tv[32]; const int sc_ = (srccol >= 0) ? srccol : 0;
#pragma unroll
    for (int i = 0; i < 32; ++i) tv[i] = W[(size_t)(k0 + 2 * i + (lane >> 5)) * ldw + sc_];
#pragma unroll
    for (int i = 0; i < 32; ++i) scr[(2 * i + (lane >> 5)) * 33 + (lane & 31)] = (srccol >= 0) ? tv[i] : 0.f;
    LDS_WAIT(); asm volatile("" ::: "memory");
    tr_store<TILED>(scr, WT, K, n0, k0, lane);
    LDS_WAIT(); asm volatile("" ::: "memory");
}

constexpr int IT_W1 = 16 * 176, IT_W2 = 44 * 32, IT_WIN = 16 * 72, IT_WO = 8 * 32, IT_WE = 8 * 32, IT_QK = 8;
constexpr int IT_TOTAL = 2 * IT_W1 + 2 * IT_W2 + IT_WIN + IT_WO + IT_WE + 8 * IT_QK;

__device__ __forceinline__ void p0_wave_item(const Ctx& F, int it, LAS float* scr) {
    const int lane = F.lane, ln = lane & 31;
    int r = it;
    if (r < 2 * IT_W1) { const int f = r / IT_W1; r -= f * IT_W1; const int kb = r / 176, nb = r % 176, n0 = 32 * nb, pn = n0 >> 8, i = (n0 & 255) + ln;
        const int src = (i < 128) ? 128 * pn + i : FF + 128 * pn + (i - 128);
        tr_item<true>(F.fwin + (size_t)f * DM * 2 * FF, 2 * FF, F.W1 + (size_t)f * 2 * FF * DM, DM, n0, src, 64 * kb, scr, lane); return; }
    r -= 2 * IT_W1;
    if (r < 2 * IT_W2) { const int f = r / IT_W2; r -= f * IT_W2; const int kb = r / 32, nb = r % 32;
        tr_item<true>(F.fwout + (size_t)f * FF * DM, DM, F.W2 + (size_t)f * DM * FF, FF, 32 * nb, 32 * nb + ln, 64 * kb, scr, lane); return; }
    r -= 2 * IT_W2;
    if (r < IT_WIN) { const int kb = r / 72, nb = r % 72, n = 32 * nb + ln;
        const int src = (n < 1536) ? n : (n < 2048) ? n + 16 : (n < 2064) ? n - 512 : -1;
        tr_item<true>(F.win, 2064, F.WIN, DM, 32 * nb, src, 64 * kb, scr, lane); return; }
    r -= IT_WIN;
    if (r < IT_WO) { const int kb = r / 32, nb = r % 32;
        tr_item<true>(F.wout, DM, F.WOUT, DM, 32 * nb, 32 * nb + ln, 64 * kb, scr, lane); return; }
    r -= IT_WO;
    if (r < IT_WE) { const int kb = r / 32, nb = r % 32, g = kb >> 1, kk0 = 64 * (kb & 1), n0 = 32 * nb, fr = lane & 15, fq = lane >> 4;
        const float* pw = F.poolw + (size_t)g * 128 * 128 + (size_t)(kk0 + fr) * 128; const float* ps = F.pscale + g * 128; const float* wo = F.wout + (size_t)(512 + g * 128) * DM + n0 + fr;
        f32x4 acc[4][2];
#pragma unroll
        for (int mt = 0; mt < 4; ++mt) { acc[mt][0] = (f32x4){0.f, 0.f, 0.f, 0.f}; acc[mt][1] = acc[mt][0]; }
#pragma unroll 4
        for (int ks = 0; ks < 32; ++ks) { const int e = 4 * ks + fq; const float pse = ps[e]; const float b0 = wo[(size_t)e * DM], b1 = wo[(size_t)e * DM + 16];
#pragma unroll
            for (int mt = 0; mt < 4; ++mt) { const float a = pw[(size_t)(16 * mt) * 128 + e] * pse;
                acc[mt][0] = __builtin_amdgcn_mfma_f32_16x16x4f32(a, b0, acc[mt][0], 0, 0, 0); acc[mt][1] = __builtin_amdgcn_mfma_f32_16x16x4f32(a, b1, acc[mt][1], 0, 0, 0); } }
#pragma unroll
        for (int mt = 0; mt < 4; ++mt)
#pragma unroll
            for (int nt = 0; nt < 2; ++nt)
#pragma unroll
                for (int e = 0; e < 4; ++e) scr[(16 * mt + 4 * fq + e) * 33 + 16 * nt + fr] = acc[mt][nt][e];
        LDS_WAIT(); asm volatile("" ::: "memory");
        tr_store<true>(scr, F.WOUT, DM, n0, 512 + 64 * kb, lane);
        LDS_WAIT(); asm volatile("" ::: "memory"); return; }
    r -= IT_WE;
    { const int which = r / (4 * IT_QK); r -= which * 4 * IT_QK; const int h = r / IT_QK; r -= h * IT_QK; const int kb = r / 4, nb = r % 4;
      const float* W = (which ? F.wk : F.wq) + (size_t)h * 128 * 128; bf16* WT = (which ? F.wkt : F.wqt) + (size_t)h * 128 * 128;
      tr_item<false>(W, 128, WT, 128, 32 * nb, 32 * nb + ln, 64 * kb, scr, lane); }
}

__device__ __forceinline__ void p0_prologue(const Ctx& F) {
    LAS float* scl = (LAS float*)(F.lds + P0_SC_OFF); LAS float* red = (LAS float*)(F.lds + P0_RED_OFF);
    for (int j = F.bid; j < 144; j += F.G) {
        for (int i = F.tid; i < 3072; i += NTHREADS) { const int b = i >> 10, k = i & 1023; const float v = (b < 2) ? F.c[b * DM + k] : F.cctx[k]; scl[i] = v / (1.0f + expf(-v)); }
        __syncthreads();
        const int col = 64 * j + F.lane, k0 = 128 * F.wave; float a0 = 0.f, a1 = 0.f, a2 = 0.f;
#pragma unroll 32
        for (int kk = 0; kk < 128; ++kk) { const float wv = F.wmod[(size_t)(k0 + kk) * (NMOD * DM) + col]; a0 += scl[k0 + kk] * wv; a1 += scl[1024 + k0 + kk] * wv; a2 += scl[2048 + k0 + kk] * wv; }
        red[(F.wave * 3 + 0) * 64 + F.lane] = a0; red[(F.wave * 3 + 1) * 64 + F.lane] = a1; red[(F.wave * 3 + 2) * 64 + F.lane] = a2;
        __syncthreads();
        if (F.tid < 192) { const int b = F.tid >> 6, l = F.tid & 63; float s = 0.f;
#pragma unroll
            for (int w = 0; w < 8; ++w) s += red[(w * 3 + b) * 64 + l];
            F.mod[b * (NMOD * DM) + 64 * j + l] = s + F.bmod[64 * j + l]; }
        __syncthreads();
    }
}
constexpr int IT_PART0 = IT_W1 + IT_W2, IT_PART1 = IT_TOTAL - IT_PART0;
__device__ __forceinline__ void convert_items(const Ctx& F, int part, int first_block, int nblocks, int idx_lo = 0, int idx_hi = 1 << 30) {
    if (F.bid < first_block || F.bid >= first_block + nblocks) return;
    LAS float* scr = (LAS float*)(F.lds + F.wave * TP0_SCR);
    const int gw = (F.bid - first_block) * NWAVES + F.wave, NGW = nblocks * NWAVES, n = min(part ? IT_PART1 : IT_PART0, idx_hi);
    for (int idx = idx_lo + gw; idx < n; idx += NGW) {
        int it;
        if (part == 0) it = (idx < IT_W1) ? idx : 2 * IT_W1 + (idx - IT_W1);
        else it = (idx < IT_W1) ? IT_W1 + idx : (idx < IT_W1 + IT_W2) ? 2 * IT_W1 + IT_W2 + (idx - IT_W1) : 2 * IT_W1 + 2 * IT_W2 + (idx - IT_W1 - IT_W2);
        p0_wave_item(F, it, scr); }
}

__device__ __forceinline__ void ld_row_f32(const float* row, int lane, f32x4 (&v)[4]) {
    v[0] = *(const f32x4*)(row + 8 * lane); v[1] = *(const f32x4*)(row + 8 * lane + 4); v[2] = *(const f32x4*)(row + 512 + 8 * lane); v[3] = *(const f32x4*)(row + 512 + 8 * lane + 4); }
__device__ __forceinline__ void st_row_f32(float* row, int lane, const f32x4 (&v)[4]) {
    *(f32x4*)(row + 8 * lane) = v[0]; *(f32x4*)(row + 8 * lane + 4) = v[1]; *(f32x4*)(row + 512 + 8 * lane) = v[2]; *(f32x4*)(row + 512 + 8 * lane + 4) = v[3]; }
__device__ __forceinline__ void unpack_row(const u32x4 (&w)[2], f32x4 (&v)[4]) {
#pragma unroll
    for (int h = 0; h < 2; ++h) { v[2 * h] = (f32x4){bflo(w[h].x), bfhi(w[h].x), bflo(w[h].y), bfhi(w[h].y)}; v[2 * h + 1] = (f32x4){bflo(w[h].z), bfhi(w[h].z), bflo(w[h].w), bfhi(w[h].w)}; } }
__device__ __forceinline__ void st_row_bf16(bf16* row, int lane, const f32x4 (&v)[4]) {
#pragma unroll
    for (int h = 0; h < 2; ++h) { u32x4 w; w.x = pk2(v[2 * h].x, v[2 * h].y); w.y = pk2(v[2 * h].z, v[2 * h].w); w.z = pk2(v[2 * h + 1].x, v[2 * h + 1].y); w.w = pk2(v[2 * h + 1].z, v[2 * h + 1].w);
        *(u32x4*)(row + 512 * h + 8 * lane) = w; } }
__device__ __forceinline__ float sumsq_row(const f32x4 (&v)[4]) { float ss = 0.f;
#pragma unroll
    for (int j = 0; j < 4; ++j) ss += (v[j].x * v[j].x + v[j].y * v[j].y) + (v[j].z * v[j].z + v[j].w * v[j].w);
    return ss; }
template <bool HAS_Z, int XSRC, int XDST, bool WRITE_Y>
__device__ __forceinline__ void row_phase(const Ctx& F, int nrows, float resw, int jsub) {
    const int gw = F.bid * NWAVES + F.wave, NGW = F.G * NWAVES, lane = F.lane;
    constexpr int NR = 2;
#pragma unroll 1
    for (int seg = 0; seg < 3; ++seg) {
        const int s_lo = (seg < 2) ? seg * SEQ : ML, s_hi = min((seg < 2) ? (seg + 1) * SEQ : MT, nrows);
        if (s_lo + gw >= s_hi) continue;
        const int mb = seg;
        f32x4 gv[4], sv[4], cv[4];
        if (HAS_Z) { const int js = jsub - 1; f32x4 ga[4], gg[4];
            ld_row_f32(F.mod + (size_t)mb * (NMOD * DM) + (3 * js + 2) * DM, lane, ga); ld_row_f32(F.npost + js * DM, lane, gg);
#pragma unroll
            for (int j = 0; j < 4; ++j) gv[j] = ga[j] * gg[j] * resw; }
        if (WRITE_Y) { const float* sh = F.mod + (size_t)mb * (NMOD * DM) + (3 * jsub) * DM; f32x4 c4[4], g4[4];
            ld_row_f32(sh, lane, sv); ld_row_f32(sh + DM, lane, c4); ld_row_f32(F.npre + jsub * DM, lane, g4);
#pragma unroll
            for (int j = 0; j < 4; ++j) cv[j] = g4[j] * (c4[j] + 1.0f); }
#pragma unroll 1
        for (int r0 = s_lo + gw; r0 < s_hi; r0 += NR * NGW) {
            int rws[NR]; bool okr[NR]; f32x4 v[NR][4]; u32x4 xw[NR][2], zw[NR][2];
#pragma unroll
            for (int q = 0; q < NR; ++q) { const int r = r0 + q * NGW; okr[q] = r < s_hi; rws[q] = okr[q] ? r : r0; }
#pragma unroll
            for (int q = 0; q < NR; ++q) {
                if (XSRC == 0) ld_row_f32((rws[q] < ML) ? F.x + (size_t)rws[q] * DM : F.ctx + (size_t)(rws[q] - ML) * DM, lane, v[q]);
                else { xw[q][0] = *(const u32x4*)(F.XB + (size_t)rws[q] * DM + 8 * lane); xw[q][1] = *(const u32x4*)(F.XB + (size_t)rws[q] * DM + 512 + 8 * lane); }
                if (HAS_Z) { zw[q][0] = *(const u32x4*)(F.Z + (size_t)rws[q] * DM + 8 * lane); zw[q][1] = *(const u32x4*)(F.Z + (size_t)rws[q] * DM + 512 + 8 * lane); } }
#pragma unroll
            for (int q = 0; q < NR; ++q) { const int r = rws[q];
                if (XSRC == 1) unpack_row(xw[q], v[q]);
                if (HAS_Z) {
                    f32x4 z[4]; unpack_row(zw[q], z);
                    const float rz = rsqrtf(wave_sum(sumsq_row(z)) * (1.0f / DM) + EPS);
#pragma unroll
                    for (int j = 0; j < 4; ++j) v[q][j] = v[q][j] + (z[j] * rz) * gv[j];
                    if (XDST == 1 && r < ML && okr[q]) st_row_bf16(F.XB + (size_t)r * DM, lane, v[q]);
                    if (XDST == 2 && okr[q]) st_row_f32(F.out + (size_t)r * DM, lane, v[q]);
                }
                if (WRITE_Y) {
                    const float rr = rsqrtf(wave_sum(sumsq_row(v[q])) * (1.0f / DM) + EPS); f32x4 y[4];
#pragma unroll
                    for (int j = 0; j < 4; ++j) y[j] = (v[q][j] * rr) * cv[j] + sv[j];
                    if (okr[q]) {
                        bf16* yt = F.Y + (size_t)(r >> 8) * (256 * DM) + (size_t)(r & 255) * 64 + (size_t)(lane >> 3) * (256 * 64) + 8 * (lane & 7);
#pragma unroll
                        for (int h = 0; h < 2; ++h) { u32x4 w; w.x = pk2(y[2 * h].x, y[2 * h].y); w.y = pk2(y[2 * h].z, y[2 * h].w); w.z = pk2(y[2 * h + 1].x, y[2 * h + 1].y); w.w = pk2(y[2 * h + 1].z, y[2 * h + 1].w);
                            *(u32x4*)(yt + (size_t)h * 8 * (256 * 64)) = w; } }
                }
            }
        }
    }
}

constexpr int TP = 272, TILE_B = 128 * TP;
__device__ __forceinline__ bf16x8 ldfrag(LAS unsigned char* tile, int row, int kk, int fq) { return *(const LAS bf16x8*)(tile + row * TP + (32 * kk + 8 * fq) * 2); }
__device__ __forceinline__ void st4(LAS unsigned char* tile, int row, int col, float a, float b, float c, float d) { u32x2 w; w.x = pk2(a, b); w.y = pk2(c, d); *(LAS u32x2*)(tile + row * TP + col * 2) = w; }
__device__ __forceinline__ bf16x8 ident_frag(int nt, int fr, int fq) { const int jj = 16 * (nt & 1) + fr - 8 * fq; bf16x8 f;
#pragma unroll
    for (int j = 0; j < 8; ++j) f[j] = (j == jj) ? (short)0x3F80 : (short)0;
    return f; }
constexpr float LOG2E = 1.4426950408889634f, LN2 = 0.6931471805599453f;
__device__ __forceinline__ float fexp(float x) { return __builtin_amdgcn_exp2f(x * LOG2E); }
__device__ __forceinline__ float fsigmoid(float x) { return __builtin_amdgcn_rcpf(1.0f + fexp(-x)); }
__device__ __forceinline__ float flog_sigmoid(float x) { return fminf(x, 0.f) - LN2 * __builtin_amdgcn_logf(1.0f + fexp(-fabsf(x))); }
struct GateScan { float ip0, ip1, b0, b1, g; int tau0, tau1; };
__device__ __forceinline__ GateScan gate_scan(const float* gates, int R0, int dir, int h, int lane) {
    GateScan r; r.tau0 = dir ? 127 - 2 * lane : 2 * lane; r.tau1 = dir ? r.tau0 - 1 : r.tau0 + 1;
    const float* gr = gates + (size_t)R0 * 16 + dir * 4 + h;
    r.ip0 = gr[r.tau0 * 16]; r.ip1 = gr[r.tau1 * 16];
    const float lf0 = flog_sigmoid(gr[r.tau0 * 16 + 8]), lf1 = flog_sigmoid(gr[r.tau1 * 16 + 8]);
    const float s = lf0 + lf1; float incl = s;
#pragma unroll
    for (int o = 1; o < 64; o <<= 1) { const float t = __shfl_up(incl, o); if (lane >= o) incl += t; }
    r.b0 = incl - s + lf0; r.b1 = incl; r.g = __shfl(incl, 63);
    return r;
}
__device__ __forceinline__ void make_vt(const bf16* vrow  , LAS unsigned char* VT, int w, int fr, int fq) {
#pragma unroll
    for (int nt = 0; nt < 8; ++nt) { const bf16x8 vf = *(const bf16x8*)(vrow + 32 * (nt >> 1) + 8 * fq);
        const f32x4 a = mfma16(vf, ident_frag(nt, fr, fq), (f32x4){0.f, 0.f, 0.f, 0.f});
        st4(VT, 16 * nt + fr, 16 * w + 4 * fq, a[0], a[1], a[2], a[3]); }
}

constexpr int M1_U = 0, M1_KW0 = TILE_B, M1_KW1 = 2 * TILE_B, M1_VT = 3 * TILE_B, M1_WGT = 4 * TILE_B;
constexpr int M1_UNITS = NB * NH * NTB;
struct M1Pre { u32x4 cu[4], pv[4], nx[4]; bf16x8 vf[8]; float gi0, gi1, gf0, gf1; };
__device__ __forceinline__ void m1_geom(int unit, int& bh, int& tb, int& R0, int& t0, int& L) {
    bh = unit & 7; tb = unit >> 3; const int b = bh >> 2; const bool isctx = tb < 2;
    R0 = isctx ? ML + b * CTXL + tb * 128 : b * SEQ + (tb - 2) * 128; t0 = isctx ? tb * 128 : (tb - 2) * 128; L = isctx ? CTXL : SEQ; }
__device__ __forceinline__ void m1_load(const Ctx& F, int unit, M1Pre& P) {
    const int tid = F.tid, lane = F.lane, w = F.wave, fr = lane & 15, fq = lane >> 4;
    int bh, tb, R0, t0, L; m1_geom(unit, bh, tb, R0, t0, L); const int h = bh & 3;
    const bf16* pb = F.P + (size_t)R0 * 2048 + h * 128;
    { const unsigned tau0 = tid >> 4, c8 = (tid & 15) * 8;
#pragma unroll
      for (int it = 0; it < 4; ++it) { const int tau = tau0 + 32 * it; const bool hp = (t0 + tau > 0), hn_ = (t0 + tau < L - 1);
          const unsigned o = opaque((tau * 2048 + c8) * 2); const char* pp = (const char*)pb + o;
          P.cu[it] = *(const u32x4*)pp; P.pv[it] = *(const u32x4*)(hp ? pp - 4096 : pp); P.nx[it] = *(const u32x4*)(hn_ ? pp + 4096 : pp); } }
    { const int dir = w & 1, tau0 = dir ? 127 - 2 * lane : 2 * lane, tau1 = dir ? tau0 - 1 : tau0 + 1;
      const float* gr = F.gates + (size_t)R0 * 16 + dir * 4 + h;
      P.gi0 = gr[tau0 * 16]; P.gi1 = gr[tau1 * 16]; P.gf0 = gr[tau0 * 16 + 8]; P.gf1 = gr[tau1 * 16 + 8]; }
}
__device__ __forceinline__ void m1_load_v(const Ctx& F, int unit, M1Pre& P) {
    const int lane = F.lane, w = F.wave, fr = lane & 15, fq = lane >> 4;
    int bh, tb, R0, t0, L; m1_geom(unit, bh, tb, R0, t0, L); const int h = bh & 3;
    const bf16* pb = F.P + (size_t)R0 * 2048 + h * 128;
    const unsigned o = opaque((fr * 2048 + 512 + 32 * (w >> 1) + 8 * fq) * 2);
#pragma unroll
    for (int tt = 0; tt < 8; ++tt) P.vf[tt] = ldg<bf16x8>(pb + (size_t)16 * tt * 2048, o);
}
__device__ __forceinline__ void m1_phase(const Ctx& F) {
    const int tid = F.tid, lane = F.lane, w = F.wave, fr = lane & 15, fq = lane >> 4;
    LAS unsigned char* U = F.lds + M1_U; LAS unsigned char* VT = F.lds + M1_VT; LAS float* wgt = (LAS float*)(F.lds + M1_WGT);
    int unit = F.bid; if (unit >= M1_UNITS) return;
    const int h = unit & 3;
    bf16x8 wqf[4], wkf[4];
#pragma unroll
    for (int kk = 0; kk < 4; ++kk) { wqf[kk] = *(const bf16x8*)(F.wqt + (size_t)(h * 128 + 16 * w + fr) * 128 + 32 * kk + 8 * fq); wkf[kk] = *(const bf16x8*)(F.wkt + (size_t)(h * 128 + 16 * w + fr) * 128 + 32 * kk + 8 * fq); }
    M1Pre cur; m1_load(F, unit, cur); m1_load_v(F, unit, cur);
    if ((F.G & 7) != 0) return;
#pragma unroll 1
    for (;;) {
        int bh, tb, R0, t0, L; m1_geom(unit, bh, tb, R0, t0, L);
        { const int ch8 = (tid & 15) * 8, ch = h * 128 + ch8;
          f32x4 cw[3][2], cb[2];
#pragma unroll
          for (int jj = 0; jj < 3; ++jj) { cw[jj][0] = *(const f32x4*)(F.convw + jj * MW + ch); cw[jj][1] = *(const f32x4*)(F.convw + jj * MW + ch + 4); }
          cb[0] = *(const f32x4*)(F.convb + ch); cb[1] = *(const f32x4*)(F.convb + ch + 4);
#pragma unroll
          for (int it = 0; it < 4; ++it) { const int tau = (tid >> 4) + 32 * it; const bool hp = (t0 + tau > 0), hn_ = (t0 + tau < L - 1);
            const u32x4 cu = cur.cu[it]; u32x4 pv = cur.pv[it], nx = cur.nx[it];
            pv.x = hp ? pv.x : 0u; pv.y = hp ? pv.y : 0u; pv.z = hp ? pv.z : 0u; pv.w = hp ? pv.w : 0u; nx.x = hn_ ? nx.x : 0u; nx.y = hn_ ? nx.y : 0u; nx.z = hn_ ? nx.z : 0u; nx.w = hn_ ? nx.w : 0u;
            float o[8];
#pragma unroll
            for (int e = 0; e < 8; ++e) { const unsigned wc_ = cu[e >> 1], wp = pv[e >> 1], wn = nx[e >> 1];
                const float xc = (e & 1) ? bfhi(wc_) : bflo(wc_), xp = (e & 1) ? bfhi(wp) : bflo(wp), xn = (e & 1) ? bfhi(wn) : bflo(wn);
                const float val = cb[e >> 2][e & 3] + xp * cw[0][e >> 2][e & 3] + xc * cw[1][e >> 2][e & 3] + xn * cw[2][e >> 2][e & 3];
                o[e] = val * fsigmoid(val); }
            u32x4 ow; ow.x = pk2(o[0], o[1]); ow.y = pk2(o[2], o[3]); ow.z = pk2(o[4], o[5]); ow.w = pk2(o[6], o[7]);
            *(LAS u32x4*)(U + tau * TP + ch8 * 2) = ow; } }
        if (w < 2) { const int dir = w, tau0 = dir ? 127 - 2 * lane : 2 * lane, tau1 = dir ? tau0 - 1 : tau0 + 1;
            const float ip0 = cur.gi0, ip1 = cur.gi1, lf0 = flog_sigmoid(cur.gf0), lf1 = flog_sigmoid(cur.gf1);
            const float s_ = lf0 + lf1; float incl = s_;
#pragma unroll
            for (int o = 1; o < 64; o <<= 1) { const float t = __shfl_up(incl, o); if (lane >= o) incl += t; }
            const float b0 = incl - s_ + lf0, b1 = incl, g = __shfl(incl, 63);
            const float a0 = g - b0 + ip0, a1 = g - b1 + ip1, ml = wave_max(fmaxf(a0, a1));
            wgt[dir * 128 + tau0] = fexp(a0 - ml); wgt[dir * 128 + tau1] = fexp(a1 - ml);
            const int sidx = (bh * 2 + dir) * NTB + tb;
            if (lane == 0) { F.mloc[sidx] = ml; F.gsum[sidx] = g; }
            const float c0 = ip0 - b0, c1 = ip1 - b1;
            float pm = fmaxf(c0, c1);
#pragma unroll
            for (int o = 1; o < 64; o <<= 1) { const float t = __shfl_up(pm, o); if (lane >= o) pm = fmaxf(pm, t); }
            float pmx = __shfl_up(pm, 1); if (lane == 0) pmx = -INFINITY;
            float* gbp = F.gb + (size_t)sidx * 384;
            gbp[tau0] = b0; gbp[tau1] = b1; gbp[128 + tau0] = c0; gbp[128 + tau1] = c1; gbp[256 + tau0] = fmaxf(pmx, c0); gbp[256 + tau1] = pm; }
        const int unext = unit + F.G; const bool has_next = unext < M1_UNITS;
        m1_load(F, has_next ? unext : unit, cur);
        LDS_BARRIER();
        { const bf16x8 idf = ident_frag(w, fr, fq); const float ksc = 0.08838834764831845f;
          bf16* qb = F.Q + (size_t)R0 * 512 + h * 128 + 16 * w; bf16* kb = F.K + (size_t)R0 * 512 + h * 128 + 16 * w;
          const unsigned go = opaque((fr * 512 + 4 * fq) * 2), fb16 = opaque(fr * TP + fq * 16), sb = opaque((16 * w + fr) * TP + 8 * fq);
#pragma unroll
          for (int tt = 0; tt < 8; ++tt) { bf16x8 uf[4];
#pragma unroll
              for (int kk = 0; kk < 4; ++kk) uf[kk] = *(const LAS bf16x8*)(U + fb16 + 16 * tt * TP + 64 * kk);
              f32x4 q = (f32x4){0.f, 0.f, 0.f, 0.f}, k = q, k2 = q;
#pragma unroll
              for (int kk = 0; kk < 4; ++kk) { q = mfma16(wqf[kk], uf[kk], q); k = mfma16(wkf[kk], uf[kk], k); k2 = mfma16(uf[kk], wkf[kk], k2); }
              { u32x2 o; o.x = pk2(q[0], q[1]); o.y = pk2(q[2], q[3]); stg<u32x2>(qb + (size_t)16 * tt * 512, go, o); }
              { u32x2 o; o.x = pk2(k[0] * ksc, k[1] * ksc); o.y = pk2(k[2] * ksc, k[3] * ksc); stg<u32x2>(kb + (size_t)16 * tt * 512, go, o); }
#pragma unroll
              for (int dir = 0; dir < 2; ++dir) { const f32x4 wv = *(const LAS f32x4*)(wgt + dir * 128 + 16 * tt + 4 * fq);
                  u32x2 o; o.x = pk2(k2[0] * ksc * wv[0], k2[1] * ksc * wv[1]); o.y = pk2(k2[2] * ksc * wv[2], k2[3] * ksc * wv[3]);
                  *(LAS u32x2*)(F.lds + (dir ? M1_KW1 : M1_KW0) + sb + 32 * tt) = o; }
              const f32x4 a = mfma16(cur.vf[tt], idf, (f32x4){0.f, 0.f, 0.f, 0.f});
              { u32x2 o; o.x = pk2(a[0], a[1]); o.y = pk2(a[2], a[3]); *(LAS u32x2*)(VT + sb + 32 * tt) = o; } } }
        m1_load_v(F, has_next ? unext : unit, cur);
        LDS_BARRIER();
        { const unsigned fb16 = opaque(fr * TP + fq * 16); bf16x8 vtf[4];
#pragma unroll
          for (int kk = 0; kk < 4; ++kk) vtf[kk] = *(const LAS bf16x8*)(VT + fb16 + 16 * w * TP + 64 * kk);
#pragma unroll
          for (int dir = 0; dir < 2; ++dir) { LAS unsigned char* KW = F.lds + (dir ? M1_KW1 : M1_KW0);
              const int cs = dir ? (tb < 2 ? 1 - tb : 131 - tb) : tb;
              bf16* cg_ = F.CKV + ((size_t)((bh * 2 + dir) * NTB + cs)) * 16384 + (size_t)16 * w * 128;
              const unsigned co = opaque((fr * 128 + 4 * fq) * 2);
              f32x4 acc[8];
#pragma unroll
              for (int mt = 0; mt < 8; ++mt) acc[mt] = (f32x4){0.f, 0.f, 0.f, 0.f};
#pragma unroll
              for (int kk = 0; kk < 4; ++kk) { bf16x8 kf[8];
#pragma unroll
                  for (int mt = 0; mt < 8; ++mt) kf[mt] = *(const LAS bf16x8*)(KW + fb16 + 16 * mt * TP + 64 * kk);
#pragma unroll
                  for (int mt = 0; mt < 8; ++mt) acc[mt] = mfma16(kf[mt], vtf[kk], acc[mt]); }
#pragma unroll
              for (int mt = 0; mt < 8; ++mt) { u32x2 o; o.x = pk2(acc[mt][0], acc[mt][1]); o.y = pk2(acc[mt][2], acc[mt][3]); stg<u32x2>(cg_ + 16 * mt, co, o); } } }
        if (tid < 256) { const int dir = tid >> 7, dk = tid & 127; LAS unsigned char* KW = F.lds + (dir ? M1_KW1 : M1_KW0) + dk * TP; float s_ = 0.f;
#pragma unroll
            for (int c = 0; c < 16; ++c) { const u32x4 q = *(const LAS u32x4*)(KW + 16 * c); s_ += (bflo(q.x) + bfhi(q.x)) + (bflo(q.y) + bfhi(q.y)) + (bflo(q.z) + bfhi(q.z)) + (bflo(q.w) + bfhi(q.w)); }
            const int cs = dir ? (tb < 2 ? 1 - tb : 131 - tb) : tb;
            F.cn[((size_t)((bh * 2 + dir) * NTB + cs)) * 128 + dk] = s_; }
        if (!has_next) break;
        unit = unext;
    }
}

template <int G_>
__device__ __forceinline__ void pool_unit_t(const Ctx& F, int b, int r) {
    constexpr int win = 2 << G_, lo = win >> 1, hi = win - 1 - lo;
    const int tid = F.tid, chunk = tid & 15, cb = tid >> 4;
    const int rlo = max(r - lo, 0), rhi = min(r + hi, GRID_ROWS - 1); const float cntr = (float)(rhi - rlo + 1);
    LAS float* vs = (LAS float*)F.lds;
    const bf16* base = F.P + (size_t)b * SEQ * 2048 + 1536 + G_ * 128;
    const unsigned off = opaque((cb * 2048 + 8 * chunk) * 2);
    f32x4 s[2][2];
#pragma unroll
    for (int k = 0; k < 2; ++k) { s[k][0] = (f32x4){0.f, 0.f, 0.f, 0.f}; s[k][1] = s[k][0]; }
#pragma unroll
    for (int i = 0; i < win; ++i) { const int rr = r - lo + i; const bool ok = (rr >= 0) && (rr < GRID_ROWS); const int rc = min(max(rr, 0), GRID_ROWS - 1);
#pragma unroll
        for (int k = 0; k < 2; ++k) { u32x4 wv = ldg<u32x4>(base + (size_t)(rc * GW + 32 * k) * 2048, off);
            wv.x = ok ? wv.x : 0u; wv.y = ok ? wv.y : 0u; wv.z = ok ? wv.z : 0u; wv.w = ok ? wv.w : 0u;
            s[k][0] = s[k][0] + (f32x4){bflo(wv.x), bfhi(wv.x), bflo(wv.y), bfhi(wv.y)}; s[k][1] = s[k][1] + (f32x4){bflo(wv.z), bfhi(wv.z), bflo(wv.w), bfhi(wv.w)}; } }
    u32x4 ctr[2];
#pragma unroll
    for (int k = 0; k < 2; ++k) { ctr[k] = ldg<u32x4>(base + (size_t)(r * GW + 32 * k) * 2048, off);
        LAS float* vp = vs + (cb + 32 * k) * 128 + 8 * chunk; *(LAS f32x4*)vp = s[k][0]; *(LAS f32x4*)(vp + 4) = s[k][1]; }
    LDS_BARRIER();
#pragma unroll
    for (int k = 0; k < 2; ++k) { const int c = cb + 32 * k, clo = max(c - lo, 0), chi = min(c + hi, GW - 1); f32x4 t0 = (f32x4){0.f, 0.f, 0.f, 0.f}, t1 = t0;
#pragma unroll
        for (int i = 0; i < win; ++i) { const int c2 = c - lo + i; const bool ok = (c2 >= 0) && (c2 < GW); const LAS float* vp = vs + min(max(c2, 0), GW - 1) * 128 + 8 * chunk;
            const f32x4 a0 = *(const LAS f32x4*)vp, a1 = *(const LAS f32x4*)(vp + 4); const float m_ = ok ? 1.f : 0.f; t0 = t0 + a0 * m_; t1 = t1 + a1 * m_; }
        const float inv = 1.0f / (cntr * (float)(chi - clo + 1)); const u32x4 cw = ctr[k];
        u32x4 o; o.x = pk2(t0[0] * inv - bflo(cw.x), t0[1] * inv - bfhi(cw.x)); o.y = pk2(t0[2] * inv - bflo(cw.y), t0[3] * inv - bfhi(cw.y));
        o.z = pk2(t1[0] * inv - bflo(cw.z), t1[1] * inv - bfhi(cw.z)); o.w = pk2(t1[2] * inv - bflo(cw.w), t1[3] * inv - bfhi(cw.w));
        { const int row = b * SEQ + r * GW + c, col = 512 + G_ * 128 + 8 * chunk;
          *(u32x4*)(F.MIX + (size_t)(row >> 8) * (256 * 1024) + (size_t)(col >> 6) * (256 * 64) + (size_t)(row & 255) * 64 + (col & 63)) = o; } }
    LDS_BARRIER();
}
__device__ __forceinline__ void pool_unit(const Ctx& F, int unit) {
    const int k = unit / GRID_ROWS, r = unit % GRID_ROWS, b = k >> 2, g = (r + k) & 3;
    if (g == 0) pool_unit_t<0>(F, b, r); else if (g == 1) pool_unit_t<1>(F, b, r); else if (g == 2) pool_unit_t<2>(F, b, r); else pool_unit_t<3>(F, b, r);
}

__device__ __forceinline__ void scan_phase(const Ctx& F) {
    const int nslots = 16 * 8192;
    LAS float* sg = (LAS float*)F.lds;
    for (int base = F.bid * NTHREADS; base < nslots; base += F.G * NTHREADS) {
        const int slot = base + F.tid, stream = base >> 13, pe = slot & 8191, dir = stream & 1;
        __syncthreads();
        if (F.tid < NTB) { const int c = F.tid, tb = dir ? (c < 2 ? 1 - c : 131 - c) : c; const size_t sidx = (size_t)stream * NTB + tb; sg[c] = F.gsum[sidx]; sg[NTB + c] = F.mloc[sidx]; }
        __syncthreads();
        const long cstep = dir ? -1 : 1; const int tb0 = dir ? 129 : 2;
        if (pe < 64) {
            float n0 = 0.f, n1 = 0.f, m = 0.f;
            const float* cnp = F.cn + (size_t)stream * NTB * 128 + 2 * pe; float* ninp = F.nin + ((size_t)stream * NTB + tb0) * 128 + 2 * pe; float* minp = F.min_ + (size_t)stream * NTB + tb0;
#pragma unroll 1
            for (int c0 = 0; c0 < NTB; c0 += 26) { f32x2v cnv[26];
#pragma unroll
                for (int i = 0; i < 26; ++i) cnv[i] = *(const f32x2v*)(cnp + (size_t)(c0 + i) * 128);
#pragma unroll
                for (int i = 0; i < 26; ++i) { const int c = c0 + i;
                    if (c >= 2) { *(f32x2v*)(ninp + cstep * (long)(c - 2) * 128) = (f32x2v){n0, n1}; if (pe == 0) minp[cstep * (long)(c - 2)] = m; }
                    const float gi = sg[c], mi = sg[NTB + c];
                    const float mn = fmaxf(gi + m, mi), ao = fexp(gi + m - mn), an = fexp(mi - mn);
                    n0 = ao * n0 + an * cnv[i].x; n1 = ao * n1 + an * cnv[i].y; m = mn; } } }
        float C0 = 0.f, C1 = 0.f, m = 0.f;
        const bf16* ckv = F.CKV + (size_t)stream * NTB * 16384 + 2 * pe; bf16* cin = F.CIN + ((size_t)stream * 128 + (tb0 - 2)) * 16384 + 2 * pe;
#pragma unroll 1
        for (int c0 = 0; c0 < NTB; c0 += 26) {
            unsigned ck[26];
#pragma unroll
            for (int i = 0; i < 26; ++i) ck[i] = *(const unsigned*)(ckv + (size_t)(c0 + i) * 16384);
#pragma unroll
            for (int i = 0; i < 26; ++i) { const int c = c0 + i;
                if (c >= 2) *(unsigned*)(cin + cstep * (long)(c - 2) * 16384) = pk2(C0, C1);
                const float gi = sg[c], mi = sg[NTB + c];
                const float mn = fmaxf(gi + m, mi), ao = fexp(gi + m - mn), an = fexp(mi - mn);
                C0 = ao * C0 + an * bflo(ck[i]); C1 = ao * C1 + an * bfhi(ck[i]); m = mn; }
        }
    }
    __syncthreads();
}

constexpr int M3_K = 0, M3_VT = TILE_B, M3_CT0 = 2 * TILE_B, M3_CT1 = 3 * TILE_B, M3_MISC = 4 * TILE_B;
constexpr int M3_UNITS = NB * NH * 128;
struct M3Pre { u32x4 kr[4]; };
__device__ __forceinline__ void m3_decode(int unit, int& bh, int& j) { bh = unit & 7; j = unit >> 3; }
__device__ __forceinline__ void m3_load(const Ctx& F, int unit, M3Pre& P) {
    const int tid = F.tid;
    int bh, j; m3_decode(unit, bh, j); const int h = bh & 3, b = bh >> 2, R0 = b * SEQ + j * 128;
    const bf16* kb = F.K + (size_t)R0 * 512 + h * 128;
    const unsigned row0 = tid >> 4, c8 = (tid & 15) * 8;
    const unsigned ok_ = opaque((row0 * 512 + c8) * 2);
#pragma unroll
    for (int it = 0; it < 4; ++it) P.kr[it] = ldg<u32x4>(kb + (size_t)it * 32 * 512, ok_);
}
__device__ __forceinline__ void m3_phase(const Ctx& F) {
    const int tid = F.tid, lane = F.lane, w = F.wave, fr = lane & 15, fq = lane >> 4;
    LAS unsigned char* Kt = F.lds + M3_K; LAS unsigned char* VT = F.lds + M3_VT;
    LAS float* rt2 = (LAS float*)(F.lds + M3_MISC); LAS float* ct2 = rt2 + 256; LAS float* winter = rt2 + 512; LAS float* minv = rt2 + 768; LAS float* ninl = rt2 + 1024;
    int unit = F.bid; if (unit >= M3_UNITS) return;
    M3Pre cur; m3_load(F, unit, cur);
    const int t = 16 * w + fr;
#pragma unroll 1
    for (;;) {
        int bh, j; m3_decode(unit, bh, j); const int h = bh & 3, b = bh >> 2, R0 = b * SEQ + j * 128;
        bf16x8 qf[4], vr[4];
        { const bf16* vb = F.P + (size_t)R0 * 2048 + 512 + h * 128; const bf16* qb = F.Q + (size_t)R0 * 512 + h * 128; const unsigned tr = opaque(16 * w + fr);
#pragma unroll
          for (int kk = 0; kk < 4; ++kk) { vr[kk] = ldg<bf16x8>(vb, (tr * 2048 + 8 * fq + 32 * kk) * 2); qf[kk] = ldg<bf16x8>(qb, (tr * 512 + 32 * kk + 8 * fq) * 2); } }
        float g_b, g_c, g_pm, g_min, g_nin;
        { const unsigned t2 = tid & 255, dir = t2 >> 7, tau = t2 & 127; const size_t s0 = (size_t)(bh * 2) * NTB + j + 2;
          const unsigned so = opaque(dir * NTB);
          g_b = ldg<float>(F.gb + s0 * 384, (so * 384 + tau) * 4); g_c = ldg<float>(F.gb + s0 * 384, (so * 384 + 128 + tau) * 4); g_pm = ldg<float>(F.gb + s0 * 384, (so * 384 + 256 + tau) * 4);
          g_min = ldg<float>(F.min_ + s0, so * 4); g_nin = ldg<float>(F.nin + s0 * 128, (so * 128 + tau) * 4); }
        u32x4 c0r[4], c1r[4];
        { const bf16* cin0 = F.CIN + ((size_t)(bh * 2 + 0) * 128 + j) * 16384; const bf16* cin1 = F.CIN + ((size_t)(bh * 2 + 1) * 128 + j) * 16384; const unsigned oc_ = opaque(((tid >> 4) * 128 + (tid & 15) * 8) * 2);
#pragma unroll
          for (int it = 0; it < 4; ++it) { c0r[it] = ldg<u32x4>(cin0 + (size_t)it * 32 * 128, oc_); c1r[it] = ldg<u32x4>(cin1 + (size_t)it * 32 * 128, oc_); } }
        LDS_BARRIER();
        { LAS unsigned char* wb = F.lds + opaque((tid >> 4) * TP + (tid & 15) * 16);
#pragma unroll
          for (int it = 0; it < 4; ++it) { *(LAS u32x4*)(wb + M3_K + it * 32 * TP) = cur.kr[it]; *(LAS u32x4*)(wb + M3_CT0 + it * 32 * TP) = c0r[it]; *(LAS u32x4*)(wb + M3_CT1 + it * 32 * TP) = c1r[it]; } }
        { const int fr_o = (int)opaque((unsigned)fr);
#pragma unroll
          for (int nt = 0; nt < 8; ++nt) { const f32x4 a = mfma16(vr[nt >> 1], ident_frag(nt, fr_o, fq), (f32x4){0.f, 0.f, 0.f, 0.f}); st4(VT, 16 * nt + fr_o, 16 * w + 4 * fq, a[0], a[1], a[2], a[3]); } }
        if (tid < 256) { const float mt_ = g_b + fmaxf(g_pm, g_min); LAS float* mb = (LAS float*)(F.lds + M3_MISC + opaque(tid * 4));
            mb[1024] = g_nin; mb[0] = (g_b - mt_) * LOG2E; mb[256] = g_c * LOG2E; mb[512] = fexp(g_b + g_min - mt_); mb[768] = fexp(-mt_); }
        const int unext = unit + F.G; const bool has_next = unext < M3_UNITS;
        m3_load(F, has_next ? unext : unit, cur);
        LDS_BARRIER();
        const unsigned fb16 = opaque(fr * TP + fq * 16), fb8 = opaque(fr * TP + fq * 8);
        const int dlt = (int)opaque((unsigned)(t - 4 * fq));
        f32x4 acc[8];
#pragma unroll
        for (int mt = 0; mt < 8; ++mt) acc[mt] = (f32x4){0.f, 0.f, 0.f, 0.f};
#pragma unroll
        for (int kk = 0; kk < 4; ++kk) { bf16x8 kf[8];
#pragma unroll
            for (int mt = 0; mt < 8; ++mt) kf[mt] = *(const LAS bf16x8*)(Kt + fb16 + 16 * mt * TP + 64 * kk);
#pragma unroll
            for (int mt = 0; mt < 8; ++mt) acc[mt] = mfma16(kf[mt], qf[kk], acc[mt]); }
        u32x2 sp[2][8]; float wi2[2], rdn[2];
#pragma unroll
        for (int dir = 0; dir < 2; ++dir) {
            const float rt = rt2[dir * 128 + t], wi = winter[dir * 128 + t], mi = minv[dir * 128 + t];
            const int sgn = dir ? -1 : 1, dl2 = (int)opaque((unsigned)(sgn * dlt));
            float dsum = 0.f;
#pragma unroll
            for (int mt = 0; mt < 8; ++mt) { const f32x4 ct = *(const LAS f32x4*)(ct2 + dir * 128 + 16 * mt + 4 * fq); float o[4];
#pragma unroll
                for (int e = 0; e < 4; ++e) { const bool ok = sgn * (16 * mt + e) <= dl2; o[e] = ok ? acc[mt][e] * __builtin_amdgcn_exp2f(rt + ct[e]) : 0.f; dsum += o[e]; }
                sp[dir][mt].x = pk2(o[0], o[1]); sp[dir][mt].y = pk2(o[2], o[3]); }
            dsum += __shfl_xor(dsum, 16); dsum += __shfl_xor(dsum, 32);
            float qn = 0.f;
#pragma unroll
            for (int kk = 0; kk < 4; ++kk)
#pragma unroll
                for (int e = 0; e < 8; ++e) qn += __uint_as_float(((unsigned)(unsigned short)qf[kk][e]) << 16) * ninl[dir * 128 + 32 * kk + 8 * fq + e];
            qn += __shfl_xor(qn, 16); qn += __shfl_xor(qn, 32);
            const float den = wi * qn + dsum; wi2[dir] = wi; rdn[dir] = 1.0f / fmaxf(fabsf(den), mi); }
        f32x4 Hs[8];
#pragma unroll
        for (int mt = 0; mt < 8; ++mt) Hs[mt] = (f32x4){0.f, 0.f, 0.f, 0.f};
#pragma unroll
        for (int dir = 0; dir < 2; ++dir) {
            LAS unsigned char* CT = F.lds + (dir ? M3_CT1 : M3_CT0);
#pragma unroll
            for (int mt = 0; mt < 8; ++mt) acc[mt] = (f32x4){0.f, 0.f, 0.f, 0.f};
#pragma unroll
            for (int kk = 0; kk < 4; ++kk) { bf16x8 cf[8];
#pragma unroll
                for (int mt = 0; mt < 8; ++mt) cf[mt] = *(const LAS bf16x8*)(CT + fb16 + 16 * mt * TP + 64 * kk);
#pragma unroll
                for (int mt = 0; mt < 8; ++mt) acc[mt] = mfma16(cf[mt], qf[kk], acc[mt]); }
            const float wi = wi2[dir], rden = rdn[dir];
#pragma unroll
            for (int mt = 0; mt < 8; ++mt) acc[mt] = acc[mt] * wi;
#pragma unroll
            for (int kk = 0; kk < 4; ++kk) {
                if (dir ? (2 * kk + 1 >= w) : (2 * kk <= w)) { u32x2 lo[8], hi[8];
                    const u32x4 bv = (u32x4){sp[dir][2 * kk].x, sp[dir][2 * kk].y, sp[dir][2 * kk + 1].x, sp[dir][2 * kk + 1].y};
#pragma unroll
                    for (int mt = 0; mt < 8; ++mt) { const LAS unsigned char* vp = VT + fb8 + 16 * mt * TP + 64 * kk; lo[mt] = *(const LAS u32x2*)vp; hi[mt] = *(const LAS u32x2*)(vp + 32); }
#pragma unroll
                    for (int mt = 0; mt < 8; ++mt) { const u32x4 av = (u32x4){lo[mt].x, lo[mt].y, hi[mt].x, hi[mt].y};
                        acc[mt] = mfma16(__builtin_bit_cast(bf16x8, av), __builtin_bit_cast(bf16x8, bv), acc[mt]); } } }
#pragma unroll
            for (int mt = 0; mt < 8; ++mt) Hs[mt] = Hs[mt] + acc[mt] * rden;
        }
        f32x4 hn[8]; u32x2 ogr[8]; const unsigned t_o = opaque((unsigned)t), fq_o = opaque((unsigned)fq);
#pragma unroll
        for (int mt = 0; mt < 8; ++mt) { hn[mt] = ldg<f32x4>(F.hnorm + h * 128 + 16 * mt, (4 * fq_o) * 4); ogr[mt] = ldg<u32x2>(F.P + (size_t)R0 * 2048 + 1024 + h * 128 + 16 * mt, (t_o * 2048 + 4 * fq_o) * 2); }
        float ss = 0.f;
#pragma unroll
        for (int mt = 0; mt < 8; ++mt) ss += (Hs[mt][0] * Hs[mt][0] + Hs[mt][1] * Hs[mt][1]) + (Hs[mt][2] * Hs[mt][2] + Hs[mt][3] * Hs[mt][3]);
        ss += __shfl_xor(ss, 16); ss += __shfl_xor(ss, 32);
        const float rr = rsqrtf(ss * (1.0f / HD) + EPS);
        bf16* mixb = F.MIX + (size_t)(R0 >> 8) * (256 * 1024) + (size_t)(2 * h) * (256 * 64) + (size_t)(R0 & 255) * 64;
#pragma unroll
        for (int mt = 0; mt < 8; ++mt) { const u32x2 ow = ogr[mt];
            const float o0 = bflo(ow.x), o1 = bfhi(ow.x), o2 = bflo(ow.y), o3 = bfhi(ow.y);
            u32x2 r; r.x = pk2(Hs[mt][0] * rr * hn[mt][0] * fsigmoid(o0), Hs[mt][1] * rr * hn[mt][1] * fsigmoid(o1));
            r.y = pk2(Hs[mt][2] * rr * hn[mt][2] * fsigmoid(o2), Hs[mt][3] * rr * hn[mt][3] * fsigmoid(o3));
            stg<u32x2>(mixb + (size_t)(mt >> 2) * (256 * 64) + 16 * (mt & 3), (t_o * 64 + 4 * fq_o) * 2, r); }
        if (!has_next) break;
        unit = unext;
    }
}

#define XB_TMO      128
#define XB_XCNT(j)  (256  + 64 * (j))
#define XB_XSUB(j)  (1280 + 64 * (j))
#define XB_XGEN(j)  (2304 + 64 * (j))
#define XB_TOP      3328
#define XB_TOPGEN   3392
#define XCD_BAR_WORDS 3456
#define XB_SPIN_CAP (1u << 18)

__device__ __forceinline__ unsigned xb_ld(unsigned* p)              { return __hip_atomic_load(p, __ATOMIC_RELAXED, __HIP_MEMORY_SCOPE_AGENT); }
__device__ __forceinline__ unsigned xb_add(unsigned* p, unsigned v) { return __hip_atomic_fetch_add(p, v, __ATOMIC_RELAXED, __HIP_MEMORY_SCOPE_AGENT); }
__device__ __forceinline__ unsigned xb_xcc_id() { return (unsigned)__builtin_amdgcn_s_getreg((3 << 11) | 20) & 0xFu; }
#define XB_SPIN(cond, bar) do { unsigned _sp = 0; while (cond) { __builtin_amdgcn_s_sleep(1); \
    if ((++_sp & 255u) == 0u) { if (xb_ld(&(bar)[XB_TMO])) break; if (_sp > XB_SPIN_CAP) { atomicAdd(&(bar)[XB_TMO], 1u); break; } } } } while (0)

struct XcdBarrier {
    unsigned* bar; unsigned x;
    volatile LAS unsigned* st;
};

__device__ __forceinline__ XcdBarrier xcd_barrier_post(unsigned* bar, volatile LAS unsigned* st) {
    XcdBarrier b; b.bar = bar; b.x = xb_xcc_id(); b.st = st;
    if (threadIdx.x == 0) (void)xb_add(&bar[XB_XCNT(b.x)], 1u);
    return b;
}
__device__ __forceinline__ void xcd_barrier_complete(unsigned* bar, unsigned x, unsigned& nloc, unsigned& nx) {
    const unsigned G = gridDim.x * gridDim.y * gridDim.z;
    unsigned sum, cnt, mine, sp = 0u;
    for (;;) {
        sum = 0u; cnt = 0u; mine = 0u;
#pragma unroll
        for (unsigned j = 0; j < 16; ++j) { const unsigned c = xb_ld(&bar[XB_XCNT(j)]); sum += c; cnt += (c > 0u) ? 1u : 0u; mine = (j == x) ? c : mine; }
        if (sum == G) break;
        __builtin_amdgcn_s_sleep(1);
        if ((++sp & 255u) == 0u) { if (xb_ld(&bar[XB_TMO])) break; if (sp > XB_SPIN_CAP) { atomicAdd(&bar[XB_TMO], 1u); break; } }
    }
    nloc = mine > 0u ? mine : 1u; nx = cnt > 0u ? cnt : 1u;
}

__device__ __forceinline__ void xcd_barrier(const XcdBarrier& b) {
    asm volatile("s_waitcnt vmcnt(0)" ::: "memory");
    __syncthreads();
    if (threadIdx.x == 0) {
        unsigned* bar = b.bar;
        __builtin_amdgcn_s_waitcnt(0);
        unsigned nloc = b.st[0], nx = b.st[1];
        if (nloc == 0u) { xcd_barrier_complete(bar, b.x, nloc, nx); b.st[0] = nloc; b.st[1] = nx; }
        const unsigned old = xb_add(&bar[XB_XSUB(b.x)], 1u);
        const unsigned gen = old / nloc;
        if (old + 1u == (gen + 1u) * nloc) {
            __builtin_amdgcn_fence(__ATOMIC_RELEASE, "agent");
            asm volatile("s_waitcnt vmcnt(0)" ::: "memory");
            const unsigned og = xb_add(&bar[XB_TOP], 1u);
            const unsigned tg = og / nx;
            if (og + 1u == (tg + 1u) * nx) xb_add(&bar[XB_TOPGEN], 1u);
            else XB_SPIN(xb_ld(&bar[XB_TOPGEN]) == tg, bar);
            __builtin_amdgcn_fence(__ATOMIC_ACQUIRE, "agent");
            xb_add(&bar[XB_XGEN(b.x)], 1u);
            asm volatile("s_waitcnt vmcnt(0)" ::: "memory");
        } else {
            XB_SPIN(xb_ld(&bar[XB_XGEN(b.x)]) == gen, bar);
            __builtin_amdgcn_fence(__ATOMIC_ACQUIRE, "agent");
            asm volatile("s_waitcnt vmcnt(0)" ::: "memory");
        }
    }
    __syncthreads();
}

#ifndef PROBE_MASK
#define PROBE_MASK 0
#endif
#ifndef PREFETCH_MB
#define PREFETCH_MB 64
#endif
constexpr int N_PHASES = 14;
__global__ void __launch_bounds__(NTHREADS, 2) fwd_kernel(Args args) {
    extern __shared__ __attribute__((aligned(16))) unsigned char lds_raw[];
    Ctx F;
    F.lds = (LAS unsigned char*)lds_raw;
    F.tid = threadIdx.x; F.lane = F.tid & 63; F.wave = __builtin_amdgcn_readfirstlane(F.tid >> 6); F.G = gridDim.x; F.bid = blockIdx.x; F.probe = args.probe;
    F.x = args.in[0]; F.c = args.in[1]; F.ctx = args.in[2]; F.cctx = args.in[3]; F.wmod = args.in[4]; F.bmod = args.in[5]; F.npre = args.in[6]; F.npost = args.in[7];
    F.fwin = args.in[8]; F.fwout = args.in[9]; F.win = args.in[10]; F.wout = args.in[11]; F.convw = args.in[12]; F.convb = args.in[13]; F.wq = args.in[14]; F.wk = args.in[15];
    F.ibias = args.in[16]; F.fbias = args.in[17]; F.hnorm = args.in[18]; F.poolw = args.in[19]; F.pscale = args.in[20];
    F.out = args.out; F.ws = args.ws; unsigned char* ws = args.ws;
    F.mod = (float*)(ws + WS_MOD); F.wqt = (bf16*)(ws + WS_WQT); F.wkt = (bf16*)(ws + WS_WKT); F.mloc = (float*)(ws + WS_MLOC); F.gsum = (float*)(ws + WS_G); F.min_ = (float*)(ws + WS_MIN);
    F.gb = (float*)(ws + WS_GB); F.cn = (float*)(ws + WS_CN); F.nin = (float*)(ws + WS_NIN); F.gates = (float*)(ws + WS_GATES);
    F.W1 = (bf16*)(ws + WS_W1); F.W2 = (bf16*)(ws + WS_W2); F.WIN = (bf16*)(ws + WS_WIN); F.WOUT = (bf16*)(ws + WS_WOUT); F.Y = (bf16*)(ws + WS_Y); F.Z = (bf16*)(ws + WS_Z);
    F.H = (bf16*)(ws + WS_H); F.P = (bf16*)(ws + WS_P); F.Q = (bf16*)(ws + WS_Q); F.K = (bf16*)(ws + WS_K); F.CIN = (bf16*)(ws + WS_CIN); F.MIX = (bf16*)(ws + WS_MIX); F.CKV = (bf16*)(ws + WS_CKV); F.XB = (bf16*)(ws + WS_XB);
    const int lo = args.ph_lo, hi = args.ph_hi;
    volatile LAS unsigned* bst = (volatile LAS unsigned*)(F.lds + LDS_BYTES - 64);
    if (F.tid < 16) bst[F.tid] = 0u;
    __syncthreads();
    XcdBarrier bar; bar.bar = (unsigned*)(ws + WS_CTL) + 1024; bar.x = 0; bar.st = bst;
    if (hi - lo > 1) bar = xcd_barrier_post((unsigned*)(ws + WS_CTL) + 1024, bst);
#ifndef PROBE_MASK
#define PROBE_MASK 0
#endif
#define IN(k) (lo <= (k) && (k) < hi)
#if PROBE_MASK
#define REPS(k) _Pragma("unroll 1") for (int rep_ = 0; rep_ <= ((args.probe >> (k)) & 1); ++rep_)
#else
#define REPS(k)
#endif
#if PROBE_MASK
#define SEAM(k) do { if (IN(k) && IN((k) + 1)) { xcd_barrier(bar); } \
    if (tphase) { const unsigned long long tn_ = __builtin_amdgcn_s_memrealtime(); if (tphase == (k) + 1) tdur = tn_ - tprev; tprev = tn_; } } while (0)
    const int tphase = (args.probe >> 20) & 31;
    unsigned long long tprev = __builtin_amdgcn_s_memrealtime(), tdur = 0ull;
#else
#define SEAM(k) do { if (IN(k) && IN((k) + 1)) { xcd_barrier(bar); } } while (0)
    constexpr int tphase = 0; unsigned long long tprev = 0ull, tdur = 0ull; (void)tprev; (void)tdur;
#endif

    if (IN(0)) REPS(0) { p0_prologue(F);
        if (F.bid >= 144) {
            constexpr int PF_MB = PREFETCH_MB;
            const size_t n16 = (size_t)PF_MB * 65536; const int t = (F.bid - 144) * NTHREADS + F.tid, nt = (F.G - 144) * NTHREADS;
            for (size_t e = (size_t)t; e < n16; e += (size_t)nt * 8) { f32x4 v[8];
#pragma unroll
                for (int i = 0; i < 8; ++i) { const size_t ee = e + (size_t)i * nt; v[i] = (ee < n16) ? ((const f32x4*)F.x)[ee] : (f32x4){0.f, 0.f, 0.f, 0.f}; }
#pragma unroll
                for (int i = 0; i < 8; ++i) asm volatile("" :: "v"(v[i])); } } } SEAM(0);
    if (IN(1)) REPS(1) { convert_items(F, 0, 0, F.G);
        if (PROBE_MASK && ((args.probe >> 19) & 1)) { xcd_barrier(bar); if (tphase) { const unsigned long long tn_ = __builtin_amdgcn_s_memrealtime(); if (tphase == 15) tdur = tn_ - tprev; tprev = tn_; } }
        row_phase<false, 0, 0, true>(F, MT, 0.f, 0); } SEAM(1);
    if (IN(2)) { pg8::Gemm g{F.Y, F.W1, ML, 2 * FF, DM, 1}; pg8::StaticOrder S; S.init(ML, 2 * FF, F.G, F.bid); pg8::EpiSwiglu E{F.H, FF};
        pg8::gemm_phase<pg8::EpiSwiglu, pg8::StaticOrder, true, true>(F.lds, g, S, E); } SEAM(2);
    if (IN(3)) {
        const int ncx = (MC / 256) * (2 * FF / 256), gA = F.G - 8; unsigned* cxcnt = (unsigned*)(F.ws + WS_CTL) + CTXCNT_WORD;
        if (F.bid >= 8 && F.bid - 8 < ncx) {
            pg8::Gemm g{F.Y + (size_t)(ML / 256) * (256 * DM), F.W1, MC, 2 * FF, DM, 1}; pg8::StaticOrder S; S.init(MC, 2 * FF, gA, F.bid - 8);
            pg8::EpiSwiglu E{F.H + (size_t)(ML / 256) * (FF / 64) * (256 * 64), FF};
            pg8::gemm_phase<pg8::EpiSwiglu, pg8::StaticOrder, true, true>(F.lds, g, S, E);
            asm volatile("s_waitcnt vmcnt(0)" ::: "memory"); __syncthreads();
            if (F.tid == 0) { __builtin_amdgcn_fence(__ATOMIC_RELEASE, "agent"); asm volatile("s_waitcnt vmcnt(0)" ::: "memory");
                __hip_atomic_fetch_add(cxcnt, 1u, __ATOMIC_RELAXED, __HIP_MEMORY_SCOPE_AGENT); } }
        { pg8::Gemm g{F.H, F.W2, MT, DM, FF, 1}; pg8::GatedOrder S; S.init(MT, DM, F.G, F.bid, 2); S.cnt = cxcnt; S.need = (unsigned)min(ncx, gA); S.pm_gate = ML / 256; pg8::EpiStore E{F.Z, DM};
          pg8::gemm_phase<pg8::EpiStore, pg8::GatedOrder, true, true>(F.lds, g, S, E); }
        { const int nb3 = (MT / 256) * (DM / 256) - 2 * F.G;
          const int first = 8 + ncx;
          if (nb3 > 0 && nb3 <= 8 && first < F.G) { constexpr int cut = (IT_PART1 * 88) / 100;
              convert_items(F, 1, first, F.G - first, 0, cut); convert_items(F, 1, 8, ncx, cut, IT_PART1); }
          else convert_items(F, 1, 0, F.G); } } SEAM(3);
    if (IN(4)) { row_phase<true, 0, 1, true>(F, MT, 0.5f, 1); } SEAM(4);
    if (IN(5)) { pg8::Gemm g{F.Y, F.WIN, MT, 2304, DM, 1}; pg8::StaticOrder S; S.init(MT, 2304, F.G, F.bid); pg8::EpiInProj E{F.P, F.gates, F.ibias, F.fbias};
        pg8::gemm_phase<pg8::EpiInProj, pg8::StaticOrder, true, true>(F.lds, g, S, E); } SEAM(5);
    if (IN(6)) { REPS(15) m1_phase(F);
        if (PROBE_MASK && ((args.probe >> 18) & 1)) { xcd_barrier(bar); if (tphase) { const unsigned long long tn_ = __builtin_amdgcn_s_memrealtime(); if (tphase == 16) tdur = tn_ - tprev; tprev = tn_; } }
                 REPS(14) {
                 if (F.G == 256) {
                     const int nk = (F.bid < 16) ? 5 : 8;
                     for (int k = 0; k < nk; ++k) pool_unit(F, F.bid + 256 * k);
                     if (F.bid >= 16 && F.bid < 64) { const int e = F.bid - 16; pool_unit(F, e / 3 + 256 * (5 + e % 3)); } }
                 else for (int u = F.bid; u < NB * GRID_ROWS * 4; u += F.G) pool_unit(F, u); } } SEAM(6);
    if (IN(7)) REPS(7) { scan_phase(F); } SEAM(7);
    if (IN(8)) REPS(8) { m3_phase(F); } SEAM(8);
    if (IN(9)) REPS(9) { pg8::Gemm g{F.MIX, F.WOUT, ML, DM, DM, 1}; pg8::StaticOrder S; S.init(ML, DM, F.G, F.bid); pg8::EpiStore E{F.Z, DM};
        pg8::gemm_phase<pg8::EpiStore, pg8::StaticOrder, true, true>(F.lds, g, S, E); } SEAM(9);
    if (IN(10)) { row_phase<true, 1, 1, true>(F, ML, 1.0f, 2); } SEAM(10);
    if (IN(11)) { pg8::Gemm g{F.Y, F.W1 + (size_t)2 * FF * DM, ML, 2 * FF, DM, 1}; pg8::StaticOrder S; S.init(ML, 2 * FF, F.G, F.bid); pg8::EpiSwiglu E{F.H, FF};
        pg8::gemm_phase<pg8::EpiSwiglu, pg8::StaticOrder, true, true>(F.lds, g, S, E); } SEAM(11);
    if (IN(12)) { pg8::Gemm g{F.H, F.W2 + (size_t)DM * FF, ML, DM, FF, 1}; pg8::StaticOrder S; S.init(ML, DM, F.G, F.bid, 1); pg8::EpiStore E{F.Z, DM};
        pg8::gemm_phase<pg8::EpiStore, pg8::StaticOrder, true, true>(F.lds, g, S, E); } SEAM(12);
    if (IN(13)) { row_phase<true, 1, 2, false>(F, ML, 0.5f, 3); }
    if (tphase) { asm volatile("s_waitcnt vmcnt(0)" ::: "memory"); __syncthreads();
        const unsigned long long tn_ = __builtin_amdgcn_s_memrealtime(); if (tphase == 14) tdur = tn_ - tprev;
        if (F.bid == 0) { const unsigned long long t0_ = __builtin_amdgcn_s_memrealtime(); while (__builtin_amdgcn_s_memrealtime() - t0_ < 10ull * tdur) __builtin_amdgcn_s_sleep(8); } }
#undef IN
#undef SEAM
}

#ifndef PROBE_MASK
#define PROBE_MASK 0
#endif
#ifndef N_LAUNCHES
#define N_LAUNCHES 1
#endif
extern "C" void kernel_launch(void* const* d_in, const int* in_sizes, int n_in, void* d_out, int out_size, void* d_ws, size_t ws_size, hipStream_t stream) {
    static int grid = 0;
    if (grid == 0) {
        if (n_in != 21 || in_sizes[0] != ML * DM || out_size != ML * DM || ws_size < WS_END) { fprintf(stderr, "kernel_launch: unexpected shapes (n_in %d, in0 %d, out %d, ws %zu)\n", n_in, n_in > 0 ? in_sizes[0] : -1, out_size, ws_size); grid = -1; return; }
        int dev = 0, cus = 0, per_cu = 0;
        (void)hipGetDevice(&dev); (void)hipDeviceGetAttribute(&cus, hipDeviceAttributeMultiprocessorCount, dev);
        (void)hipFuncSetAttribute((const void*)fwd_kernel, hipFuncAttributeMaxDynamicSharedMemorySize, LDS_BYTES);
        (void)hipOccupancyMaxActiveBlocksPerMultiprocessor(&per_cu, (const void*)fwd_kernel, NTHREADS, LDS_BYTES);
        (void)hipGetLastError();
        if (per_cu < 1) { fprintf(stderr, "kernel_launch: occupancy query says %d blocks per CU\n", per_cu); grid = -1; return; }
        grid = cus;
    }
    if (grid < 0) return;
    Args a{};
    for (int i = 0; i < 21; ++i) a.in[i] = (const float*)d_in[i];
    a.out = (float*)d_out; a.ws = (unsigned char*)d_ws; a.probe = PROBE_MASK;
    if (N_LAUNCHES == 1) {
        (void)hipMemsetAsync((char*)d_ws + WS_CTL, 0, CTL_ZERO_BYTES, stream);
        a.ph_lo = 0; a.ph_hi = N_PHASES; void* kargs[] = {&a};
        hipError_t e = hipLaunchCooperativeKernel((const void*)fwd_kernel, dim3(grid), dim3(NTHREADS), kargs, LDS_BYTES, stream);
        if (e != hipSuccess) fprintf(stderr, "cooperative launch failed: %s (grid %d)\n", hipGetErrorString(e), grid);
    } else {
        for (int p = 0; p < N_PHASES; ++p) { a.ph_lo = p; a.ph_hi = p + 1; hipLaunchKernelGGL(fwd_kernel, dim3(grid), dim3(NTHREADS), LDS_BYTES, stream, a); }
    }
}
```

```cpp
#include <hip/hip_runtime.h>
#include <hip/hip_cooperative_groups.h>
#include <cstdio>
#include <cstdint>
namespace cg = cooperative_groups;
namespace pg8 {
#define PG8_LAS __attribute__((address_space(3)))
typedef unsigned short bf16_t;
typedef short bf16x8 __attribute__((ext_vector_type(8)));
typedef float f32x4 __attribute__((ext_vector_type(4)));
typedef unsigned u32x4 __attribute__((ext_vector_type(4)));
constexpr int BM = 256, BK = 64, HALF = 128, HTB = HALF * BK * 2  , STAGE_BYTES = 8 * HTB, NXCD = 8, WGM = 8;

__host__ __device__ __forceinline__ int lds_byte(int r, int c) { const int st = (r >> 4) * 2 + (c >> 5), rr = r & 15, cc = c & 31, ob = rr * 64 + cc * 2; return st * 1024 + (ob ^ (((ob >> 9) & 1) << 5)); }
__host__ __device__ __forceinline__ void stage_rc(int b, int& R, int& C) { const int st = b / 1024, sb = b % 1024, swz = sb ^ (((sb >> 9) & 1) << 5); R = (st >> 1) * 16 + swz / 64; C = (st & 1) * 32 + (swz % 64) / 2; }
__host__ __device__ __forceinline__ int perm32(int rho) { const int n = rho >> 4, i = rho & 15; return 8 * (i >> 2) + 4 * n + (i & 3); }

struct Unit { int pm, pn; };
struct Gemm { const bf16_t* A; const bf16_t* Bt; int M, N, K; int a_tiled; };

struct StaticOrder {
    int nM, nN, nwg, G, c, rev;
    __host__ __device__ void init(int M, int N, int G_, int c_, int rev_ = 0) { nM = M / BM; nN = N / BM; nwg = nM * nN; G = G_; c = c_; rev = rev_; }
    __host__ __device__ bool next(int i, Unit& u) const {
        const long L = (long)i * G + c; if (L >= nwg) return false;
        int wgid = (int)L; { const int q = nwg / NXCD, r = nwg % NXCD, xcd = wgid % NXCD, off = wgid / NXCD; wgid = (xcd < r ? xcd * (q + 1) : r * (q + 1) + (xcd - r) * q) + off; }
        const int nig = WGM * nN, gid = wgid / nig, fm = gid * WGM, gsz = (nM - fm) < WGM ? (nM - fm) : WGM;
        u.pm = fm + ((wgid % nig) % gsz); u.pn = (wgid % nig) / gsz;
        if (rev == 1) u.pm = nM - 1 - u.pm; else if (rev == 2) u.pm = (u.pm < nM - 2) ? nM - 3 - u.pm : u.pm;
        return true;
    }
    __device__ __forceinline__ void a_ready(const Unit&) const {}
    __device__ __forceinline__ void done(const Unit&) const {}
};
struct GatedOrder : StaticOrder {
    unsigned* cnt; unsigned need; int pm_gate;
    __device__ __forceinline__ void a_ready(const Unit& u) const {
        if (u.pm < pm_gate) return;
        if (threadIdx.x < 64) { unsigned sp = 0;
            while ((unsigned)__builtin_amdgcn_readfirstlane(__hip_atomic_load(cnt, __ATOMIC_RELAXED, __HIP_MEMORY_SCOPE_AGENT)) < need) { __builtin_amdgcn_s_sleep(2); if (++sp > (1u << 22)) break; }
            __builtin_amdgcn_fence(__ATOMIC_ACQUIRE, "agent");
            asm volatile("s_waitcnt vmcnt(0)" ::: "memory"); }
        asm volatile("" ::: "memory"); __builtin_amdgcn_s_barrier(); asm volatile("" ::: "memory");
    }
};
__device__ __forceinline__ unsigned cvt_pk_bf16(float lo, float hi) { unsigned r; asm volatile("v_cvt_pk_bf16_f32 %0, %1, %2" : "=v"(r) : "v"(lo), "v"(hi)); return r; }
typedef float f32x2 __attribute__((ext_vector_type(2)));
typedef unsigned u32x2 __attribute__((ext_vector_type(2)));
struct EpiStore {
    static constexpr bool PERM = true, AFTER_DRAIN = false;
    bf16_t* O; int ldc;
    __device__ __forceinline__ void operator()(const f32x4 (&acc)[2][2][4][2], const Unit& u, int wr, int wc, int fr, int fq) const {
        const int row0 = u.pm * BM + wr * 64 + fr, col0 = u.pn * BM + wc * 32 + 8 * fq;
#pragma unroll
        for (int ai = 0; ai < 2; ++ai)
#pragma unroll
            for (int m = 0; m < 4; ++m) { bf16_t* rowp = O + (size_t)(row0 + ai * HALF + m * 16) * ldc + col0;
#pragma unroll
                for (int bj = 0; bj < 2; ++bj) { const f32x4 v0 = acc[ai][bj][m][0], v1 = acc[ai][bj][m][1];
                    u32x4 w; w.x = cvt_pk_bf16(v0[0], v0[1]); w.y = cvt_pk_bf16(v0[2], v0[3]); w.z = cvt_pk_bf16(v1[0], v1[1]); w.w = cvt_pk_bf16(v1[2], v1[3]);
                    *(u32x4*)(rowp + bj * HALF) = w; } }
    }
};
__device__ __forceinline__ float silu_mul(float a, float b) { return a * b * __builtin_amdgcn_rcpf(1.0f + __builtin_amdgcn_exp2f(a * -1.4426950408889634f)); }
struct EpiSwiglu {
    static constexpr bool PERM = true, AFTER_DRAIN = false;
    bf16_t* O; int ldc;
    __device__ __forceinline__ void operator()(const f32x4 (&acc)[2][2][4][2], const Unit& u, int wr, int wc, int fr, int fq) const {
        const int hcol = u.pn * HALF + wc * 32 + 8 * fq, r0 = wr * 64 + fr;
        bf16_t* slab = O + ((size_t)u.pm * (ldc / 64) + (hcol >> 6)) * (BM * 64) + (hcol & 63);
#pragma unroll
        for (int ai = 0; ai < 2; ++ai)
#pragma unroll
            for (int m = 0; m < 4; ++m) { bf16_t* rowp = slab + (size_t)(r0 + ai * HALF + m * 16) * 64;
                const f32x4 a0 = acc[ai][0][m][0], a1 = acc[ai][0][m][1], b0 = acc[ai][1][m][0], b1 = acc[ai][1][m][1];
                u32x4 w; w.x = cvt_pk_bf16(silu_mul(a0[0], b0[0]), silu_mul(a0[1], b0[1])); w.y = cvt_pk_bf16(silu_mul(a0[2], b0[2]), silu_mul(a0[3], b0[3]));
                w.z = cvt_pk_bf16(silu_mul(a1[0], b1[0]), silu_mul(a1[1], b1[1])); w.w = cvt_pk_bf16(silu_mul(a1[2], b1[2]), silu_mul(a1[3], b1[3]));
                *(u32x4*)rowp = w; }
    }
};
struct EpiInProj {
    static constexpr bool PERM = true, AFTER_DRAIN = false;
    bf16_t* P; float* gates; const float* ib; const float* fb;
    __device__ __forceinline__ void operator()(const f32x4 (&acc)[2][2][4][2], const Unit& u, int wr, int wc, int fr, int fq) const {
        const int row0 = u.pm * BM + wr * 64 + fr;
        if (u.pn < 8) {
            const int col0 = u.pn * BM + wc * 32 + 8 * fq;
#pragma unroll
            for (int ai = 0; ai < 2; ++ai)
#pragma unroll
                for (int m = 0; m < 4; ++m) { bf16_t* rowp = P + (size_t)(row0 + ai * HALF + m * 16) * 2048 + col0;
#pragma unroll
                    for (int bj = 0; bj < 2; ++bj) { const f32x4 v0 = acc[ai][bj][m][0], v1 = acc[ai][bj][m][1];
                        u32x4 w; w.x = cvt_pk_bf16(v0[0], v0[1]); w.y = cvt_pk_bf16(v0[2], v0[3]); w.z = cvt_pk_bf16(v1[0], v1[1]); w.w = cvt_pk_bf16(v1[2], v1[3]);
                        *(u32x4*)(rowp + bj * HALF) = w; } }
        } else if (wc == 0 && fq < 2) {
            const float* bp = (fq == 0) ? ib : fb;
            const f32x4 bv0 = *(const f32x4*)bp, bv1 = *(const f32x4*)(bp + 4);
#pragma unroll
            for (int ai = 0; ai < 2; ++ai)
#pragma unroll
                for (int m = 0; m < 4; ++m) { float* gp = gates + (size_t)(row0 + ai * HALF + m * 16) * 16 + 8 * fq;
                    *(f32x4*)gp = acc[ai][0][m][0] + bv0; *(f32x4*)(gp + 4) = acc[ai][0][m][1] + bv1; }
        }
    }
};
template <class Epi, class Sched, bool ALIGN_EPI = false, bool SP2 = false>
__device__ __forceinline__ void gemm_phase(PG8_LAS unsigned char* lds, const Gemm g, const Sched& S, const Epi& E) {
    const int tid = threadIdx.x, wid = __builtin_amdgcn_readfirstlane(tid >> 6), lane = tid & 63, wr = wid >> 2, wc = wid & 3, fr = lane & 15, fq = lane >> 4;
    const int K = g.K, nt = K / BK, ldA = g.a_tiled ? BK : K;
    unsigned voffA[2], voffB[2];
#pragma unroll
    for (int i = 0; i < 2; ++i) { int R, C; stage_rc(tid * 16 + i * 8192, R, C); const int Rb = Epi::PERM ? ((R & ~31) + perm32(R & 31)) : R;
        voffA[i] = (unsigned)(R * ldA + C) * 2u; voffB[i] = (unsigned)(Rb * ldA + C) * 2u; }
    const size_t kstep = (size_t)(BK * 2);
    const size_t hstep = (size_t)HALF * K * 2;
    const size_t tstep = 2 * hstep;
    const size_t kstepA = g.a_tiled ? (size_t)(BM * BK * 2) : kstep, hstepA = g.a_tiled ? (size_t)(HALF * BK * 2) : hstep, tstepA = g.a_tiled ? (size_t)(K / BK) * (BM * BK * 2) : tstep;
    const unsigned ldsw = (unsigned)wid * 1024u;
    const int aoff = lds_byte(wr * 64 + fr, fq * 8), boff = lds_byte(wc * 32 + fr, fq * 8);
#define PG8_SA(b, h) (((b) * 2 + (h)) * HTB)
#define PG8_SB(b, h) ((4 + (b) * 2 + (h)) * HTB)
#define PG8_STAGE(bufoff, gbase, voff) do { _Pragma("unroll") for (int _i = 0; _i < 2; ++_i) \
        __builtin_amdgcn_global_load_lds((const unsigned*)((const char*)(gbase) + (voff)[_i]), (PG8_LAS unsigned*)(lds + (bufoff) + ldsw + _i * 8192), 16, 0, 0); } while (0)
#define PG8_LDA(dst, b, h) do { _Pragma("unroll") for (int m = 0; m < 4; ++m) _Pragma("unroll") for (int k = 0; k < 2; ++k) dst[m][k] = *(const PG8_LAS bf16x8*)(lds + PG8_SA(b, h) + aoff + m * 2048 + k * 1024); } while (0)
#define PG8_LDB(dst, b, h) do { _Pragma("unroll") for (int n = 0; n < 2; ++n) _Pragma("unroll") for (int k = 0; k < 2; ++k) dst[n][k] = *(const PG8_LAS bf16x8*)(lds + PG8_SB(b, h) + boff + n * 2048 + k * 1024); } while (0)
#define PG8_MMA(ai, bj, At, Bt) do { __builtin_amdgcn_s_setprio(1); _Pragma("unroll") for (int m = 0; m < 4; ++m) _Pragma("unroll") for (int n = 0; n < 2; ++n) _Pragma("unroll") for (int k = 0; k < 2; ++k) \
        acc[ai][bj][m][n] = __builtin_amdgcn_mfma_f32_16x16x32_bf16(Bt[n][k], At[m][k], acc[ai][bj][m][n], 0, 0, 0); __builtin_amdgcn_s_setprio(0); } while (0)
#define PG8_WAIT_V(n) asm volatile("s_waitcnt vmcnt(" #n ")" ::: "memory")
#define PG8_WAIT_L(n) asm volatile("s_waitcnt lgkmcnt(" #n ")" ::: "memory")
#define PG8_BAR __builtin_amdgcn_s_barrier()
#define PG8_SCHED __builtin_amdgcn_sched_barrier(0)
    Unit cur, nxt; int ui = 0;
    if (!S.next(0, cur)) return;
    f32x4 acc[2][2][4][2];
#pragma unroll
    for (int a = 0; a < 2; ++a)
#pragma unroll
        for (int b = 0; b < 2; ++b)
#pragma unroll
            for (int m = 0; m < 4; ++m)
#pragma unroll
                for (int n = 0; n < 2; ++n) acc[a][b][m][n] = (f32x4){0.f, 0.f, 0.f, 0.f};
    bf16x8 At[4][2], B0[2][2], B1[2][2];
    const char* cA = (const char*)g.A + (size_t)cur.pm * tstepA; const char* cB = (const char*)g.Bt + (size_t)cur.pn * tstepA;
    S.a_ready(cur);
    if constexpr (SP2) {
        PG8_STAGE(PG8_SB(0, 0), cB, voffB); PG8_STAGE(PG8_SB(0, 1), cB + hstepA, voffB); PG8_STAGE(PG8_SA(0, 0), cA, voffA); PG8_STAGE(PG8_SA(0, 1), cA + hstepA, voffA);
        if (wr == 1) PG8_BAR;
        PG8_WAIT_V(2); PG8_BAR;
        PG8_STAGE(PG8_SB(1, 0), cB + kstepA, voffB); PG8_STAGE(PG8_SA(1, 0), cA + kstepA, voffA); PG8_STAGE(PG8_SB(1, 1), cB + hstepA + kstepA, voffB);
        PG8_WAIT_V(6); PG8_BAR;
    } else {
        PG8_STAGE(PG8_SB(0, 0), cB, voffB); PG8_STAGE(PG8_SA(0, 0), cA, voffA); PG8_STAGE(PG8_SB(0, 1), cB + hstepA, voffB); PG8_STAGE(PG8_SA(0, 1), cA + hstepA, voffA);
        if (wr == 1) PG8_BAR;
        PG8_WAIT_V(4); PG8_BAR;
        PG8_STAGE(PG8_SB(1, 0), cB + kstepA, voffB); PG8_STAGE(PG8_SA(1, 0), cA + kstepA, voffA); PG8_STAGE(PG8_SB(1, 1), cB + hstepA + kstepA, voffB);
        PG8_WAIT_V(6); PG8_BAR;
    }
    for (;;) {
        const bool has_next = S.next(ui + 1, nxt);
        const char* nA = has_next ? (const char*)g.A + (size_t)nxt.pm * tstepA : cA; const char* nB = has_next ? (const char*)g.Bt + (size_t)nxt.pn * tstepA : cB;
        for (int t = 0; t < nt; t += 2) {
            const bool last = (t == nt - 2);
            const char* a1 = cA + (size_t)(t + 1) * kstepA;
            const char* a2 = last ? nA : cA + (size_t)(t + 2) * kstepA; const char* b2 = last ? nB : cB + (size_t)(t + 2) * kstepA;
            const char* a3 = a2 + kstepA; const char* b3 = b2 + kstepA;
            if (last && has_next) S.a_ready(nxt);
            if constexpr (SP2) {
            PG8_LDB(B0, 0, 0); PG8_LDB(B1, 0, 1); PG8_SCHED; PG8_LDA(At, 0, 0); PG8_STAGE(PG8_SA(1, 1), a1 + hstepA, voffA);
            PG8_WAIT_V(8); PG8_WAIT_L(0); PG8_BAR; PG8_MMA(0, 0, At, B0); PG8_MMA(0, 1, At, B1); PG8_BAR; PG8_SCHED;
            PG8_LDA(At, 0, 1); PG8_STAGE(PG8_SB(0, 0), b2, voffB); PG8_STAGE(PG8_SB(0, 1), b2 + hstepA, voffB); PG8_STAGE(PG8_SA(0, 0), a2, voffA);
            PG8_WAIT_V(8); PG8_WAIT_L(0); PG8_BAR; PG8_MMA(1, 0, At, B0); PG8_MMA(1, 1, At, B1); PG8_BAR; PG8_SCHED;
            PG8_LDB(B0, 1, 0); PG8_LDB(B1, 1, 1); PG8_SCHED; PG8_LDA(At, 1, 0); PG8_STAGE(PG8_SA(0, 1), a2 + hstepA, voffA);
            PG8_WAIT_V(8); PG8_WAIT_L(0); PG8_BAR; PG8_MMA(0, 0, At, B0); PG8_MMA(0, 1, At, B1); PG8_BAR; PG8_SCHED;
            PG8_LDA(At, 1, 1); PG8_STAGE(PG8_SB(1, 0), b3, voffB); PG8_STAGE(PG8_SB(1, 1), b3 + hstepA, voffB); PG8_STAGE(PG8_SA(1, 0), a3, voffA);
            PG8_WAIT_V(8); PG8_WAIT_L(0); PG8_BAR; PG8_MMA(1, 0, At, B0); PG8_MMA(1, 1, At, B1); PG8_BAR; PG8_SCHED;
            } else {
            PG8_LDB(B0, 0, 0); PG8_SCHED; PG8_LDA(At, 0, 0); PG8_STAGE(PG8_SA(1, 1), a1 + hstepA, voffA);
            PG8_WAIT_L(8); PG8_BAR; PG8_WAIT_L(0); PG8_MMA(0, 0, At, B0); PG8_BAR; PG8_SCHED;
            PG8_LDB(B1, 0, 1); PG8_STAGE(PG8_SB(0, 0), b2, voffB);
            PG8_BAR; PG8_WAIT_L(0); PG8_MMA(0, 1, At, B1); PG8_BAR;
            PG8_LDA(At, 0, 1); PG8_STAGE(PG8_SA(0, 0), a2, voffA);
            PG8_BAR; PG8_WAIT_L(0); PG8_MMA(1, 0, At, B0); PG8_BAR; PG8_SCHED;
            PG8_STAGE(PG8_SB(0, 1), b2 + hstepA, voffB);
            PG8_WAIT_V(6); PG8_BAR; PG8_MMA(1, 1, At, B1); PG8_BAR;
            PG8_LDB(B0, 1, 0); PG8_SCHED; PG8_LDA(At, 1, 0); PG8_STAGE(PG8_SA(0, 1), a2 + hstepA, voffA);
            PG8_WAIT_L(8); PG8_BAR; PG8_WAIT_L(0); PG8_MMA(0, 0, At, B0); PG8_BAR; PG8_SCHED;
            PG8_LDB(B1, 1, 1); PG8_STAGE(PG8_SB(1, 0), b3, voffB);
            PG8_BAR; PG8_WAIT_L(0); PG8_MMA(0, 1, At, B1); PG8_BAR;
            PG8_LDA(At, 1, 1); PG8_STAGE(PG8_SA(1, 0), a3, voffA);
            PG8_BAR; PG8_WAIT_L(0); PG8_MMA(1, 0, At, B0); PG8_BAR; PG8_SCHED;
            PG8_STAGE(PG8_SB(1, 1), b3 + hstepA, voffB);
            PG8_WAIT_V(6); PG8_BAR; PG8_MMA(1, 1, At, B1); PG8_BAR;
            }
        }
        if constexpr (ALIGN_EPI) { if (wr == 0) PG8_BAR; }
        if constexpr (!Epi::AFTER_DRAIN) { E(acc, cur, wr, wc, fr, fq); S.done(cur); }
        if (!has_next) break;
#pragma unroll
        for (int a = 0; a < 2; ++a)
#pragma unroll
            for (int b = 0; b < 2; ++b)
#pragma unroll
                for (int m = 0; m < 4; ++m)
#pragma unroll
                    for (int n = 0; n < 2; ++n) acc[a][b][m][n] = (f32x4){0.f, 0.f, 0.f, 0.f};
        cur = nxt; cA = nA; cB = nB; ++ui;
        if constexpr (ALIGN_EPI) { if (wr == 1) PG8_BAR; }
    }
    PG8_WAIT_V(0);
    if constexpr (!ALIGN_EPI) { if (wr == 0) PG8_BAR; }
    PG8_BAR;
    if constexpr (Epi::AFTER_DRAIN) { E.fused(acc, cur, wr, wc, fr, fq, lds, wid, lane); S.done(cur); }
#undef PG8_SA
#undef PG8_SB
#undef PG8_STAGE
#undef PG8_LDA
#undef PG8_LDB
#undef PG8_MMA
#undef PG8_WAIT_V
#undef PG8_WAIT_L
#undef PG8_BAR
#undef PG8_SCHED
}
}
constexpr int DM = 1024, SEQ = 16384, NB = 2, CTXL = 256, FF = 2816, NMOD = 9;
constexpr int ML = NB * SEQ, MC = NB * CTXL, MT = ML + MC;
constexpr int NH = 4, HD = 128, MW = 512, GW = 64, GRID_ROWS = SEQ / GW;
constexpr int NTB = 130;
constexpr float EPS = 1e-6f;
constexpr int NWAVES = 8, NTHREADS = 512;

constexpr size_t MiB = 1u << 20, KiB = 1024;
constexpr size_t WS_CTL = 0;
constexpr size_t WS_MOD = 1 * MiB;
constexpr size_t WS_WQT = 1 * MiB + 256 * KiB;
constexpr size_t WS_WKT = 1 * MiB + 512 * KiB;
constexpr size_t WS_MLOC = 1 * MiB + 768 * KiB;
constexpr size_t WS_G = WS_MLOC + 16 * KiB;
constexpr size_t WS_MIN = WS_G + 16 * KiB;
constexpr size_t WS_CN = 2 * MiB;
constexpr size_t WS_NIN = 3 * MiB + 256 * KiB;
constexpr size_t WS_GATES = 5 * MiB;
constexpr size_t WS_W1 = 8 * MiB;
constexpr size_t WS_W2 = 30 * MiB;
constexpr size_t WS_WIN = 41 * MiB;
constexpr size_t WS_WOUT = 46 * MiB;
constexpr size_t WS_Y = 48 * MiB;
constexpr size_t WS_Z = 113 * MiB;
constexpr size_t WS_CKV = 48 * MiB;
constexpr size_t WS_H = 178 * MiB;
constexpr size_t WS_P = 178 * MiB;
constexpr size_t WS_Q = 308 * MiB;
constexpr size_t WS_K = WS_Q + (size_t)MT * 512 * 2;
constexpr size_t WS_CIN = 113 * MiB;
constexpr size_t WS_XB = 373 * MiB;
constexpr size_t WS_MIX = 437 * MiB;
constexpr size_t WS_GB = 501 * MiB;
constexpr size_t WS_END = 505 * MiB;
static_assert(WS_K + (size_t)MT * 512 * 2 <= WS_XB && WS_XB + (size_t)ML * 1024 * 2 <= WS_MIX && WS_CIN + (size_t)16 * 128 * 32768 <= WS_H && WS_Z + (size_t)MT * 1024 * 2 <= WS_H && WS_CKV + (size_t)16 * 130 * 65536 <= WS_H && WS_P + (size_t)MT * 2048 * 2 <= WS_Q, "ws map");
static_assert(WS_GATES + (size_t)MT * 64 <= WS_W1 && WS_NIN + 16 * 130 * 512 <= WS_GATES && WS_CN + 16 * 130 * 512 <= WS_NIN, "ws map small");
constexpr size_t CTL_ZERO_BYTES = 64 * KiB;
constexpr int CTXCNT_WORD = 8192;

constexpr int LDS_BYTES = 160 * 1024;

#define LAS __attribute__((address_space(3)))
typedef unsigned short bf16;
typedef short bf16x8 __attribute__((ext_vector_type(8)));
typedef float f32x4 __attribute__((ext_vector_type(4)));
typedef float f32x2v __attribute__((ext_vector_type(2)));
typedef unsigned u32x4 __attribute__((ext_vector_type(4)));
typedef unsigned u32x2 __attribute__((ext_vector_type(2)));
#define LDS_WAIT() asm volatile("s_waitcnt lgkmcnt(0)" ::: "memory")
#define LDS_BARRIER() do { asm volatile("s_waitcnt lgkmcnt(0)" ::: "memory"); __builtin_amdgcn_s_barrier(); asm volatile("" ::: "memory"); } while (0)

__device__ __forceinline__ unsigned f2bf(float f) { unsigned u = __builtin_bit_cast(unsigned, f); return (u + 0x7fffu + ((u >> 16) & 1u)) >> 16; }
typedef float f32x2c_t __attribute__((ext_vector_type(2))); typedef __bf16 bf16x2c_t __attribute__((ext_vector_type(2)));
__device__ __forceinline__ unsigned pk2(float lo, float hi) { const f32x2c_t v = {lo, hi}; const bf16x2c_t b = __builtin_convertvector(v, bf16x2c_t); return __builtin_bit_cast(unsigned, b); }
__device__ __forceinline__ float bflo(unsigned w) { return __uint_as_float(w << 16); }
__device__ __forceinline__ float bfhi(unsigned w) { return __uint_as_float(w & 0xffff0000u); }
__device__ __forceinline__ float wave_sum(float v) {
#pragma unroll
    for (int o = 1; o < 64; o <<= 1) v += __shfl_xor(v, o);
    return v;
}
__device__ __forceinline__ float wave_max(float v) {
#pragma unroll
    for (int o = 1; o < 64; o <<= 1) v = fmaxf(v, __shfl_xor(v, o));
    return v;
}
__device__ __forceinline__ float log_sigmoid(float x) { return fminf(x, 0.f) - log1pf(expf(-fabsf(x))); }
__device__ __forceinline__ f32x4 mfma16(bf16x8 a, bf16x8 b, f32x4 c) { return __builtin_amdgcn_mfma_f32_16x16x32_bf16(a, b, c, 0, 0, 0); }

__device__ __forceinline__ unsigned opaque(unsigned x) { asm volatile("" : "+v"(x)); return x; }
template <class T> __device__ __forceinline__ T ldg(const void* ubase, unsigned boff) { return *(const T*)((const char*)ubase + boff); }
template <class T> __device__ __forceinline__ void stg(void* ubase, unsigned boff, T v) { *(T*)((char*)ubase + boff) = v; }

struct Args { const float* in[21]; float* out; unsigned char* ws; int ph_lo, ph_hi, probe, pad; };

struct Ctx {
    LAS unsigned char* lds;
    int tid, lane, wave, G, bid, probe;
    const float *x, *c, *ctx, *cctx, *wmod, *bmod, *npre, *npost, *fwin, *fwout, *win, *wout, *convw, *convb, *wq, *wk, *ibias, *fbias, *hnorm, *poolw, *pscale;
    float* out; unsigned char* ws;
    float* mod; bf16 *wqt, *wkt; float *mloc, *gsum, *min_, *cn, *nin, *gates, *gb;
    bf16 *W1, *W2, *WIN, *WOUT, *Y, *Z, *H, *P, *Q, *K, *CIN, *MIX, *CKV, *XB;
};

constexpr int TP0_SCR = 16384;
constexpr int P0_SC_OFF = 131072, P0_RED_OFF = 131072 + 12288;

template <bool TILED>
__device__ __forceinline__ void tr_store(LAS float* scr, bf16* WT, int K, int n0, int k0, int lane) {
    const int c = lane & 7;
#pragma unroll
    for (int j = 0; j < 4; ++j) { const int n = (lane >> 3) + 8 * j; const LAS float* s = scr + (8 * c) * 33 + n;
        u32x4 o; o.x = pk2(s[0 * 33], s[1 * 33]); o.y = pk2(s[2 * 33], s[3 * 33]); o.z = pk2(s[4 * 33], s[5 * 33]); o.w = pk2(s[6 * 33], s[7 * 33]);
        const int nn = n0 + n;
        if (TILED) *(u32x4*)(WT + ((size_t)(nn >> 8) * (K >> 6) + (k0 >> 6)) * (256 * 64) + (size_t)(nn & 255) * 64 + 8 * c) = o;
        else *(u32x4*)(WT + (size_t)nn * K + k0 + 8 * c) = o; }
}
template <bool TILED>
__device__ __forceinline__ void tr_item(const float* W, int ldw, bf16* WT, int K, int n0, int srccol, int k0, LAS float* scr, int lane) {
    float tv[32]; const int sc_ = (srccol >= 0) ? srccol : 0;
#pragma unroll
    for (int i = 0; i < 32; ++i) tv[i] = W[(size_t)(k0 + 2 * i + (lane >> 5)) * ldw + sc_];
#pragma unroll
    for (int i = 0; i < 32; ++i) scr[(2 * i + (lane >> 5)) * 33 + (lane & 31)] = (srccol >= 0) ? tv[i] : 0.f;
    LDS_WAIT(); asm volatile("" ::: "memory");
    tr_store<TILED>(scr, WT, K, n0, k0, lane);
    LDS_WAIT(); asm volatile("" ::: "memory");
}

constexpr int IT_W1 = 16 * 176, IT_W2 = 44 * 32, IT_WIN = 16 * 72, IT_WO = 8 * 32, IT_WE = 8 * 32, IT_QK = 8;
constexpr int IT_TOTAL = 2 * IT_W1 + 2 * IT_W2 + IT_WIN + IT_WO + IT_WE + 8 * IT_QK;

__device__ __forceinline__ void p0_wave_item(const Ctx& F, int it, LAS float* scr) {
    const int lane = F.lane, ln = lane & 31;
    int r = it;
    if (r < 2 * IT_W1) { const int f = r / IT_W1; r -= f * IT_W1; const int kb = r / 176, nb = r % 176, n0 = 32 * nb, pn = n0 >> 8, i = (n0 & 255) + ln;
        const int src = (i < 128) ? 128 * pn + i : FF + 128 * pn + (i - 128);
        tr_item<true>(F.fwin + (size_t)f * DM * 2 * FF, 2 * FF, F.W1 + (size_t)f * 2 * FF * DM, DM, n0, src, 64 * kb, scr, lane); return; }
    r -= 2 * IT_W1;
    if (r < 2 * IT_W2) { const int f = r / IT_W2; r -= f * IT_W2; const int kb = r / 32, nb = r % 32;
        tr_item<true>(F.fwout + (size_t)f * FF * DM, DM, F.W2 + (size_t)f * DM * FF, FF, 32 * nb, 32 * nb + ln, 64 * kb, scr, lane); return; }
    r -= 2 * IT_W2;
    if (r < IT_WIN) { const int kb = r / 72, nb = r % 72, n = 32 * nb + ln;
        const int src = (n < 1536) ? n : (n < 2048) ? n + 16 : (n < 2064) ? n - 512 : -1;
        tr_item<true>(F.win, 2064, F.WIN, DM, 32 * nb, src, 64 * kb, scr, lane); return; }
    r -= IT_WIN;
    if (r < IT_WO) { const int kb = r / 32, nb = r % 32;
        tr_item<true>(F.wout, DM, F.WOUT, DM, 32 * nb, 32 * nb + ln, 64 * kb, scr, lane); return; }
    r -= IT_WO;
    if (r < IT_WE) { const int kb = r / 32, nb = r % 32, g = kb >> 1, kk0 = 64 * (kb & 1), n0 = 32 * nb, fr = lane & 15, fq = lane >> 4;
        const float* pw = F.poolw + (size_t)g * 128 * 128 + (size_t)(kk0 + fr) * 128; const float* ps = F.pscale + g * 128; const float* wo = F.wout + (size_t)(512 + g * 128) * DM + n0 + fr;
        f32x4 acc[4][2];
#pragma unroll
        for (int mt = 0; mt < 4; ++mt) { acc[mt][0] = (f32x4){0.f, 0.f, 0.f, 0.f}; acc[mt][1] = acc[mt][0]; }
#pragma unroll 4
        for (int ks = 0; ks < 32; ++ks) { const int e = 4 * ks + fq; const float pse = ps[e]; const float b0 = wo[(size_t)e * DM], b1 = wo[(size_t)e * DM + 16];
#pragma unroll
            for (int mt = 0; mt < 4; ++mt) { const float a = pw[(size_t)(16 * mt) * 128 + e] * pse;
                acc[mt][0] = __builtin_amdgcn_mfma_f32_16x16x4f32(a, b0, acc[mt][0], 0, 0, 0); acc[mt][1] = __builtin_amdgcn_mfma_f32_16x16x4f32(a, b1, acc[mt][1], 0, 0, 0); } }
#pragma unroll
        for (int mt = 0; mt < 4; ++mt)
#pragma unroll
            for (int nt = 0; nt < 2; ++nt)
#pragma unroll
                for (int e = 0; e < 4; ++e) scr[(16 * mt + 4 * fq + e) * 33 + 16 * nt + fr] = acc[mt][nt][e];
        LDS_WAIT(); asm volatile("" ::: "memory");
        tr_store<true>(scr, F.WOUT, DM, n0, 512 + 64 * kb, lane);
        LDS_WAIT(); asm volatile("" ::: "memory"); return; }
    r -= IT_WE;
    { const int which = r / (4 * IT_QK); r -= which * 4 * IT_QK; const int h = r / IT_QK; r -= h * IT_QK; const int kb = r / 4, nb = r % 4;
      const float* W = (which ? F.wk : F.wq) + (size_t)h * 128 * 128; bf16* WT = (which ? F.wkt : F.wqt) + (size_t)h * 128 * 128;
      tr_item<false>(W, 128, WT, 128, 32 * nb, 32 * nb + ln, 64 * kb, scr, lane); }
}

__device__ __forceinline__ void p0_prologue(const Ctx& F) {
    LAS float* scl = (LAS float*)(F.lds + P0_SC_OFF); LAS float* red = (LAS float*)(F.lds + P0_RED_OFF);
    for (int j = F.bid; j < 144; j += F.G) {
        for (int i = F.tid; i < 3072; i += NTHREADS) { const int b = i >> 10, k = i & 1023; const float v = (b < 2) ? F.c[b * DM + k] : F.cctx[k]; scl[i] = v / (1.0f + expf(-v)); }
        __syncthreads();
        const int col = 64 * j + F.lane, k0 = 128 * F.wave; float a0 = 0.f, a1 = 0.f, a2 = 0.f;
#pragma unroll 32
        for (int kk = 0; kk < 128; ++kk) { const float wv = F.wmod[(size_t)(k0 + kk) * (NMOD * DM) + col]; a0 += scl[k0 + kk] * wv; a1 += scl[1024 + k0 + kk] * wv; a2 += scl[2048 + k0 + kk] * wv; }
        red[(F.wave * 3 + 0) * 64 + F.lane] = a0; red[(F.wave * 3 + 1) * 64 + F.lane] = a1; red[(F.wave * 3 + 2) * 64 + F.lane] = a2;
        __syncthreads();
        if (F.tid < 192) { const int b = F.tid >> 6, l = F.tid & 63; float s = 0.f;
#pragma unroll
            for (int w = 0; w < 8; ++w) s += red[(w * 3 + b) * 64 + l];
            F.mod[b * (NMOD * DM) + 64 * j + l] = s + F.bmod[64 * j + l]; }
        __syncthreads();
    }
}
constexpr int IT_PART0 = IT_W1 + IT_W2, IT_PART1 = IT_TOTAL - IT_PART0;
__device__ __forceinline__ void convert_items(const Ctx& F, int part, int first_block, int nblocks, int idx_lo = 0, int idx_hi = 1 << 30) {
    if (F.bid < first_block || F.bid >= first_block + nblocks) return;
    LAS float* scr = (LAS float*)(F.lds + F.wave * TP0_SCR);
    const int gw = (F.bid - first_block) * NWAVES + F.wave, NGW = nblocks * NWAVES, n = min(part ? IT_PART1 : IT_PART0, idx_hi);
    for (int idx = idx_lo + gw; idx < n; idx += NGW) {
        int it;
        if (part == 0) it = (idx < IT_W1) ? idx : 2 * IT_W1 + (idx - IT_W1);
        else it = (idx < IT_W1) ? IT_W1 + idx : (idx < IT_W1 + IT_W2) ? 2 * IT_W1 + IT_W2 + (idx - IT_W1) : 2 * IT_W1 + 2 * IT_W2 + (idx - IT_W1 - IT_W2);
        p0_wave_item(F, it, scr); }
}

__device__ __forceinline__ void ld_row_f32(const float* row, int lane, f32x4 (&v)[4]) {
    v[0] = *(const f32x4*)(row + 8 * lane); v[1] = *(const f32x4*)(row + 8 * lane + 4); v[2] = *(const f32x4*)(row + 512 + 8 * lane); v[3] = *(const f32x4*)(row + 512 + 8 * lane + 4); }
__device__ __forceinline__ void st_row_f32(float* row, int lane, const f32x4 (&v)[4]) {
    *(f32x4*)(row + 8 * lane) = v[0]; *(f32x4*)(row + 8 * lane + 4) = v[1]; *(f32x4*)(row + 512 + 8 * lane) = v[2]; *(f32x4*)(row + 512 + 8 * lane + 4) = v[3]; }
__device__ __forceinline__ void unpack_row(const u32x4 (&w)[2], f32x4 (&v)[4]) {
#pragma unroll
    for (int h = 0; h < 2; ++h) { v[2 * h] = (f32x4){bflo(w[h].x), bfhi(w[h].x), bflo(w[h].y), bfhi(w[h].y)}; v[2 * h + 1] = (f32x4){bflo(w[h].z), bfhi(w[h].z), bflo(w[h].w), bfhi(w[h].w)}; } }
__device__ __forceinline__ void st_row_bf16(bf16* row, int lane, const f32x4 (&v)[4]) {
#pragma unroll
    for (int h = 0; h < 2; ++h) { u32x4 w; w.x = pk2(v[2 * h].x, v[2 * h].y); w.y = pk2(v[2 * h].z, v[2 * h].w); w.z = pk2(v[2 * h + 1].x, v[2 * h + 1].y); w.w = pk2(v[2 * h + 1].z, v[2 * h + 1].w);
        *(u32x4*)(row + 512 * h + 8 * lane) = w; } }
__device__ __forceinline__ float sumsq_row(const f32x4 (&v)[4]) { float ss = 0.f;
#pragma unroll
    for (int j = 0; j < 4; ++j) ss += (v[j].x * v[j].x + v[j].y * v[j].y) + (v[j].z * v[j].z + v[j].w * v[j].w);
    return ss; }
template <bool HAS_Z, int XSRC, int XDST, bool WRITE_Y>
__device__ __forceinline__ void row_phase(const Ctx& F, int nrows, float resw, int jsub) {
    const int gw = F.bid * NWAVES + F.wave, NGW = F.G * NWAVES, lane = F.lane;
    constexpr int NR = 2;
#pragma unroll 1
    for (int seg = 0; seg < 3; ++seg) {
        const int s_lo = (seg < 2) ? seg * SEQ : ML, s_hi = min((seg < 2) ? (seg + 1) * SEQ : MT, nrows);
        if (s_lo + gw >= s_hi) continue;
        const int mb = seg;
        f32x4 gv[4], sv[4], cv[4];
        if (HAS_Z) { const int js = jsub - 1; f32x4 ga[4], gg[4];
            ld_row_f32(F.mod + (size_t)mb * (NMOD * DM) + (3 * js + 2) * DM, lane, ga); ld_row_f32(F.npost + js * DM, lane, gg);
#pragma unroll
            for (int j = 0; j < 4; ++j) gv[j] = ga[j] * gg[j] * resw; }
        if (WRITE_Y) { const float* sh = F.mod + (size_t)mb * (NMOD * DM) + (3 * jsub) * DM; f32x4 c4[4], g4[4];
            ld_row_f32(sh, lane, sv); ld_row_f32(sh + DM, lane, c4); ld_row_f32(F.npre + jsub * DM, lane, g4);
#pragma unroll
            for (int j = 0; j < 4; ++j) cv[j] = g4[j] * (c4[j] + 1.0f); }
#pragma unroll 1
        for (int r0 = s_lo + gw; r0 < s_hi; r0 += NR * NGW) {
            int rws[NR]; bool okr[NR]; f32x4 v[NR][4]; u32x4 xw[NR][2], zw[NR][2];
#pragma unroll
            for (int q = 0; q < NR; ++q) { const int r = r0 + q * NGW; okr[q] = r < s_hi; rws[q] = okr[q] ? r : r0; }
#pragma unroll
            for (int q = 0; q < NR; ++q) {
                if (XSRC == 0) ld_row_f32((rws[q] < ML) ? F.x + (size_t)rws[q] * DM : F.ctx + (size_t)(rws[q] - ML) * DM, lane, v[q]);
                else { xw[q][0] = *(const u32x4*)(F.XB + (size_t)rws[q] * DM + 8 * lane); xw[q][1] = *(const u32x4*)(F.XB + (size_t)rws[q] * DM + 512 + 8 * lane); }
                if (HAS_Z) { zw[q][0] = *(const u32x4*)(F.Z + (size_t)rws[q] * DM + 8 * lane); zw[q][1] = *(const u32x4*)(F.Z + (size_t)rws[q] * DM + 512 + 8 * lane); } }
#pragma unroll
            for (int q = 0; q < NR; ++q) { const int r = rws[q];
                if (XSRC == 1) unpack_row(xw[q], v[q]);
                if (HAS_Z) {
                    f32x4 z[4]; unpack_row(zw[q], z);
                    const float rz = rsqrtf(wave_sum(sumsq_row(z)) * (1.0f / DM) + EPS);
#pragma unroll
                    for (int j = 0; j < 4; ++j) v[q][j] = v[q][j] + (z[j] * rz) * gv[j];
                    if (XDST == 1 && r < ML && okr[q]) st_row_bf16(F.XB + (size_t)r * DM, lane, v[q]);
                    if (XDST == 2 && okr[q]) st_row_f32(F.out + (size_t)r * DM, lane, v[q]);
                }
                if (WRITE_Y) {
                    const float rr = rsqrtf(wave_sum(sumsq_row(v[q])) * (1.0f / DM) + EPS); f32x4 y[4];
#pragma unroll
                    for (int j = 0; j < 4; ++j) y[j] = (v[q][j] * rr) * cv[j] + sv[j];
                    if (okr[q]) {
                        bf16* yt = F.Y + (size_t)(r >> 8) * (256 * DM) + (size_t)(r & 255) * 64 + (size_t)(lane >> 3) * (256 * 64) + 8 * (lane & 7);
#pragma unroll
                        for (int h = 0; h < 2; ++h) { u32x4 w; w.x = pk2(y[2 * h].x, y[2 * h].y); w.y = pk2(y[2 * h].z, y[2 * h].w); w.z = pk2(y[2 * h + 1].x, y[2 * h + 1].y); w.w = pk2(y[2 * h + 1].z, y[2 * h + 1].w);
                            *(u32x4*)(yt + (size_t)h * 8 * (256 * 64)) = w; } }
                }
            }
        }
    }
}

constexpr int TP = 272, TILE_B = 128 * TP;
__device__ __forceinline__ bf16x8 ldfrag(LAS unsigned char* tile, int row, int kk, int fq) { return *(const LAS bf16x8*)(tile + row * TP + (32 * kk + 8 * fq) * 2); }
__device__ __forceinline__ void st4(LAS unsigned char* tile, int row, int col, float a, float b, float c, float d) { u32x2 w; w.x = pk2(a, b); w.y = pk2(c, d); *(LAS u32x2*)(tile + row * TP + col * 2) = w; }
__device__ __forceinline__ bf16x8 ident_frag(int nt, int fr, int fq) { const int jj = 16 * (nt & 1) + fr - 8 * fq; bf16x8 f;
#pragma unroll
    for (int j = 0; j < 8; ++j) f[j] = (j == jj) ? (short)0x3F80 : (short)0;
    return f; }
constexpr float LOG2E = 1.4426950408889634f, LN2 = 0.6931471805599453f;
__device__ __forceinline__ float fexp(float x) { return __builtin_amdgcn_exp2f(x * LOG2E); }
__device__ __forceinline__ float fsigmoid(float x) { return __builtin_amdgcn_rcpf(1.0f + fexp(-x)); }
__device__ __forceinline__ float flog_sigmoid(float x) { return fminf(x, 0.f) - LN2 * __builtin_amdgcn_logf(1.0f + fexp(-fabsf(x))); }
struct GateScan { float ip0, ip1, b0, b1, g; int tau0, tau1; };
__device__ __forceinline__ GateScan gate_scan(const float* gates, int R0, int dir, int h, int lane) {
    GateScan r; r.tau0 = dir ? 127 - 2 * lane : 2 * lane; r.tau1 = dir ? r.tau0 - 1 : r.tau0 + 1;
    const float* gr = gates + (size_t)R0 * 16 + dir * 4 + h;
    r.ip0 = gr[r.tau0 * 16]; r.ip1 = gr[r.tau1 * 16];
    const float lf0 = flog_sigmoid(gr[r.tau0 * 16 + 8]), lf1 = flog_sigmoid(gr[r.tau1 * 16 + 8]);
    const float s = lf0 + lf1; float incl = s;
#pragma unroll
    for (int o = 1; o < 64; o <<= 1) { const float t = __shfl_up(incl, o); if (lane >= o) incl += t; }
    r.b0 = incl - s + lf0; r.b1 = incl; r.g = __shfl(incl, 63);
    return r;
}
__device__ __forceinline__ void make_vt(const bf16* vrow  , LAS unsigned char* VT, int w, int fr, int fq) {
#pragma unroll
    for (int nt = 0; nt < 8; ++nt) { const bf16x8 vf = *(const bf16x8*)(vrow + 32 * (nt >> 1) + 8 * fq);
        const f32x4 a = mfma16(vf, ident_frag(nt, fr, fq), (f32x4){0.f, 0.f, 0.f, 0.f});
        st4(VT, 16 * nt + fr, 16 * w + 4 * fq, a[0], a[1], a[2], a[3]); }
}

constexpr int M1_U = 0, M1_KW0 = TILE_B, M1_KW1 = 2 * TILE_B, M1_VT = 3 * TILE_B, M1_WGT = 4 * TILE_B;
constexpr int M1_UNITS = NB * NH * NTB;
struct M1Pre { u32x4 cu[4], pv[4], nx[4]; bf16x8 vf[8]; float gi0, gi1, gf0, gf1; };
__device__ __forceinline__ void m1_geom(int unit, int& bh, int& tb, int& R0, int& t0, int& L) {
    bh = unit & 7; tb = unit >> 3; const int b = bh >> 2; const bool isctx = tb < 2;
    R0 = isctx ? ML + b * CTXL + tb * 128 : b * SEQ + (tb - 2) * 128; t0 = isctx ? tb * 128 : (tb - 2) * 128; L = isctx ? CTXL : SEQ; }
__device__ __forceinline__ void m1_load(const Ctx& F, int unit, M1Pre& P) {
    const int tid = F.tid, lane = F.lane, w = F.wave, fr = lane & 15, fq = lane >> 4;
    int bh, tb, R0, t0, L; m1_geom(unit, bh, tb, R0, t0, L); const int h = bh & 3;
    const bf16* pb = F.P + (size_t)R0 * 2048 + h * 128;
    { const unsigned tau0 = tid >> 4, c8 = (tid & 15) * 8;
#pragma unroll
      for (int it = 0; it < 4; ++it) { const int tau = tau0 + 32 * it; const bool hp = (t0 + tau > 0), hn_ = (t0 + tau < L - 1);
          const unsigned o = opaque((tau * 2048 + c8) * 2); const char* pp = (const char*)pb + o;
          P.cu[it] = *(const u32x4*)pp; P.pv[it] = *(const u32x4*)(hp ? pp - 4096 : pp); P.nx[it] = *(const u32x4*)(hn_ ? pp + 4096 : pp); } }
    { const int dir = w & 1, tau0 = dir ? 127 - 2 * lane : 2 * lane, tau1 = dir ? tau0 - 1 : tau0 + 1;
      const float* gr = F.gates + (size_t)R0 * 16 + dir * 4 + h;
      P.gi0 = gr[tau0 * 16]; P.gi1 = gr[tau1 * 16]; P.gf0 = gr[tau0 * 16 + 8]; P.gf1 = gr[tau1 * 16 + 8]; }
}
__device__ __forceinline__ void m1_load_v(const Ctx& F, int unit, M1Pre& P) {
    const int lane = F.lane, w = F.wave, fr = lane & 15, fq = lane >> 4;
    int bh, tb, R0, t0, L; m1_geom(unit, bh, tb, R0, t0, L); const int h = bh & 3;
    const bf16* pb = F.P + (size_t)R0 * 2048 + h * 128;
    const unsigned o = opaque((fr * 2048 + 512 + 32 * (w >> 1) + 8 * fq) * 2);
#pragma unroll
    for (int tt = 0; tt < 8; ++tt) P.vf[tt] = ldg<bf16x8>(pb + (size_t)16 * tt * 2048, o);
}
__device__ __forceinline__ void m1_phase(const Ctx& F) {
    const int tid = F.tid, lane = F.lane, w = F.wave, fr = lane & 15, fq = lane >> 4;
    LAS unsigned char* U = F.lds + M1_U; LAS unsigned char* VT = F.lds + M1_VT; LAS float* wgt = (LAS float*)(F.lds + M1_WGT);
    int unit = F.bid; if (unit >= M1_UNITS) return;
    const int h = unit & 3;
    bf16x8 wqf[4], wkf[4];
#pragma unroll
    for (int kk = 0; kk < 4; ++kk) { wqf[kk] = *(const bf16x8*)(F.wqt + (size_t)(h * 128 + 16 * w + fr) * 128 + 32 * kk + 8 * fq); wkf[kk] = *(const bf16x8*)(F.wkt + (size_t)(h * 128 + 16 * w + fr) * 128 + 32 * kk + 8 * fq); }
    M1Pre cur; m1_load(F, unit, cur); m1_load_v(F, unit, cur);
    if ((F.G & 7) != 0) return;
#pragma unroll 1
    for (;;) {
        int bh, tb, R0, t0, L; m1_geom(unit, bh, tb, R0, t0, L);
        { const int ch8 = (tid & 15) * 8, ch = h * 128 + ch8;
          f32x4 cw[3][2], cb[2];
#pragma unroll
          for (int jj = 0; jj < 3; ++jj) { cw[jj][0] = *(const f32x4*)(F.convw + jj * MW + ch); cw[jj][1] = *(const f32x4*)(F.convw + jj * MW + ch + 4); }
          cb[0] = *(const f32x4*)(F.convb + ch); cb[1] = *(const f32x4*)(F.convb + ch + 4);
#pragma unroll
          for (int it = 0; it < 4; ++it) { const int tau = (tid >> 4) + 32 * it; const bool hp = (t0 + tau > 0), hn_ = (t0 + tau < L - 1);
            const u32x4 cu = cur.cu[it]; u32x4 pv = cur.pv[it], nx = cur.nx[it];
            pv.x = hp ? pv.x : 0u; pv.y = hp ? pv.y : 0u; pv.z = hp ? pv.z : 0u; pv.w = hp ? pv.w : 0u; nx.x = hn_ ? nx.x : 0u; nx.y = hn_ ? nx.y : 0u; nx.z = hn_ ? nx.z : 0u; nx.w = hn_ ? nx.w : 0u;
            float o[8];
#pragma unroll
            for (int e = 0; e < 8; ++e) { const unsigned wc_ = cu[e >> 1], wp = pv[e >> 1], wn = nx[e >> 1];
                const float xc = (e & 1) ? bfhi(wc_) : bflo(wc_), xp = (e & 1) ? bfhi(wp) : bflo(wp), xn = (e & 1) ? bfhi(wn) : bflo(wn);
                const float val = cb[e >> 2][e & 3] + xp * cw[0][e >> 2][e & 3] + xc * cw[1][e >> 2][e & 3] + xn * cw[2][e >> 2][e & 3];
                o[e] = val * fsigmoid(val); }
            u32x4 ow; ow.x = pk2(o[0], o[1]); ow.y = pk2(o[2], o[3]); ow.z = pk2(o[4], o[5]); ow.w = pk2(o[6], o[7]);
            *(LAS u32x4*)(U + tau * TP + ch8 * 2) = ow; } }
        if (w < 2) { const int dir = w, tau0 = dir ? 127 - 2 * lane : 2 * lane, tau1 = dir ? tau0 - 1 : tau0 + 1;
            const float ip0 = cur.gi0, ip1 = cur.gi1, lf0 = flog_sigmoid(cur.gf0), lf1 = flog_sigmoid(cur.gf1);
            const float s_ = lf0 + lf1; float incl = s_;
#pragma unroll
            for (int o = 1; o < 64; o <<= 1) { const float t = __shfl_up(incl, o); if (lane >= o) incl += t; }
            const float b0 = incl - s_ + lf0, b1 = incl, g = __shfl(incl, 63);
            const float a0 = g - b0 + ip0, a1 = g - b1 + ip1, ml = wave_max(fmaxf(a0, a1));
            wgt[dir * 128 + tau0] = fexp(a0 - ml); wgt[dir * 128 + tau1] = fexp(a1 - ml);
            const int sidx = (bh * 2 + dir) * NTB + tb;
            if (lane == 0) { F.mloc[sidx] = ml; F.gsum[sidx] = g; }
            const float c0 = ip0 - b0, c1 = ip1 - b1;
            float pm = fmaxf(c0, c1);
#pragma unroll
            for (int o = 1; o < 64; o <<= 1) { const float t = __shfl_up(pm, o); if (lane >= o) pm = fmaxf(pm, t); }
            float pmx = __shfl_up(pm, 1); if (lane == 0) pmx = -INFINITY;
            float* gbp = F.gb + (size_t)sidx * 384;
            gbp[tau0] = b0; gbp[tau1] = b1; gbp[128 + tau0] = c0; gbp[128 + tau1] = c1; gbp[256 + tau0] = fmaxf(pmx, c0); gbp[256 + tau1] = pm; }
        const int unext = unit + F.G; const bool has_next = unext < M1_UNITS;
        m1_load(F, has_next ? unext : unit, cur);
        LDS_BARRIER();
        { const bf16x8 idf = ident_frag(w, fr, fq); const float ksc = 0.08838834764831845f;
          bf16* qb = F.Q + (size_t)R0 * 512 + h * 128 + 16 * w; bf16* kb = F.K + (size_t)R0 * 512 + h * 128 + 16 * w;
          const unsigned go = opaque((fr * 512 + 4 * fq) * 2), fb16 = opaque(fr * TP + fq * 16), sb = opaque((16 * w + fr) * TP + 8 * fq);
#pragma unroll
          for (int tt = 0; tt < 8; ++tt) { bf16x8 uf[4];
#pragma unroll
              for (int kk = 0; kk < 4; ++kk) uf[kk] = *(const LAS bf16x8*)(U + fb16 + 16 * tt * TP + 64 * kk);
              f32x4 q = (f32x4){0.f, 0.f, 0.f, 0.f}, k = q, k2 = q;
#pragma unroll
              for (int kk = 0; kk < 4; ++kk) { q = mfma16(wqf[kk], uf[kk], q); k = mfma16(wkf[kk], uf[kk], k); k2 = mfma16(uf[kk], wkf[kk], k2); }
              { u32x2 o; o.x = pk2(q[0], q[1]); o.y = pk2(q[2], q[3]); stg<u32x2>(qb + (size_t)16 * tt * 512, go, o); }
              { u32x2 o; o.x = pk2(k[0] * ksc, k[1] * ksc); o.y = pk2(k[2] * ksc, k[3] * ksc); stg<u32x2>(kb + (size_t)16 * tt * 512, go, o); }
#pragma unroll
              for (int dir = 0; dir < 2; ++dir) { const f32x4 wv = *(const LAS f32x4*)(wgt + dir * 128 + 16 * tt + 4 * fq);
                  u32x2 o; o.x = pk2(k2[0] * ksc * wv[0], k2[1] * ksc * wv[1]); o.y = pk2(k2[2] * ksc * wv[2], k2[3] * ksc * wv[3]);
                  *(LAS u32x2*)(F.lds + (dir ? M1_KW1 : M1_KW0) + sb + 32 * tt) = o; }
              const f32x4 a = mfma16(cur.vf[tt], idf, (f32x4){0.f, 0.f, 0.f, 0.f});
              { u32x2 o; o.x = pk2(a[0], a[1]); o.y = pk2(a[2], a[3]); *(LAS u32x2*)(VT + sb + 32 * tt) = o; } } }
        m1_load_v(F, has_next ? unext : unit, cur);
        LDS_BARRIER();
        { const unsigned fb16 = opaque(fr * TP + fq * 16); bf16x8 vtf[4];
#pragma unroll
          for (int kk = 0; kk < 4; ++kk) vtf[kk] = *(const LAS bf16x8*)(VT + fb16 + 16 * w * TP + 64 * kk);
#pragma unroll
          for (int dir = 0; dir < 2; ++dir) { LAS unsigned char* KW = F.lds + (dir ? M1_KW1 : M1_KW0);
              const int cs = dir ? (tb < 2 ? 1 - tb : 131 - tb) : tb;
              bf16* cg_ = F.CKV + ((size_t)((bh * 2 + dir) * NTB + cs)) * 16384 + (size_t)16 * w * 128;
              const unsigned co = opaque((fr * 128 + 4 * fq) * 2);
              f32x4 acc[8];
#pragma unroll
              for (int mt = 0; mt < 8; ++mt) acc[mt] = (f32x4){0.f, 0.f, 0.f, 0.f};
#pragma unroll
              for (int kk = 0; kk < 4; ++kk) { bf16x8 kf[8];
#pragma unroll
                  for (int mt = 0; mt < 8; ++mt) kf[mt] = *(const LAS bf16x8*)(KW + fb16 + 16 * mt * TP + 64 * kk);
#pragma unroll
                  for (int mt = 0; mt < 8; ++mt) acc[mt] = mfma16(kf[mt], vtf[kk], acc[mt]); }
#pragma unroll
              for (int mt = 0; mt < 8; ++mt) { u32x2 o; o.x = pk2(acc[mt][0], acc[mt][1]); o.y = pk2(acc[mt][2], acc[mt][3]); stg<u32x2>(cg_ + 16 * mt, co, o); } } }
        if (tid < 256) { const int dir = tid >> 7, dk = tid & 127; LAS unsigned char* KW = F.lds + (dir ? M1_KW1 : M1_KW0) + dk * TP; float s_ = 0.f;
#pragma unroll
            for (int c = 0; c < 16; ++c) { const u32x4 q = *(const LAS u32x4*)(KW + 16 * c); s_ += (bflo(q.x) + bfhi(q.x)) + (bflo(q.y) + bfhi(q.y)) + (bflo(q.z) + bfhi(q.z)) + (bflo(q.w) + bfhi(q.w)); }
            const int cs = dir ? (tb < 2 ? 1 - tb : 131 - tb) : tb;
            F.cn[((size_t)((bh * 2 + dir) * NTB + cs)) * 128 + dk] = s_; }
        if (!has_next) break;
        unit = unext;
    }
}

template <int G_>
__device__ __forceinline__ void pool_unit_t(const Ctx& F, int b, int r) {
    constexpr int win = 2 << G_, lo = win >> 1, hi = win - 1 - lo;
    const int tid = F.tid, chunk = tid & 15, cb = tid >> 4;
    const int rlo = max(r - lo, 0), rhi = min(r + hi, GRID_ROWS - 1); const float cntr = (float)(rhi - rlo + 1);
    LAS float* vs = (LAS float*)F.lds;
    const bf16* base = F.P + (size_t)b * SEQ * 2048 + 1536 + G_ * 128;
    const unsigned off = opaque((cb * 2048 + 8 * chunk) * 2);
    f32x4 s[2][2];
#pragma unroll
    for (int k = 0; k < 2; ++k) { s[k][0] = (f32x4){0.f, 0.f, 0.f, 0.f}; s[k][1] = s[k][0]; }
#pragma unroll
    for (int i = 0; i < win; ++i) { const int rr = r - lo + i; const bool ok = (rr >= 0) && (rr < GRID_ROWS); const int rc = min(max(rr, 0), GRID_ROWS - 1);
#pragma unroll
        for (int k = 0; k < 2; ++k) { u32x4 wv = ldg<u32x4>(base + (size_t)(rc * GW + 32 * k) * 2048, off);
            wv.x = ok ? wv.x : 0u; wv.y = ok ? wv.y : 0u; wv.z = ok ? wv.z : 0u; wv.w = ok ? wv.w : 0u;
            s[k][0] = s[k][0] + (f32x4){bflo(wv.x), bfhi(wv.x), bflo(wv.y), bfhi(wv.y)}; s[k][1] = s[k][1] + (f32x4){bflo(wv.z), bfhi(wv.z), bflo(wv.w), bfhi(wv.w)}; } }
    u32x4 ctr[2];
#pragma unroll
    for (int k = 0; k < 2; ++k) { ctr[k] = ldg<u32x4>(base + (size_t)(r * GW + 32 * k) * 2048, off);
        LAS float* vp = vs + (cb + 32 * k) * 128 + 8 * chunk; *(LAS f32x4*)vp = s[k][0]; *(LAS f32x4*)(vp + 4) = s[k][1]; }
    LDS_BARRIER();
#pragma unroll
    for (int k = 0; k < 2; ++k) { const int c = cb + 32 * k, clo = max(c - lo, 0), chi = min(c + hi, GW - 1); f32x4 t0 = (f32x4){0.f, 0.f, 0.f, 0.f}, t1 = t0;
#pragma unroll
        for (int i = 0; i < win; ++i) { const int c2 = c - lo + i; const bool ok = (c2 >= 0) && (c2 < GW); const LAS float* vp = vs + min(max(c2, 0), GW - 1) * 128 + 8 * chunk;
            const f32x4 a0 = *(const LAS f32x4*)vp, a1 = *(const LAS f32x4*)(vp + 4); const float m_ = ok ? 1.f : 0.f; t0 = t0 + a0 * m_; t1 = t1 + a1 * m_; }
        const float inv = 1.0f / (cntr * (float)(chi - clo + 1)); const u32x4 cw = ctr[k];
        u32x4 o; o.x = pk2(t0[0] * inv - bflo(cw.x), t0[1] * inv - bfhi(cw.x)); o.y = pk2(t0[2] * inv - bflo(cw.y), t0[3] * inv - bfhi(cw.y));
        o.z = pk2(t1[0] * inv - bflo(cw.z), t1[1] * inv - bfhi(cw.z)); o.w = pk2(t1[2] * inv - bflo(cw.w), t1[3] * inv - bfhi(cw.w));
        { const int row = b * SEQ + r * GW + c, col = 512 + G_ * 128 + 8 * chunk;
          *(u32x4*)(F.MIX + (size_t)(row >> 8) * (256 * 1024) + (size_t)(col >> 6) * (256 * 64) + (size_t)(row & 255) * 64 + (col & 63)) = o; } }
    LDS_BARRIER();
}
__device__ __forceinline__ void pool_unit(const Ctx& F, int unit) {
    const int k = unit / GRID_ROWS, r = unit % GRID_ROWS, b = k >> 2, g = (r + k) & 3;
    if (g == 0) pool_unit_t<0>(F, b, r); else if (g == 1) pool_unit_t<1>(F, b, r); else if (g == 2) pool_unit_t<2>(F, b, r); else pool_unit_t<3>(F, b, r);
}

__device__ __forceinline__ void scan_phase(const Ctx& F) {
    const int nslots = 16 * 4096; constexpr int NA = 256;
    LAS float* sg = (LAS float*)F.lds;
    for (int base = F.bid * NA; base < nslots; base += F.G * NA) {
        const int slot = base + (F.tid & (NA - 1)), stream = base >> 12, pq = slot & 4095, dir = stream & 1; const bool active = F.tid < NA;
        __syncthreads();
        if (F.tid < NTB) { const int c = F.tid, tb = dir ? (c < 2 ? 1 - c : 131 - c) : c; const size_t sidx = (size_t)stream * NTB + tb; sg[c] = F.gsum[sidx]; sg[NTB + c] = F.mloc[sidx]; }
        __syncthreads();
        if (!active) continue;
        const long cstep = dir ? -1 : 1; const int tb0 = dir ? 129 : 2;
        if (pq < 32) {
            f32x4 nv = (f32x4){0.f, 0.f, 0.f, 0.f}; float m = 0.f;
            const float* cnp = F.cn + (size_t)stream * NTB * 128 + 4 * pq; float* ninp = F.nin + ((size_t)stream * NTB + tb0) * 128 + 4 * pq; float* minp = F.min_ + (size_t)stream * NTB + tb0;
#pragma unroll 1
            for (int c0 = 0; c0 < NTB; c0 += 26) { f32x4 cnv[26];
#pragma unroll
                for (int i = 0; i < 26; ++i) cnv[i] = *(const f32x4*)(cnp + (size_t)(c0 + i) * 128);
#pragma unroll
                for (int i = 0; i < 26; ++i) { const int c = c0 + i;
                    if (c >= 2) { *(f32x4*)(ninp + cstep * (long)(c - 2) * 128) = nv; if (pq == 0) minp[cstep * (long)(c - 2)] = m; }
                    const float gi = sg[c], mi = sg[NTB + c];
                    const float mn = fmaxf(gi + m, mi), ao = fexp(gi + m - mn), an = fexp(mi - mn);
                    nv = nv * ao + cnv[i] * an; m = mn; } } }
        f32x4 C = (f32x4){0.f, 0.f, 0.f, 0.f}; float m = 0.f;
        const bf16* ckv = F.CKV + (size_t)stream * NTB * 16384 + 4 * pq; bf16* cin = F.CIN + ((size_t)stream * 128 + (tb0 - 2)) * 16384 + 4 * pq;
#pragma unroll 1
        for (int c0 = 0; c0 < NTB; c0 += 26) {
            u32x2 ck[26];
#pragma unroll
            for (int i = 0; i < 26; ++i) ck[i] = *(const u32x2*)(ckv + (size_t)(c0 + i) * 16384);
#pragma unroll
            for (int i = 0; i < 26; ++i) { const int c = c0 + i;
                if (c >= 2) { u32x2 o; o.x = pk2(C[0], C[1]); o.y = pk2(C[2], C[3]); *(u32x2*)(cin + cstep * (long)(c - 2) * 16384) = o; }
                const float gi = sg[c], mi = sg[NTB + c];
                const float mn = fmaxf(gi + m, mi), ao = fexp(gi + m - mn), an = fexp(mi - mn);
                C = C * ao + (f32x4){bflo(ck[i].x), bfhi(ck[i].x), bflo(ck[i].y), bfhi(ck[i].y)} * an; m = mn; }
        }
    }
    __syncthreads();
}

constexpr int M3_K = 0, M3_VT = TILE_B, M3_CT0 = 2 * TILE_B, M3_CT1 = 3 * TILE_B, M3_MISC = 4 * TILE_B;
constexpr int M3_UNITS = NB * NH * 128;
struct M3Pre { u32x4 kr[4]; };
__device__ __forceinline__ void m3_decode(int unit, int& bh, int& j) { bh = unit & 7; j = unit >> 3; }
__device__ __forceinline__ void m3_load(const Ctx& F, int unit, M3Pre& P) {
    const int tid = F.tid;
    int bh, j; m3_decode(unit, bh, j); const int h = bh & 3, b = bh >> 2, R0 = b * SEQ + j * 128;
    const bf16* kb = F.K + (size_t)R0 * 512 + h * 128;
    const unsigned row0 = tid >> 4, c8 = (tid & 15) * 8;
    const unsigned ok_ = opaque((row0 * 512 + c8) * 2);
#pragma unroll
    for (int it = 0; it < 4; ++it) P.kr[it] = ldg<u32x4>(kb + (size_t)it * 32 * 512, ok_);
}
__device__ __forceinline__ void m3_phase(const Ctx& F) {
    const int tid = F.tid, lane = F.lane, w = F.wave, fr = lane & 15, fq = lane >> 4;
    LAS unsigned char* Kt = F.lds + M3_K; LAS unsigned char* VT = F.lds + M3_VT;
    LAS float* rt2 = (LAS float*)(F.lds + M3_MISC); LAS float* ct2 = rt2 + 256; LAS float* winter = rt2 + 512; LAS float* minv = rt2 + 768; LAS float* ninl = rt2 + 1024;
    int unit = F.bid; if (unit >= M3_UNITS) return;
    M3Pre cur; m3_load(F, unit, cur);
    const int t = 16 * w + fr;
#pragma unroll 1
    for (;;) {
        int bh, j; m3_decode(unit, bh, j); const int h = bh & 3, b = bh >> 2, R0 = b * SEQ + j * 128;
        bf16x8 qf[4], vr[4];
        { const bf16* vb = F.P + (size_t)R0 * 2048 + 512 + h * 128; const bf16* qb = F.Q + (size_t)R0 * 512 + h * 128; const unsigned tr = opaque(16 * w + fr);
#pragma unroll
          for (int kk = 0; kk < 4; ++kk) { vr[kk] = ldg<bf16x8>(vb, (tr * 2048 + 8 * fq + 32 * kk) * 2); qf[kk] = ldg<bf16x8>(qb, (tr * 512 + 32 * kk + 8 * fq) * 2); } }
        float g_b, g_c, g_pm, g_min, g_nin;
        { const unsigned t2 = tid & 255, dir = t2 >> 7, tau = t2 & 127; const size_t s0 = (size_t)(bh * 2) * NTB + j + 2;
          const unsigned so = opaque(dir * NTB);
          g_b = ldg<float>(F.gb + s0 * 384, (so * 384 + tau) * 4); g_c = ldg<float>(F.gb + s0 * 384, (so * 384 + 128 + tau) * 4); g_pm = ldg<float>(F.gb + s0 * 384, (so * 384 + 256 + tau) * 4);
          g_min = ldg<float>(F.min_ + s0, so * 4); g_nin = ldg<float>(F.nin + s0 * 128, (so * 128 + tau) * 4); }
        u32x4 c0r[4], c1r[4];
        { const bf16* cin0 = F.CIN + ((size_t)(bh * 2 + 0) * 128 + j) * 16384; const bf16* cin1 = F.CIN + ((size_t)(bh * 2 + 1) * 128 + j) * 16384; const unsigned oc_ = opaque(((tid >> 4) * 128 + (tid & 15) * 8) * 2);
#pragma unroll
          for (int it = 0; it < 4; ++it) { c0r[it] = ldg<u32x4>(cin0 + (size_t)it * 32 * 128, oc_); c1r[it] = ldg<u32x4>(cin1 + (size_t)it * 32 * 128, oc_); } }
        LDS_BARRIER();
        { LAS unsigned char* wb = F.lds + opaque((tid >> 4) * TP + (tid & 15) * 16);
#pragma unroll
          for (int it = 0; it < 4; ++it) { *(LAS u32x4*)(wb + M3_K + it * 32 * TP) = cur.kr[it]; *(LAS u32x4*)(wb + M3_CT0 + it * 32 * TP) = c0r[it]; *(LAS u32x4*)(wb + M3_CT1 + it * 32 * TP) = c1r[it]; } }
        { const int fr_o = (int)opaque((unsigned)fr);
#pragma unroll
          for (int nt = 0; nt < 8; ++nt) { const f32x4 a = mfma16(vr[nt >> 1], ident_frag(nt, fr_o, fq), (f32x4){0.f, 0.f, 0.f, 0.f}); st4(VT, 16 * nt + fr_o, 16 * w + 4 * fq, a[0], a[1], a[2], a[3]); } }
        if (tid < 256) { const float mt_ = g_b + fmaxf(g_pm, g_min); LAS float* mb = (LAS float*)(F.lds + M3_MISC + opaque(tid * 4));
            mb[1024] = g_nin; mb[0] = (g_b - mt_) * LOG2E; mb[256] = g_c * LOG2E; mb[512] = fexp(g_b + g_min - mt_); mb[768] = fexp(-mt_); }
        const int unext = unit + F.G; const bool has_next = unext < M3_UNITS;
        m3_load(F, has_next ? unext : unit, cur);
        LDS_BARRIER();
        const unsigned fb16 = opaque(fr * TP + fq * 16), fb8 = opaque(fr * TP + fq * 8);
        const int dlt = (int)opaque((unsigned)(t - 4 * fq));
        f32x4 acc[8];
#pragma unroll
        for (int mt = 0; mt < 8; ++mt) acc[mt] = (f32x4){0.f, 0.f, 0.f, 0.f};
#pragma unroll
        for (int kk = 0; kk < 4; ++kk) { bf16x8 kf[8];
#pragma unroll
            for (int mt = 0; mt < 8; ++mt) kf[mt] = *(const LAS bf16x8*)(Kt + fb16 + 16 * mt * TP + 64 * kk);
#pragma unroll
            for (int mt = 0; mt < 8; ++mt) acc[mt] = mfma16(kf[mt], qf[kk], acc[mt]); }
        u32x2 sp[2][8]; float wi2[2], rdn[2];
#pragma unroll
        for (int dir = 0; dir < 2; ++dir) {
            const float rt = rt2[dir * 128 + t], wi = winter[dir * 128 + t], mi = minv[dir * 128 + t];
            const int sgn = dir ? -1 : 1, dl2 = (int)opaque((unsigned)(sgn * dlt));
            float dsum = 0.f;
#pragma unroll
            for (int mt = 0; mt < 8; ++mt) { const f32x4 ct = *(const LAS f32x4*)(ct2 + dir * 128 + 16 * mt + 4 * fq); float o[4];
#pragma unroll
                for (int e = 0; e < 4; ++e) { const bool ok = sgn * (16 * mt + e) <= dl2; o[e] = ok ? acc[mt][e] * __builtin_amdgcn_exp2f(rt + ct[e]) : 0.f; dsum += o[e]; }
                sp[dir][mt].x = pk2(o[0], o[1]); sp[dir][mt].y = pk2(o[2], o[3]); }
            dsum += __shfl_xor(dsum, 16); dsum += __shfl_xor(dsum, 32);
            float qn = 0.f;
#pragma unroll
            for (int kk = 0; kk < 4; ++kk)
#pragma unroll
                for (int e = 0; e < 8; ++e) qn += __uint_as_float(((unsigned)(unsigned short)qf[kk][e]) << 16) * ninl[dir * 128 + 32 * kk + 8 * fq + e];
            qn += __shfl_xor(qn, 16); qn += __shfl_xor(qn, 32);
            const float den = wi * qn + dsum; wi2[dir] = wi; rdn[dir] = 1.0f / fmaxf(fabsf(den), mi); }
        f32x4 Hs[8];
#pragma unroll
        for (int mt = 0; mt < 8; ++mt) Hs[mt] = (f32x4){0.f, 0.f, 0.f, 0.f};
#pragma unroll
        for (int dir = 0; dir < 2; ++dir) {
            LAS unsigned char* CT = F.lds + (dir ? M3_CT1 : M3_CT0);
#pragma unroll
            for (int mt = 0; mt < 8; ++mt) acc[mt] = (f32x4){0.f, 0.f, 0.f, 0.f};
#pragma unroll
            for (int kk = 0; kk < 4; ++kk) { bf16x8 cf[8];
#pragma unroll
                for (int mt = 0; mt < 8; ++mt) cf[mt] = *(const LAS bf16x8*)(CT + fb16 + 16 * mt * TP + 64 * kk);
#pragma unroll
                for (int mt = 0; mt < 8; ++mt) acc[mt] = mfma16(cf[mt], qf[kk], acc[mt]); }
            const float wi = wi2[dir], rden = rdn[dir];
#pragma unroll
            for (int mt = 0; mt < 8; ++mt) acc[mt] = acc[mt] * wi;
#pragma unroll
            for (int kk = 0; kk < 4; ++kk) {
                if (dir ? (2 * kk + 1 >= w) : (2 * kk <= w)) { u32x2 lo[8], hi[8];
                    const u32x4 bv = (u32x4){sp[dir][2 * kk].x, sp[dir][2 * kk].y, sp[dir][2 * kk + 1].x, sp[dir][2 * kk + 1].y};
#pragma unroll
                    for (int mt = 0; mt < 8; ++mt) { const LAS unsigned char* vp = VT + fb8 + 16 * mt * TP + 64 * kk; lo[mt] = *(const LAS u32x2*)vp; hi[mt] = *(const LAS u32x2*)(vp + 32); }
#pragma unroll
                    for (int mt = 0; mt < 8; ++mt) { const u32x4 av = (u32x4){lo[mt].x, lo[mt].y, hi[mt].x, hi[mt].y};
                        acc[mt] = mfma16(__builtin_bit_cast(bf16x8, av), __builtin_bit_cast(bf16x8, bv), acc[mt]); } } }
#pragma unroll
            for (int mt = 0; mt < 8; ++mt) Hs[mt] = Hs[mt] + acc[mt] * rden;
        }
        f32x4 hn[8]; u32x2 ogr[8]; const unsigned t_o = opaque((unsigned)t), fq_o = opaque((unsigned)fq);
#pragma unroll
        for (int mt = 0; mt < 8; ++mt) { hn[mt] = ldg<f32x4>(F.hnorm + h * 128 + 16 * mt, (4 * fq_o) * 4); ogr[mt] = ldg<u32x2>(F.P + (size_t)R0 * 2048 + 1024 + h * 128 + 16 * mt, (t_o * 2048 + 4 * fq_o) * 2); }
        float ss = 0.f;
#pragma unroll
        for (int mt = 0; mt < 8; ++mt) ss += (Hs[mt][0] * Hs[mt][0] + Hs[mt][1] * Hs[mt][1]) + (Hs[mt][2] * Hs[mt][2] + Hs[mt][3] * Hs[mt][3]);
        ss += __shfl_xor(ss, 16); ss += __shfl_xor(ss, 32);
        const float rr = rsqrtf(ss * (1.0f / HD) + EPS);
        bf16* mixb = F.MIX + (size_t)(R0 >> 8) * (256 * 1024) + (size_t)(2 * h) * (256 * 64) + (size_t)(R0 & 255) * 64;
#pragma unroll
        for (int mt = 0; mt < 8; ++mt) { const u32x2 ow = ogr[mt];
            const float o0 = bflo(ow.x), o1 = bfhi(ow.x), o2 = bflo(ow.y), o3 = bfhi(ow.y);
            u32x2 r; r.x = pk2(Hs[mt][0] * rr * hn[mt][0] * fsigmoid(o0), Hs[mt][1] * rr * hn[mt][1] * fsigmoid(o1));
            r.y = pk2(Hs[mt][2] * rr * hn[mt][2] * fsigmoid(o2), Hs[mt][3] * rr * hn[mt][3] * fsigmoid(o3));
            stg<u32x2>(mixb + (size_t)(mt >> 2) * (256 * 64) + 16 * (mt & 3), (t_o * 64 + 4 * fq_o) * 2, r); }
        if (!has_next) break;
        unit = unext;
    }
}

#define XB_TMO      128
#define XB_XCNT(j)  (256  + 64 * (j))
#define XB_XSUB(j)  (1280 + 64 * (j))
#define XB_XGEN(j)  (2304 + 64 * (j))
#define XB_TOP      3328
#define XB_TOPGEN   3392
#define XCD_BAR_WORDS 3456
#define XB_SPIN_CAP (1u << 18)

__device__ __forceinline__ unsigned xb_ld(unsigned* p)              { return __hip_atomic_load(p, __ATOMIC_RELAXED, __HIP_MEMORY_SCOPE_AGENT); }
__device__ __forceinline__ unsigned xb_add(unsigned* p, unsigned v) { return __hip_atomic_fetch_add(p, v, __ATOMIC_RELAXED, __HIP_MEMORY_SCOPE_AGENT); }
__device__ __forceinline__ unsigned xb_xcc_id() { return (unsigned)__builtin_amdgcn_s_getreg((3 << 11) | 20) & 0xFu; }
#define XB_SPIN(cond, bar) do { unsigned _sp = 0; while (cond) { __builtin_amdgcn_s_sleep(1); \
    if ((++_sp & 255u) == 0u) { if (xb_ld(&(bar)[XB_TMO])) break; if (_sp > XB_SPIN_CAP) { atomicAdd(&(bar)[XB_TMO], 1u); break; } } } } while (0)

struct XcdBarrier {
    unsigned* bar; unsigned x;
    volatile LAS unsigned* st;
};

__device__ __forceinline__ XcdBarrier xcd_barrier_post(unsigned* bar, volatile LAS unsigned* st) {
    XcdBarrier b; b.bar = bar; b.x = xb_xcc_id(); b.st = st;
    if (threadIdx.x == 0) (void)xb_add(&bar[XB_XCNT(b.x)], 1u);
    return b;
}
__device__ __forceinline__ void xcd_barrier_complete(unsigned* bar, unsigned x, unsigned& nloc, unsigned& nx) {
    const unsigned G = gridDim.x * gridDim.y * gridDim.z;
    unsigned sum, cnt, mine, sp = 0u;
    for (;;) {
        sum = 0u; cnt = 0u; mine = 0u;
#pragma unroll
        for (unsigned j = 0; j < 16; ++j) { const unsigned c = xb_ld(&bar[XB_XCNT(j)]); sum += c; cnt += (c > 0u) ? 1u : 0u; mine = (j == x) ? c : mine; }
        if (sum == G) break;
        __builtin_amdgcn_s_sleep(1);
        if ((++sp & 255u) == 0u) { if (xb_ld(&bar[XB_TMO])) break; if (sp > XB_SPIN_CAP) { atomicAdd(&bar[XB_TMO], 1u); break; } }
    }
    nloc = mine > 0u ? mine : 1u; nx = cnt > 0u ? cnt : 1u;
}

__device__ __forceinline__ void xcd_barrier(const XcdBarrier& b) {
    asm volatile("s_waitcnt vmcnt(0)" ::: "memory");
    __syncthreads();
    if (threadIdx.x == 0) {
        unsigned* bar = b.bar;
        __builtin_amdgcn_s_waitcnt(0);
        unsigned nloc = b.st[0], nx = b.st[1];
        if (nloc == 0u) { xcd_barrier_complete(bar, b.x, nloc, nx); b.st[0] = nloc; b.st[1] = nx; }
        const unsigned old = xb_add(&bar[XB_XSUB(b.x)], 1u);
        const unsigned gen = old / nloc;
        if (old + 1u == (gen + 1u) * nloc) {
            __builtin_amdgcn_fence(__ATOMIC_RELEASE, "agent");
            asm volatile("s_waitcnt vmcnt(0)" ::: "memory");
            const unsigned og = xb_add(&bar[XB_TOP], 1u);
            const unsigned tg = og / nx;
            if (og + 1u == (tg + 1u) * nx) xb_add(&bar[XB_TOPGEN], 1u);
            else XB_SPIN(xb_ld(&bar[XB_TOPGEN]) == tg, bar);
            __builtin_amdgcn_fence(__ATOMIC_ACQUIRE, "agent");
            xb_add(&bar[XB_XGEN(b.x)], 1u);
            asm volatile("s_waitcnt vmcnt(0)" ::: "memory");
        } else {
            XB_SPIN(xb_ld(&bar[XB_XGEN(b.x)]) == gen, bar);
            __builtin_amdgcn_fence(__ATOMIC_ACQUIRE, "agent");
            asm volatile("s_waitcnt vmcnt(0)" ::: "memory");
        }
    }
    __syncthreads();
}

#ifndef PROBE_MASK
#define PROBE_MASK 0
#endif
#ifndef PREFETCH_MB
#define PREFETCH_MB 32
#endif
constexpr int N_PHASES = 14;
__global__ void __launch_bounds__(NTHREADS, 2) fwd_kernel(Args args) {
    extern __shared__ __attribute__((aligned(16))) unsigned char lds_raw[];
    Ctx F;
    F.lds = (LAS unsigned char*)lds_raw;
    F.tid = threadIdx.x; F.lane = F.tid & 63; F.wave = __builtin_amdgcn_readfirstlane(F.tid >> 6); F.G = gridDim.x; F.bid = blockIdx.x; F.probe = args.probe;
    F.x = args.in[0]; F.c = args.in[1]; F.ctx = args.in[2]; F.cctx = args.in[3]; F.wmod = args.in[4]; F.bmod = args.in[5]; F.npre = args.in[6]; F.npost = args.in[7];
    F.fwin = args.in[8]; F.fwout = args.in[9]; F.win = args.in[10]; F.wout = args.in[11]; F.convw = args.in[12]; F.convb = args.in[13]; F.wq = args.in[14]; F.wk = args.in[15];
    F.ibias = args.in[16]; F.fbias = args.in[17]; F.hnorm = args.in[18]; F.poolw = args.in[19]; F.pscale = args.in[20];
    F.out = args.out; F.ws = args.ws; unsigned char* ws = args.ws;
    F.mod = (float*)(ws + WS_MOD); F.wqt = (bf16*)(ws + WS_WQT); F.wkt = (bf16*)(ws + WS_WKT); F.mloc = (float*)(ws + WS_MLOC); F.gsum = (float*)(ws + WS_G); F.min_ = (float*)(ws + WS_MIN);
    F.gb = (float*)(ws + WS_GB); F.cn = (float*)(ws + WS_CN); F.nin = (float*)(ws + WS_NIN); F.gates = (float*)(ws + WS_GATES);
    F.W1 = (bf16*)(ws + WS_W1); F.W2 = (bf16*)(ws + WS_W2); F.WIN = (bf16*)(ws + WS_WIN); F.WOUT = (bf16*)(ws + WS_WOUT); F.Y = (bf16*)(ws + WS_Y); F.Z = (bf16*)(ws + WS_Z);
    F.H = (bf16*)(ws + WS_H); F.P = (bf16*)(ws + WS_P); F.Q = (bf16*)(ws + WS_Q); F.K = (bf16*)(ws + WS_K); F.CIN = (bf16*)(ws + WS_CIN); F.MIX = (bf16*)(ws + WS_MIX); F.CKV = (bf16*)(ws + WS_CKV); F.XB = (bf16*)(ws + WS_XB);
    const int lo = args.ph_lo, hi = args.ph_hi;
    volatile LAS unsigned* bst = (volatile LAS unsigned*)(F.lds + LDS_BYTES - 64);
    if (F.tid < 16) bst[F.tid] = 0u;
    __syncthreads();
    XcdBarrier bar; bar.bar = (unsigned*)(ws + WS_CTL) + 1024; bar.x = 0; bar.st = bst;
    if (hi - lo > 1) bar = xcd_barrier_post((unsigned*)(ws + WS_CTL) + 1024, bst);
#ifndef PROBE_MASK
#define PROBE_MASK 0
#endif
#define IN(k) (lo <= (k) && (k) < hi)
#if PROBE_MASK
#define REPS(k) _Pragma("unroll 1") for (int rep_ = 0; rep_ <= ((args.probe >> (k)) & 1); ++rep_)
#else
#define REPS(k)
#endif
#if PROBE_MASK
#define SEAM(k) do { if (IN(k) && IN((k) + 1)) { xcd_barrier(bar); } \
    if (tphase) { const unsigned long long tn_ = __builtin_amdgcn_s_memrealtime(); if (tphase == (k) + 1) tdur = tn_ - tprev; tprev = tn_; } } while (0)
    const int tphase = (args.probe >> 20) & 31;
    unsigned long long tprev = __builtin_amdgcn_s_memrealtime(), tdur = 0ull;
#else
#define SEAM(k) do { if (IN(k) && IN((k) + 1)) { xcd_barrier(bar); } } while (0)
    constexpr int tphase = 0; unsigned long long tprev = 0ull, tdur = 0ull; (void)tprev; (void)tdur;
#endif

    if (IN(0)) REPS(0) { p0_prologue(F);
        if (F.bid >= 144) {
            constexpr int PF_MB = PREFETCH_MB;
            const size_t n16 = (size_t)PF_MB * 65536; const int t = (F.bid - 144) * NTHREADS + F.tid, nt = (F.G - 144) * NTHREADS;
            for (size_t e = (size_t)t; e < n16; e += (size_t)nt * 8) { f32x4 v[8];
#pragma unroll
                for (int i = 0; i < 8; ++i) { const size_t ee = e + (size_t)i * nt; v[i] = (ee < n16) ? ((const f32x4*)F.x)[ee] : (f32x4){0.f, 0.f, 0.f, 0.f}; }
#pragma unroll
                for (int i = 0; i < 8; ++i) asm volatile("" :: "v"(v[i])); } } } SEAM(0);
    if (IN(1)) REPS(1) { convert_items(F, 0, 0, F.G);
        if (PROBE_MASK && ((args.probe >> 19) & 1)) { xcd_barrier(bar); if (tphase) { const unsigned long long tn_ = __builtin_amdgcn_s_memrealtime(); if (tphase == 15) tdur = tn_ - tprev; tprev = tn_; } }
        row_phase<false, 0, 0, true>(F, MT, 0.f, 0); } SEAM(1);
    if (IN(2)) { pg8::Gemm g{F.Y, F.W1, ML, 2 * FF, DM, 1}; pg8::StaticOrder S; S.init(ML, 2 * FF, F.G, F.bid); pg8::EpiSwiglu E{F.H, FF};
        pg8::gemm_phase<pg8::EpiSwiglu, pg8::StaticOrder, true, true>(F.lds, g, S, E); } SEAM(2);
    if (IN(3)) {
        const int ncx = (MC / 256) * (2 * FF / 256), gA = F.G - 8; unsigned* cxcnt = (unsigned*)(F.ws + WS_CTL) + CTXCNT_WORD;
        if (F.bid >= 8 && F.bid - 8 < ncx) {
            pg8::Gemm g{F.Y + (size_t)(ML / 256) * (256 * DM), F.W1, MC, 2 * FF, DM, 1}; pg8::StaticOrder S; S.init(MC, 2 * FF, gA, F.bid - 8);
            pg8::EpiSwiglu E{F.H + (size_t)(ML / 256) * (FF / 64) * (256 * 64), FF};
            pg8::gemm_phase<pg8::EpiSwiglu, pg8::StaticOrder, true, true>(F.lds, g, S, E);
            asm volatile("s_waitcnt vmcnt(0)" ::: "memory"); __syncthreads();
            if (F.tid == 0) { __builtin_amdgcn_fence(__ATOMIC_RELEASE, "agent"); asm volatile("s_waitcnt vmcnt(0)" ::: "memory");
                __hip_atomic_fetch_add(cxcnt, 1u, __ATOMIC_RELAXED, __HIP_MEMORY_SCOPE_AGENT); } }
        { pg8::Gemm g{F.H, F.W2, MT, DM, FF, 1}; pg8::GatedOrder S; S.init(MT, DM, F.G, F.bid, 2); S.cnt = cxcnt; S.need = (unsigned)min(ncx, gA); S.pm_gate = ML / 256; pg8::EpiStore E{F.Z, DM};
          pg8::gemm_phase<pg8::EpiStore, pg8::GatedOrder, true, true>(F.lds, g, S, E); }
        { const int nb3 = (MT / 256) * (DM / 256) - 2 * F.G;
          const int first = 8 + ncx;
          if (nb3 > 0 && nb3 <= 8 && first < F.G) { constexpr int cut = (IT_PART1 * 88) / 100;
              convert_items(F, 1, first, F.G - first, 0, cut); convert_items(F, 1, 8, ncx, cut, IT_PART1); }
          else convert_items(F, 1, 0, F.G); } } SEAM(3);
    if (IN(4)) { row_phase<true, 0, 1, true>(F, MT, 0.5f, 1); } SEAM(4);
    if (IN(5)) { pg8::Gemm g{F.Y, F.WIN, MT, 2304, DM, 1}; pg8::StaticOrder S; S.init(MT, 2304, F.G, F.bid); pg8::EpiInProj E{F.P, F.gates, F.ibias, F.fbias};
        pg8::gemm_phase<pg8::EpiInProj, pg8::StaticOrder, true, true>(F.lds, g, S, E); } SEAM(5);
    if (IN(6)) { REPS(15) m1_phase(F);
        if (PROBE_MASK && ((args.probe >> 18) & 1)) { xcd_barrier(bar); if (tphase) { const unsigned long long tn_ = __builtin_amdgcn_s_memrealtime(); if (tphase == 16) tdur = tn_ - tprev; tprev = tn_; } }
                 REPS(14) {
                 if (F.G == 256) {
                     const int nk = (F.bid < 16) ? 5 : 8;
                     for (int k = 0; k < nk; ++k) pool_unit(F, F.bid + 256 * k);
                     if (F.bid >= 16 && F.bid < 64) { const int e = F.bid - 16; pool_unit(F, e / 3 + 256 * (5 + e % 3)); } }
                 else for (int u = F.bid; u < NB * GRID_ROWS * 4; u += F.G) pool_unit(F, u); } } SEAM(6);
    if (IN(7)) REPS(7) { scan_phase(F); } SEAM(7);
    if (IN(8)) REPS(8) { m3_phase(F); } SEAM(8);
    if (IN(9)) REPS(9) { pg8::Gemm g{F.MIX, F.WOUT, ML, DM, DM, 1}; pg8::StaticOrder S; S.init(ML, DM, F.G, F.bid); pg8::EpiStore E{F.Z, DM};
        pg8::gemm_phase<pg8::EpiStore, pg8::StaticOrder, true, true>(F.lds, g, S, E); } SEAM(9);
    if (IN(10)) { row_phase<true, 1, 1, true>(F, ML, 1.0f, 2); } SEAM(10);
    if (IN(11)) { pg8::Gemm g{F.Y, F.W1 + (size_t)2 * FF * DM, ML, 2 * FF, DM, 1}; pg8::StaticOrder S; S.init(ML, 2 * FF, F.G, F.bid); pg8::EpiSwiglu E{F.H, FF};
        pg8::gemm_phase<pg8::EpiSwiglu, pg8::StaticOrder, true, true>(F.lds, g, S, E); } SEAM(11);
    if (IN(12)) { pg8::Gemm g{F.H, F.W2 + (size_t)DM * FF, ML, DM, FF, 1}; pg8::StaticOrder S; S.init(ML, DM, F.G, F.bid, 1); pg8::EpiStore E{F.Z, DM};
        pg8::gemm_phase<pg8::EpiStore, pg8::StaticOrder, true, true>(F.lds, g, S, E); } SEAM(12);
    if (IN(13)) { row_phase<true, 1, 2, false>(F, ML, 0.5f, 3); }
    if (tphase) { asm volatile("s_waitcnt vmcnt(0)" ::: "memory"); __syncthreads();
        const unsigned long long tn_ = __builtin_amdgcn_s_memrealtime(); if (tphase == 14) tdur = tn_ - tprev;
        if (F.bid == 0) { const unsigned long long t0_ = __builtin_amdgcn_s_memrealtime(); while (__builtin_amdgcn_s_memrealtime() - t0_ < 10ull * tdur) __builtin_amdgcn_s_sleep(8); } }
#undef IN
#undef SEAM
}

#ifndef PROBE_MASK
#define PROBE_MASK 0
#endif
#ifndef N_LAUNCHES
#define N_LAUNCHES 1
#endif
extern "C" void kernel_launch(void* const* d_in, const int* in_sizes, int n_in, void* d_out, int out_size, void* d_ws, size_t ws_size, hipStream_t stream) {
    static int grid = 0;
    if (grid == 0) {
        if (n_in != 21 || in_sizes[0] != ML * DM || out_size != ML * DM || ws_size < WS_END) { fprintf(stderr, "kernel_launch: unexpected shapes (n_in %d, in0 %d, out %d, ws %zu)\n", n_in, n_in > 0 ? in_sizes[0] : -1, out_size, ws_size); grid = -1; return; }
        int dev = 0, cus = 0, per_cu = 0;
        (void)hipGetDevice(&dev); (void)hipDeviceGetAttribute(&cus, hipDeviceAttributeMultiprocessorCount, dev);
        (void)hipFuncSetAttribute((const void*)fwd_kernel, hipFuncAttributeMaxDynamicSharedMemorySize, LDS_BYTES);
        (void)hipOccupancyMaxActiveBlocksPerMultiprocessor(&per_cu, (const void*)fwd_kernel, NTHREADS, LDS_BYTES);
        (void)hipGetLastError();
        if (per_cu < 1) { fprintf(stderr, "kernel_launch: occupancy query says %d blocks per CU\n", per_cu); grid = -1; return; }
        grid = cus;
    }
    if (grid < 0) return;
    Args a{};
    for (int i = 0; i < 21; ++i) a.in[i] = (const float*)d_in[i];
    a.out = (float*)d_out; a.ws = (unsigned char*)d_ws; a.probe = PROBE_MASK;
    if (N_LAUNCHES == 1) {
        (void)hipMemsetAsync((char*)d_ws + WS_CTL, 0, CTL_ZERO_BYTES, stream);
        a.ph_lo = 0; a.ph_hi = N_PHASES; void* kargs[] = {&a};
        hipError_t e = hipLaunchCooperativeKernel((const void*)fwd_kernel, dim3(grid), dim3(NTHREADS), kargs, LDS_BYTES, stream);
        if (e != hipSuccess) fprintf(stderr, "cooperative launch failed: %s (grid %d)\n", hipGetErrorString(e), grid);
    } else {
        for (int p = 0; p < N_PHASES; ++p) { a.ph_lo = p; a.ph_hi = p + 1; hipLaunchKernelGGL(fwd_kernel, dim3(grid), dim3(NTHREADS), LDS_BYTES, stream, a); }
    }
}
```

```cpp
#include <hip/hip_runtime.h>
#include <hip/hip_cooperative_groups.h>
#include <cstdio>
#include <cstdint>
namespace cg = cooperative_groups;
namespace pg8 {
#define PG8_LAS __attribute__((address_space(3)))
typedef unsigned short bf16_t;
typedef short bf16x8 __attribute__((ext_vector_type(8)));
typedef float f32x4 __attribute__((ext_vector_type(4)));
typedef unsigned u32x4 __attribute__((ext_vector_type(4)));
constexpr int BM = 256, BK = 64, HALF = 128, HTB = HALF * BK * 2  , STAGE_BYTES = 8 * HTB, NXCD = 8, WGM = 8;

__host__ __device__ __forceinline__ int lds_byte(int r, int c) { const int st = (r >> 4) * 2 + (c >> 5), rr = r & 15, cc = c & 31, ob = rr * 64 + cc * 2; return st * 1024 + (ob ^ (((ob >> 9) & 1) << 5)); }
__host__ __device__ __forceinline__ void stage_rc(int b, int& R, int& C) { const int st = b / 1024, sb = b % 1024, swz = sb ^ (((sb >> 9) & 1) << 5); R = (st >> 1) * 16 + swz / 64; C = (st & 1) * 32 + (swz % 64) / 2; }
__host__ __device__ __forceinline__ int perm32(int rho) { const int n = rho >> 4, i = rho & 15; return 8 * (i >> 2) + 4 * n + (i & 3); }

struct Unit { int pm, pn; };
struct Gemm { const bf16_t* A; const bf16_t* Bt; int M, N, K; int a_tiled; };

struct StaticOrder {
    int nM, nN, nwg, G, c, rev;
    __host__ __device__ void init(int M, int N, int G_, int c_, int rev_ = 0) { nM = M / BM; nN = N / BM; nwg = nM * nN; G = G_; c = c_; rev = rev_; }
    __host__ __device__ bool next(int i, Unit& u) const {
        const long L = (long)i * G + c; if (L >= nwg) return false;
        int wgid = (int)L; { const int q = nwg / NXCD, r = nwg % NXCD, xcd = wgid % NXCD, off = wgid / NXCD; wgid = (xcd < r ? xcd * (q + 1) : r * (q + 1) + (xcd - r) * q) + off; }
        const int nig = WGM * nN, gid = wgid / nig, fm = gid * WGM, gsz = (nM - fm) < WGM ? (nM - fm) : WGM;
        u.pm = fm + ((wgid % nig) % gsz); u.pn = (wgid % nig) / gsz;
        if (rev == 1) u.pm = nM - 1 - u.pm; else if (rev == 2) u.pm = (u.pm < nM - 2) ? nM - 3 - u.pm : u.pm;
        return true;
    }
    __device__ __forceinline__ void a_ready(const Unit&) const {}
    __device__ __forceinline__ void done(const Unit&) const {}
};
struct GatedOrder : StaticOrder {
    unsigned* cnt; unsigned need; int pm_gate;
    __device__ __forceinline__ void a_ready(const Unit& u) const {
        if (u.pm < pm_gate) return;
        if (threadIdx.x < 64) { unsigned sp = 0;
            while ((unsigned)__builtin_amdgcn_readfirstlane(__hip_atomic_load(cnt, __ATOMIC_RELAXED, __HIP_MEMORY_SCOPE_AGENT)) < need) { __builtin_amdgcn_s_sleep(2); if (++sp > (1u << 22)) break; }
            __builtin_amdgcn_fence(__ATOMIC_ACQUIRE, "agent");
            asm volatile("s_waitcnt vmcnt(0)" ::: "memory"); }
        asm volatile("" ::: "memory"); __builtin_amdgcn_s_barrier(); asm volatile("" ::: "memory");
    }
};
__device__ __forceinline__ unsigned cvt_pk_bf16(float lo, float hi) { unsigned r; asm volatile("v_cvt_pk_bf16_f32 %0, %1, %2" : "=v"(r) : "v"(lo), "v"(hi)); return r; }
typedef float f32x2 __attribute__((ext_vector_type(2)));
typedef unsigned u32x2 __attribute__((ext_vector_type(2)));
struct EpiStore {
    static constexpr bool PERM = true, AFTER_DRAIN = false;
    bf16_t* O; int ldc;
    __device__ __forceinline__ void operator()(const f32x4 (&acc)[2][2][4][2], const Unit& u, int wr, int wc, int fr, int fq) const {
        const int row0 = u.pm * BM + wr * 64 + fr, col0 = u.pn * BM + wc * 32 + 8 * fq;
#pragma unroll
        for (int ai = 0; ai < 2; ++ai)
#pragma unroll
            for (int m = 0; m < 4; ++m) { bf16_t* rowp = O + (size_t)(row0 + ai * HALF + m * 16) * ldc + col0;
#pragma unroll
                for (int bj = 0; bj < 2; ++bj) { const f32x4 v0 = acc[ai][bj][m][0], v1 = acc[ai][bj][m][1];
                    u32x4 w; w.x = cvt_pk_bf16(v0[0], v0[1]); w.y = cvt_pk_bf16(v0[2], v0[3]); w.z = cvt_pk_bf16(v1[0], v1[1]); w.w = cvt_pk_bf16(v1[2], v1[3]);
                    *(u32x4*)(rowp + bj * HALF) = w; } }
    }
};
__device__ __forceinline__ float silu_mul(float a, float b) { return a * b * __builtin_amdgcn_rcpf(1.0f + __builtin_amdgcn_exp2f(a * -1.4426950408889634f)); }
struct EpiSwiglu {
    static constexpr bool PERM = true, AFTER_DRAIN = false;
    bf16_t* O; int ldc;
    __device__ __forceinline__ void operator()(const f32x4 (&acc)[2][2][4][2], const Unit& u, int wr, int wc, int fr, int fq) const {
        const int hcol = u.pn * HALF + wc * 32 + 8 * fq, r0 = wr * 64 + fr;
        bf16_t* slab = O + ((size_t)u.pm * (ldc / 64) + (hcol >> 6)) * (BM * 64) + (hcol & 63);
#pragma unroll
        for (int ai = 0; ai < 2; ++ai)
#pragma unroll
            for (int m = 0; m < 4; ++m) { bf16_t* rowp = slab + (size_t)(r0 + ai * HALF + m * 16) * 64;
                const f32x4 a0 = acc[ai][0][m][0], a1 = acc[ai][0][m][1], b0 = acc[ai][1][m][0], b1 = acc[ai][1][m][1];
                u32x4 w; w.x = cvt_pk_bf16(silu_mul(a0[0], b0[0]), silu_mul(a0[1], b0[1])); w.y = cvt_pk_bf16(silu_mul(a0[2], b0[2]), silu_mul(a0[3], b0[3]));
                w.z = cvt_pk_bf16(silu_mul(a1[0], b1[0]), silu_mul(a1[1], b1[1])); w.w = cvt_pk_bf16(silu_mul(a1[2], b1[2]), silu_mul(a1[3], b1[3]));
                *(u32x4*)rowp = w; }
    }
};
struct EpiInProj {
    static constexpr bool PERM = true, AFTER_DRAIN = false;
    bf16_t* P; float* gates; const float* ib; const float* fb;
    __device__ __forceinline__ void operator()(const f32x4 (&acc)[2][2][4][2], const Unit& u, int wr, int wc, int fr, int fq) const {
        const int row0 = u.pm * BM + wr * 64 + fr;
        if (u.pn < 8) {
            const int col0 = u.pn * BM + wc * 32 + 8 * fq;
#pragma unroll
            for (int ai = 0; ai < 2; ++ai)
#pragma unroll
                for (int m = 0; m < 4; ++m) { bf16_t* rowp = P + (size_t)(row0 + ai * HALF + m * 16) * 2048 + col0;
#pragma unroll
                    for (int bj = 0; bj < 2; ++bj) { const f32x4 v0 = acc[ai][bj][m][0], v1 = acc[ai][bj][m][1];
                        u32x4 w; w.x = cvt_pk_bf16(v0[0], v0[1]); w.y = cvt_pk_bf16(v0[2], v0[3]); w.z = cvt_pk_bf16(v1[0], v1[1]); w.w = cvt_pk_bf16(v1[2], v1[3]);
                        *(u32x4*)(rowp + bj * HALF) = w; } }
        } else if (wc == 0 && fq < 2) {
            const float* bp = (fq == 0) ? ib : fb;
            const f32x4 bv0 = *(const f32x4*)bp, bv1 = *(const f32x4*)(bp + 4);
#pragma unroll
            for (int ai = 0; ai < 2; ++ai)
#pragma unroll
                for (int m = 0; m < 4; ++m) { float* gp = gates + (size_t)(row0 + ai * HALF + m * 16) * 16 + 8 * fq;
                    *(f32x4*)gp = acc[ai][0][m][0] + bv0; *(f32x4*)(gp + 4) = acc[ai][0][m][1] + bv1; }
        }
    }
};
template <class Epi, class Sched, bool ALIGN_EPI = false, bool SP2 = false>
__device__ __forceinline__ void gemm_phase(PG8_LAS unsigned char* lds, const Gemm g, const Sched& S, const Epi& E) {
    const int tid = threadIdx.x, wid = __builtin_amdgcn_readfirstlane(tid >> 6), lane = tid & 63, wr = wid >> 2, wc = wid & 3, fr = lane & 15, fq = lane >> 4;
    const int K = g.K, nt = K / BK, ldA = g.a_tiled ? BK : K;
    unsigned voffA[2], voffB[2];
#pragma unroll
    for (int i = 0; i < 2; ++i) { int R, C; stage_rc(tid * 16 + i * 8192, R, C); const int Rb = Epi::PERM ? ((R & ~31) + perm32(R & 31)) : R;
        voffA[i] = (unsigned)(R * ldA + C) * 2u; voffB[i] = (unsigned)(Rb * ldA + C) * 2u; }
    const size_t kstep = (size_t)(BK * 2);
    const size_t hstep = (size_t)HALF * K * 2;
    const size_t tstep = 2 * hstep;
    const size_t kstepA = g.a_tiled ? (size_t)(BM * BK * 2) : kstep, hstepA = g.a_tiled ? (size_t)(HALF * BK * 2) : hstep, tstepA = g.a_tiled ? (size_t)(K / BK) * (BM * BK * 2) : tstep;
    const unsigned ldsw = (unsigned)wid * 1024u;
    const int aoff = lds_byte(wr * 64 + fr, fq * 8), boff = lds_byte(wc * 32 + fr, fq * 8);
#define PG8_SA(b, h) (((b) * 2 + (h)) * HTB)
#define PG8_SB(b, h) ((4 + (b) * 2 + (h)) * HTB)
#define PG8_STAGE(bufoff, gbase, voff) do { _Pragma("unroll") for (int _i = 0; _i < 2; ++_i) \
        __builtin_amdgcn_global_load_lds((const unsigned*)((const char*)(gbase) + (voff)[_i]), (PG8_LAS unsigned*)(lds + (bufoff) + ldsw + _i * 8192), 16, 0, 0); } while (0)
#define PG8_LDA(dst, b, h) do { _Pragma("unroll") for (int m = 0; m < 4; ++m) _Pragma("unroll") for (int k = 0; k < 2; ++k) dst[m][k] = *(const PG8_LAS bf16x8*)(lds + PG8_SA(b, h) + aoff + m * 2048 + k * 1024); } while (0)
#define PG8_LDB(dst, b, h) do { _Pragma("unroll") for (int n = 0; n < 2; ++n) _Pragma("unroll") for (int k = 0; k < 2; ++k) dst[n][k] = *(const PG8_LAS bf16x8*)(lds + PG8_SB(b, h) + boff + n * 2048 + k * 1024); } while (0)
#define PG8_MMA(ai, bj, At, Bt) do { __builtin_amdgcn_s_setprio(1); _Pragma("unroll") for (int m = 0; m < 4; ++m) _Pragma("unroll") for (int n = 0; n < 2; ++n) _Pragma("unroll") for (int k = 0; k < 2; ++k) \
        acc[ai][bj][m][n] = __builtin_amdgcn_mfma_f32_16x16x32_bf16(Bt[n][k], At[m][k], acc[ai][bj][m][n], 0, 0, 0); __builtin_amdgcn_s_setprio(0); } while (0)
#define PG8_WAIT_V(n) asm volatile("s_waitcnt vmcnt(" #n ")" ::: "memory")
#define PG8_WAIT_L(n) asm volatile("s_waitcnt lgkmcnt(" #n ")" ::: "memory")
#define PG8_BAR __builtin_amdgcn_s_barrier()
#define PG8_SCHED __builtin_amdgcn_sched_barrier(0)
    Unit cur, nxt; int ui = 0;
    if (!S.next(0, cur)) return;
    f32x4 acc[2][2][4][2];
#pragma unroll
    for (int a = 0; a < 2; ++a)
#pragma unroll
        for (int b = 0; b < 2; ++b)
#pragma unroll
            for (int m = 0; m < 4; ++m)
#pragma unroll
                for (int n = 0; n < 2; ++n) acc[a][b][m][n] = (f32x4){0.f, 0.f, 0.f, 0.f};
    bf16x8 At[4][2], B0[2][2], B1[2][2];
    const char* cA = (const char*)g.A + (size_t)cur.pm * tstepA; const char* cB = (const char*)g.Bt + (size_t)cur.pn * tstepA;
    S.a_ready(cur);
    if constexpr (SP2) {
        PG8_STAGE(PG8_SB(0, 0), cB, voffB); PG8_STAGE(PG8_SB(0, 1), cB + hstepA, voffB); PG8_STAGE(PG8_SA(0, 0), cA, voffA); PG8_STAGE(PG8_SA(0, 1), cA + hstepA, voffA);
        if (wr == 1) PG8_BAR;
        PG8_WAIT_V(2); PG8_BAR;
        PG8_STAGE(PG8_SB(1, 0), cB + kstepA, voffB); PG8_STAGE(PG8_SA(1, 0), cA + kstepA, voffA); PG8_STAGE(PG8_SB(1, 1), cB + hstepA + kstepA, voffB);
        PG8_WAIT_V(6); PG8_BAR;
    } else {
        PG8_STAGE(PG8_SB(0, 0), cB, voffB); PG8_STAGE(PG8_SA(0, 0), cA, voffA); PG8_STAGE(PG8_SB(0, 1), cB + hstepA, voffB); PG8_STAGE(PG8_SA(0, 1), cA + hstepA, voffA);
        if (wr == 1) PG8_BAR;
        PG8_WAIT_V(4); PG8_BAR;
        PG8_STAGE(PG8_SB(1, 0), cB + kstepA, voffB); PG8_STAGE(PG8_SA(1, 0), cA + kstepA, voffA); PG8_STAGE(PG8_SB(1, 1), cB + hstepA + kstepA, voffB);
        PG8_WAIT_V(6); PG8_BAR;
    }
    for (;;) {
        const bool has_next = S.next(ui + 1, nxt);
        const char* nA = has_next ? (const char*)g.A + (size_t)nxt.pm * tstepA : cA; const char* nB = has_next ? (const char*)g.Bt + (size_t)nxt.pn * tstepA : cB;
        for (int t = 0; t < nt; t += 2) {
            const bool last = (t == nt - 2);
            const char* a1 = cA + (size_t)(t + 1) * kstepA;
            const char* a2 = last ? nA : cA + (size_t)(t + 2) * kstepA; const char* b2 = last ? nB : cB + (size_t)(t + 2) * kstepA;
            const char* a3 = a2 + kstepA; const char* b3 = b2 + kstepA;
            if (last && has_next) S.a_ready(nxt);
            if constexpr (SP2) {
            PG8_LDB(B0, 0, 0); PG8_LDB(B1, 0, 1); PG8_SCHED; PG8_LDA(At, 0, 0); PG8_STAGE(PG8_SA(1, 1), a1 + hstepA, voffA);
            PG8_WAIT_V(8); PG8_WAIT_L(0); PG8_BAR; PG8_MMA(0, 0, At, B0); PG8_MMA(0, 1, At, B1); PG8_BAR; PG8_SCHED;
            PG8_LDA(At, 0, 1); PG8_STAGE(PG8_SB(0, 0), b2, voffB); PG8_STAGE(PG8_SB(0, 1), b2 + hstepA, voffB); PG8_STAGE(PG8_SA(0, 0), a2, voffA);
            PG8_WAIT_V(8); PG8_WAIT_L(0); PG8_BAR; PG8_MMA(1, 0, At, B0); PG8_MMA(1, 1, At, B1); PG8_BAR; PG8_SCHED;
            PG8_LDB(B0, 1, 0); PG8_LDB(B1, 1, 1); PG8_SCHED; PG8_LDA(At, 1, 0); PG8_STAGE(PG8_SA(0, 1), a2 + hstepA, voffA);
            PG8_WAIT_V(8); PG8_WAIT_L(0); PG8_BAR; PG8_MMA(0, 0, At, B0); PG8_MMA(0, 1, At, B1); PG8_BAR; PG8_SCHED;
            PG8_LDA(At, 1, 1); PG8_STAGE(PG8_SB(1, 0), b3, voffB); PG8_STAGE(PG8_SB(1, 1), b3 + hstepA, voffB); PG8_STAGE(PG8_SA(1, 0), a3, voffA);
            PG8_WAIT_V(8); PG8_WAIT_L(0); PG8_BAR; PG8_MMA(1, 0, At, B0); PG8_MMA(1, 1, At, B1); PG8_BAR; PG8_SCHED;
            } else {
            PG8_LDB(B0, 0, 0); PG8_SCHED; PG8_LDA(At, 0, 0); PG8_STAGE(PG8_SA(1, 1), a1 + hstepA, voffA);
            PG8_WAIT_L(8); PG8_BAR; PG8_WAIT_L(0); PG8_MMA(0, 0, At, B0); PG8_BAR; PG8_SCHED;
            PG8_LDB(B1, 0, 1); PG8_STAGE(PG8_SB(0, 0), b2, voffB);
            PG8_BAR; PG8_WAIT_L(0); PG8_MMA(0, 1, At, B1); PG8_BAR;
            PG8_LDA(At, 0, 1); PG8_STAGE(PG8_SA(0, 0), a2, voffA);
            PG8_BAR; PG8_WAIT_L(0); PG8_MMA(1, 0, At, B0); PG8_BAR; PG8_SCHED;
            PG8_STAGE(PG8_SB(0, 1), b2 + hstepA, voffB);
            PG8_WAIT_V(6); PG8_BAR; PG8_MMA(1, 1, At, B1); PG8_BAR;
            PG8_LDB(B0, 1, 0); PG8_SCHED; PG8_LDA(At, 1, 0); PG8_STAGE(PG8_SA(0, 1), a2 + hstepA, voffA);
            PG8_WAIT_L(8); PG8_BAR; PG8_WAIT_L(0); PG8_MMA(0, 0, At, B0); PG8_BAR; PG8_SCHED;
            PG8_LDB(B1, 1, 1); PG8_STAGE(PG8_SB(1, 0), b3, voffB);
            PG8_BAR; PG8_WAIT_L(0); PG8_MMA(0, 1, At, B1); PG8_BAR;
            PG8_LDA(At, 1, 1); PG8_STAGE(PG8_SA(1, 0), a3, voffA);
            PG8_BAR; PG8_WAIT_L(0); PG8_MMA(1, 0, At, B0); PG8_BAR; PG8_SCHED;
            PG8_STAGE(PG8_SB(1, 1), b3 + hstepA, voffB);
            PG8_WAIT_V(6); PG8_BAR; PG8_MMA(1, 1, At, B1); PG8_BAR;
            }
        }
        if constexpr (ALIGN_EPI) { if (wr == 0) PG8_BAR; }
        if constexpr (!Epi::AFTER_DRAIN) { E(acc, cur, wr, wc, fr, fq); S.done(cur); }
        if (!has_next) break;
#pragma unroll
        for (int a = 0; a < 2; ++a)
#pragma unroll
            for (int b = 0; b < 2; ++b)
#pragma unroll
                for (int m = 0; m < 4; ++m)
#pragma unroll
                    for (int n = 0; n < 2; ++n) acc[a][b][m][n] = (f32x4){0.f, 0.f, 0.f, 0.f};
        cur = nxt; cA = nA; cB = nB; ++ui;
        if constexpr (ALIGN_EPI) { if (wr == 1) PG8_BAR; }
    }
    PG8_WAIT_V(0);
    if constexpr (!ALIGN_EPI) { if (wr == 0) PG8_BAR; }
    PG8_BAR;
    if constexpr (Epi::AFTER_DRAIN) { E.fused(acc, cur, wr, wc, fr, fq, lds, wid, lane); S.done(cur); }
#undef PG8_SA
#undef PG8_SB
#undef PG8_STAGE
#undef PG8_LDA
#undef PG8_LDB
#undef PG8_MMA
#undef PG8_WAIT_V
#undef PG8_WAIT_L
#undef PG8_BAR
#undef PG8_SCHED
}
}
constexpr int DM = 1024, SEQ = 16384, NB = 2, CTXL = 256, FF = 2816, NMOD = 9;
constexpr int ML = NB * SEQ, MC = NB * CTXL, MT = ML + MC;
constexpr int NH = 4, HD = 128, MW = 512, GW = 64, GRID_ROWS = SEQ / GW;
constexpr int NTB = 130;
constexpr float EPS = 1e-6f;
constexpr int NWAVES = 8, NTHREADS = 512;

constexpr size_t MiB = 1u << 20, KiB = 1024;
constexpr size_t WS_CTL = 0;
constexpr size_t WS_MOD = 1 * MiB;
constexpr size_t WS_WQT = 1 * MiB + 256 * KiB;
constexpr size_t WS_WKT = 1 * MiB + 512 * KiB;
constexpr size_t WS_MLOC = 1 * MiB + 768 * KiB;
constexpr size_t WS_G = WS_MLOC + 16 * KiB;
constexpr size_t WS_MIN = WS_G + 16 * KiB;
constexpr size_t WS_CN = 2 * MiB;
constexpr size_t WS_NIN = 3 * MiB + 256 * KiB;
constexpr size_t WS_GATES = 5 * MiB;
constexpr size_t WS_W1 = 8 * MiB;
constexpr size_t WS_W2 = 30 * MiB;
constexpr size_t WS_WIN = 41 * MiB;
constexpr size_t WS_WOUT = 46 * MiB;
constexpr size_t WS_Y = 48 * MiB;
constexpr size_t WS_Z = 113 * MiB;
constexpr size_t WS_CKV = 48 * MiB;
constexpr size_t WS_H = 178 * MiB;
constexpr size_t WS_P = 178 * MiB;
constexpr size_t WS_Q = 308 * MiB;
constexpr size_t WS_K = WS_Q + (size_t)MT * 512 * 2;
constexpr size_t WS_CIN = 113 * MiB;
constexpr size_t WS_XB = 373 * MiB;
constexpr size_t WS_MIX = 437 * MiB;
constexpr size_t WS_GB = 501 * MiB;
constexpr size_t WS_END = 505 * MiB;
static_assert(WS_K + (size_t)MT * 512 * 2 <= WS_XB && WS_XB + (size_t)ML * 1024 * 2 <= WS_MIX && WS_CIN + (size_t)16 * 128 * 32768 <= WS_H && WS_Z + (size_t)MT * 1024 * 2 <= WS_H && WS_CKV + (size_t)16 * 130 * 65536 <= WS_H && WS_P + (size_t)MT * 2048 * 2 <= WS_Q, "ws map");
static_assert(WS_GATES + (size_t)MT * 64 <= WS_W1 && WS_NIN + 16 * 130 * 512 <= WS_GATES && WS_CN + 16 * 130 * 512 <= WS_NIN, "ws map small");
constexpr size_t CTL_ZERO_BYTES = 64 * KiB;
constexpr int CTXCNT_WORD = 8192;

constexpr int LDS_BYTES = 160 * 1024;

#define LAS __attribute__((address_space(3)))
typedef unsigned short bf16;
typedef short bf16x8 __attribute__((ext_vector_type(8)));
typedef float f32x4 __attribute__((ext_vector_type(4)));
typedef float f32x2v __attribute__((ext_vector_type(2)));
typedef unsigned u32x4 __attribute__((ext_vector_type(4)));
typedef unsigned u32x2 __attribute__((ext_vector_type(2)));
#define LDS_WAIT() asm volatile("s_waitcnt lgkmcnt(0)" ::: "memory")
#define LDS_BARRIER() do { asm volatile("s_waitcnt lgkmcnt(0)" ::: "memory"); __builtin_amdgcn_s_barrier(); asm volatile("" ::: "memory"); } while (0)

__device__ __forceinline__ unsigned f2bf(float f) { unsigned u = __builtin_bit_cast(unsigned, f); return (u + 0x7fffu + ((u >> 16) & 1u)) >> 16; }
typedef float f32x2c_t __attribute__((ext_vector_type(2))); typedef __bf16 bf16x2c_t __attribute__((ext_vector_type(2)));
__device__ __forceinline__ unsigned pk2(float lo, float hi) { const f32x2c_t v = {lo, hi}; const bf16x2c_t b = __builtin_convertvector(v, bf16x2c_t); return __builtin_bit_cast(unsigned, b); }
__device__ __forceinline__ float bflo(unsigned w) { return __uint_as_float(w << 16); }
__device__ __forceinline__ float bfhi(unsigned w) { return __uint_as_float(w & 0xffff0000u); }
__device__ __forceinline__ float wave_sum(float v) {
#pragma unroll
    for (int o = 1; o < 64; o <<= 1) v += __shfl_xor(v, o);
    return v;
}
__device__ __forceinline__ float wave_max(float v) {
#pragma unroll
    for (int o = 1; o < 64; o <<= 1) v = fmaxf(v, __shfl_xor(v, o));
    return v;
}
__device__ __forceinline__ float log_sigmoid(float x) { return fminf(x, 0.f) - log1pf(expf(-fabsf(x))); }
__device__ __forceinline__ f32x4 mfma16(bf16x8 a, bf16x8 b, f32x4 c) { return __builtin_amdgcn_mfma_f32_16x16x32_bf16(a, b, c, 0, 0, 0); }

__device__ __forceinline__ unsigned opaque(unsigned x) { asm volatile("" : "+v"(x)); return x; }
template <class T> __device__ __forceinline__ T ldg(const void* ubase, unsigned boff) { return *(const T*)((const char*)ubase + boff); }
template <class T> __device__ __forceinline__ void stg(void* ubase, unsigned boff, T v) { *(T*)((char*)ubase + boff) = v; }

struct Args { const float* in[21]; float* out; unsigned char* ws; int ph_lo, ph_hi, probe, pad; };

struct Ctx {
    LAS unsigned char* lds;
    int tid, lane, wave, G, bid, probe;
    const float *x, *c, *ctx, *cctx, *wmod, *bmod, *npre, *npost, *fwin, *fwout, *win, *wout, *convw, *convb, *wq, *wk, *ibias, *fbias, *hnorm, *poolw, *pscale;
    float* out; unsigned char* ws;
    float* mod; bf16 *wqt, *wkt; float *mloc, *gsum, *min_, *cn, *nin, *gates, *gb;
    bf16 *W1, *W2, *WIN, *WOUT, *Y, *Z, *H, *P, *Q, *K, *CIN, *MIX, *CKV, *XB;
};

constexpr int TP0_SCR = 16384;
constexpr int P0_SC_OFF = 131072, P0_RED_OFF = 131072 + 12288;

template <bool TILED>
__device__ __forceinline__ void tr_store(LAS float* scr, bf16* WT, int K, int n0, int k0, int lane) {
    const int c = lane & 7;
#pragma unroll
    for (int j = 0; j < 4; ++j) { const int n = (lane >> 3) + 8 * j; const LAS float* s = scr + (8 * c) * 33 + n;
        u32x4 o; o.x = pk2(s[0 * 33], s[1 * 33]); o.y = pk2(s[2 * 33], s[3 * 33]); o.z = pk2(s[4 * 33], s[5 * 33]); o.w = pk2(s[6 * 33], s[7 * 33]);
        const int nn = n0 + n;
        if (TILED) *(u32x4*)(WT + ((size_t)(nn >> 8) * (K >> 6) + (k0 >> 6)) * (256 * 64) + (size_t)(nn & 255) * 64 + 8 * c) = o;
        else *(u32x4*)(WT + (size_t)nn * K + k0 + 8 * c) = o; }
}
template <bool TILED>
__device__ __forceinline__ void tr_item(const float* W, int ldw, bf16* WT, int K, int n0, int srccol, int k0, LAS float* scr, int lane) {
    float tv[32]; const int sc_ = (srccol >= 0) ? srccol : 0;
#pragma unroll
    for (int i = 0; i < 32; ++i) tv[i] = W[(size_t)(k0 + 2 * i + (lane >> 5)) * ldw + sc_];
#pragma unroll
    for (int i = 0; i < 32; ++i) scr[(2 * i + (lane >> 5)) * 33 + (lane & 31)] = (srccol >= 0) ? tv[i] : 0.f;
    LDS_WAIT(); asm volatile("" ::: "memory");
    tr_store<TILED>(scr, WT, K, n0, k0, lane);
    LDS_WAIT(); asm volatile("" ::: "memory");
}

constexpr int IT_W1 = 16 * 176, IT_W2 = 44 * 32, IT_WIN = 16 * 72, IT_WO = 8 * 32, IT_WE = 8 * 32, IT_QK = 8;
constexpr int IT_TOTAL = 2 * IT_W1 + 2 * IT_W2 + IT_WIN + IT_WO + IT_WE + 8 * IT_QK;

__device__ __forceinline__ void p0_wave_item(const Ctx& F, int it, LAS float* scr) {
    const int lane = F.lane, ln = lane & 31;
    int r = it;
    if (r < 2 * IT_W1) { const int f = r / IT_W1; r -= f * IT_W1; const int kb = r / 176, nb = r % 176, n0 = 32 * nb, pn = n0 >> 8, i = (n0 & 255) + ln;
        const int src = (i < 128) ? 128 * pn + i : FF + 128 * pn + (i - 128);
        tr_item<true>(F.fwin + (size_t)f * DM * 2 * FF, 2 * FF, F.W1 + (size_t)f * 2 * FF * DM, DM, n0, src, 64 * kb, scr, lane); return; }
    r -= 2 * IT_W1;
    if (r < 2 * IT_W2) { const int f = r / IT_W2; r -= f * IT_W2; const int kb = r / 32, nb = r % 32;
        tr_item<true>(F.fwout + (size_t)f * FF * DM, DM, F.W2 + (size_t)f * DM * FF, FF, 32 * nb, 32 * nb + ln, 64 * kb, scr, lane); return; }
    r -= 2 * IT_W2;
    if (r < IT_WIN) { const int kb = r / 72, nb = r % 72, n = 32 * nb + ln;
        const int src = (n < 1536) ? n : (n < 2048) ? n + 16 : (n < 2064) ? n - 512 : -1;
        tr_item<true>(F.win, 2064, F.WIN, DM, 32 * nb, src, 64 * kb, scr, lane); return; }
    r -= IT_WIN;
    if (r < IT_WO) { const int kb = r / 32, nb = r % 32;
        tr_item<true>(F.wout, DM, F.WOUT, DM, 32 * nb, 32 * nb + ln, 64 * kb, scr, lane); return; }
    r -= IT_WO;
    if (r < IT_WE) { const int kb = r / 32, nb = r % 32, g = kb >> 1, kk0 = 64 * (kb & 1), n0 = 32 * nb, fr = lane & 15, fq = lane >> 4;
        const float* pw = F.poolw + (size_t)g * 128 * 128 + (size_t)(kk0 + fr) * 128; const float* ps = F.pscale + g * 128; const float* wo = F.wout + (size_t)(512 + g * 128) * DM + n0 + fr;
        f32x4 acc[4][2];
#pragma unroll
        for (int mt = 0; mt < 4; ++mt) { acc[mt][0] = (f32x4){0.f, 0.f, 0.f, 0.f}; acc[mt][1] = acc[mt][0]; }
#pragma unroll 4
        for (int ks = 0; ks < 32; ++ks) { const int e = 4 * ks + fq; const float pse = ps[e]; const float b0 = wo[(size_t)e * DM], b1 = wo[(size_t)e * DM + 16];
#pragma unroll
            for (int mt = 0; mt < 4; ++mt) { const float a = pw[(size_t)(16 * mt) * 128 + e] * pse;
                acc[mt][0] = __builtin_amdgcn_mfma_f32_16x16x4f32(a, b0, acc[mt][0], 0, 0, 0); acc[mt][1] = __builtin_amdgcn_mfma_f32_16x16x4f32(a, b1, acc[mt][1], 0, 0, 0); } }
#pragma unroll
        for (int mt = 0; mt < 4; ++mt)
#pragma unroll
            for (int nt = 0; nt < 2; ++nt)
#pragma unroll
                for (int e = 0; e < 4; ++e) scr[(16 * mt + 4 * fq + e) * 33 + 16 * nt + fr] = acc[mt][nt][e];
        LDS_WAIT(); asm volatile("" ::: "memory");
        tr_store<true>(scr, F.WOUT, DM, n0, 512 + 64 * kb, lane);
        LDS_WAIT(); asm volatile("" ::: "memory"); return; }
    r -= IT_WE;
    { const int which = r / (4 * IT_QK); r -= which * 4 * IT_QK; const int h = r / IT_QK; r -= h * IT_QK; const int kb = r / 4, nb = r % 4;
      const float* W = (which ? F.wk : F.wq) + (size_t)h * 128 * 128; bf16* WT = (which ? F.wkt : F.wqt) + (size_t)h * 128 * 128;
      tr_item<false>(W, 128, WT, 128, 32 * nb, 32 * nb + ln, 64 * kb, scr, lane); }
}

__device__ __forceinline__ void p0_prologue(const Ctx& F) {
    LAS float* scl = (LAS float*)(F.lds + P0_SC_OFF); LAS float* red = (LAS float*)(F.lds + P0_RED_OFF);
    for (int j = F.bid; j < 144; j += F.G) {
        for (int i = F.tid; i < 3072; i += NTHREADS) { const int b = i >> 10, k = i & 1023; const float v = (b < 2) ? F.c[b * DM + k] : F.cctx[k]; scl[i] = v / (1.0f + expf(-v)); }
        __syncthreads();
        const int col = 64 * j + F.lane, k0 = 128 * F.wave; float a0 = 0.f, a1 = 0.f, a2 = 0.f;
#pragma unroll 32
        for (int kk = 0; kk < 128; ++kk) { const float wv = F.wmod[(size_t)(k0 + kk) * (NMOD * DM) + col]; a0 += scl[k0 + kk] * wv; a1 += scl[1024 + k0 + kk] * wv; a2 += scl[2048 + k0 + kk] * wv; }
        red[(F.wave * 3 + 0) * 64 + F.lane] = a0; red[(F.wave * 3 + 1) * 64 + F.lane] = a1; red[(F.wave * 3 + 2) * 64 + F.lane] = a2;
        __syncthreads();
        if (F.tid < 192) { const int b = F.tid >> 6, l = F.tid & 63; float s = 0.f;
#pragma unroll
            for (int w = 0; w < 8; ++w) s += red[(w * 3 + b) * 64 + l];
            F.mod[b * (NMOD * DM) + 64 * j + l] = s + F.bmod[64 * j + l]; }
        __syncthreads();
    }
}
constexpr int IT_PART0 = IT_W1 + IT_W2, IT_PART1 = IT_TOTAL - IT_PART0;
__device__ __forceinline__ void convert_items(const Ctx& F, int part, int first_block, int nblocks, int idx_lo = 0, int idx_hi = 1 << 30) {
    if (F.bid < first_block || F.bid >= first_block + nblocks) return;
    LAS float* scr = (LAS float*)(F.lds + F.wave * TP0_SCR);
    const int gw = (F.bid - first_block) * NWAVES + F.wave, NGW = nblocks * NWAVES, n = min(part ? IT_PART1 : IT_PART0, idx_hi);
    for (int idx = idx_lo + gw; idx < n; idx += NGW) {
        int it;
        if (part == 0) it = (idx < IT_W1) ? idx : 2 * IT_W1 + (idx - IT_W1);
        else it = (idx < IT_W1) ? IT_W1 + idx : (idx < IT_W1 + IT_W2) ? 2 * IT_W1 + IT_W2 + (idx - IT_W1) : 2 * IT_W1 + 2 * IT_W2 + (idx - IT_W1 - IT_W2);
        p0_wave_item(F, it, scr); }
}

__device__ __forceinline__ void ld_row_f32(const float* row, int lane, f32x4 (&v)[4]) {
    v[0] = *(const f32x4*)(row + 8 * lane); v[1] = *(const f32x4*)(row + 8 * lane + 4); v[2] = *(const f32x4*)(row + 512 + 8 * lane); v[3] = *(const f32x4*)(row + 512 + 8 * lane + 4); }
__device__ __forceinline__ void st_row_f32(float* row, int lane, const f32x4 (&v)[4]) {
    *(f32x4*)(row + 8 * lane) = v[0]; *(f32x4*)(row + 8 * lane + 4) = v[1]; *(f32x4*)(row + 512 + 8 * lane) = v[2]; *(f32x4*)(row + 512 + 8 * lane + 4) = v[3]; }
__device__ __forceinline__ void unpack_row(const u32x4 (&w)[2], f32x4 (&v)[4]) {
#pragma unroll
    for (int h = 0; h < 2; ++h) { v[2 * h] = (f32x4){bflo(w[h].x), bfhi(w[h].x), bflo(w[h].y), bfhi(w[h].y)}; v[2 * h + 1] = (f32x4){bflo(w[h].z), bfhi(w[h].z), bflo(w[h].w), bfhi(w[h].w)}; } }
__device__ __forceinline__ void st_row_bf16(bf16* row, int lane, const f32x4 (&v)[4]) {
#pragma unroll
    for (int h = 0; h < 2; ++h) { u32x4 w; w.x = pk2(v[2 * h].x, v[2 * h].y); w.y = pk2(v[2 * h].z, v[2 * h].w); w.z = pk2(v[2 * h + 1].x, v[2 * h + 1].y); w.w = pk2(v[2 * h + 1].z, v[2 * h + 1].w);
        *(u32x4*)(row + 512 * h + 8 * lane) = w; } }
__device__ __forceinline__ float sumsq_row(const f32x4 (&v)[4]) { float ss = 0.f;
#pragma unroll
    for (int j = 0; j < 4; ++j) ss += (v[j].x * v[j].x + v[j].y * v[j].y) + (v[j].z * v[j].z + v[j].w * v[j].w);
    return ss; }
template <bool HAS_Z, int XSRC, int XDST, bool WRITE_Y>
__device__ __forceinline__ void row_phase(const Ctx& F, int nrows, float resw, int jsub) {
    const int gw = F.bid * NWAVES + F.wave, NGW = F.G * NWAVES, lane = F.lane;
    constexpr int NR = 2;
#pragma unroll 1
    for (int seg = 0; seg < 3; ++seg) {
        const int s_lo = (seg < 2) ? seg * SEQ : ML, s_hi = min((seg < 2) ? (seg + 1) * SEQ : MT, nrows);
        if (s_lo + gw >= s_hi) continue;
        const int mb = seg;
        f32x4 gv[4], sv[4], cv[4];
        if (HAS_Z) { const int js = jsub - 1; f32x4 ga[4], gg[4];
            ld_row_f32(F.mod + (size_t)mb * (NMOD * DM) + (3 * js + 2) * DM, lane, ga); ld_row_f32(F.npost + js * DM, lane, gg);
#pragma unroll
            for (int j = 0; j < 4; ++j) gv[j] = ga[j] * gg[j] * resw; }
        if (WRITE_Y) { const float* sh = F.mod + (size_t)mb * (NMOD * DM) + (3 * jsub) * DM; f32x4 c4[4], g4[4];
            ld_row_f32(sh, lane, sv); ld_row_f32(sh + DM, lane, c4); ld_row_f32(F.npre + jsub * DM, lane, g4);
#pragma unroll
            for (int j = 0; j < 4; ++j) cv[j] = g4[j] * (c4[j] + 1.0f); }
#pragma unroll 1
        for (int r0 = s_lo + gw; r0 < s_hi; r0 += NR * NGW) {
            int rws[NR]; bool okr[NR]; f32x4 v[NR][4]; u32x4 xw[NR][2], zw[NR][2];
#pragma unroll
            for (int q = 0; q < NR; ++q) { const int r = r0 + q * NGW; okr[q] = r < s_hi; rws[q] = okr[q] ? r : r0; }
#pragma unroll
            for (int q = 0; q < NR; ++q) {
                if (XSRC == 0) ld_row_f32((rws[q] < ML) ? F.x + (size_t)rws[q] * DM : F.ctx + (size_t)(rws[q] - ML) * DM, lane, v[q]);
                else { xw[q][0] = *(const u32x4*)(F.XB + (size_t)rws[q] * DM + 8 * lane); xw[q][1] = *(const u32x4*)(F.XB + (size_t)rws[q] * DM + 512 + 8 * lane); }
                if (HAS_Z) { zw[q][0] = *(const u32x4*)(F.Z + (size_t)rws[q] * DM + 8 * lane); zw[q][1] = *(const u32x4*)(F.Z + (size_t)rws[q] * DM + 512 + 8 * lane); } }
#pragma unroll
            for (int q = 0; q < NR; ++q) { const int r = rws[q];
                if (XSRC == 1) unpack_row(xw[q], v[q]);
                if (HAS_Z) {
                    f32x4 z[4]; unpack_row(zw[q], z);
                    const float rz = rsqrtf(wave_sum(sumsq_row(z)) * (1.0f / DM) + EPS);
#pragma unroll
                    for (int j = 0; j < 4; ++j) v[q][j] = v[q][j] + (z[j] * rz) * gv[j];
                    if (XDST == 1 && r < ML && okr[q]) st_row_bf16(F.XB + (size_t)r * DM, lane, v[q]);
                    if (XDST == 2 && okr[q]) st_row_f32(F.out + (size_t)r * DM, lane, v[q]);
                }
                if (WRITE_Y) {
                    const float rr = rsqrtf(wave_sum(sumsq_row(v[q])) * (1.0f / DM) + EPS); f32x4 y[4];
#pragma unroll
                    for (int j = 0; j < 4; ++j) y[j] = (v[q][j] * rr) * cv[j] + sv[j];
                    if (okr[q]) {
                        bf16* yt = F.Y + (size_t)(r >> 8) * (256 * DM) + (size_t)(r & 255) * 64 + (size_t)(lane >> 3) * (256 * 64) + 8 * (lane & 7);
#pragma unroll
                        for (int h = 0; h < 2; ++h) { u32x4 w; w.x = pk2(y[2 * h].x, y[2 * h].y); w.y = pk2(y[2 * h].z, y[2 * h].w); w.z = pk2(y[2 * h + 1].x, y[2 * h + 1].y); w.w = pk2(y[2 * h + 1].z, y[2 * h + 1].w);
                            *(u32x4*)(yt + (size_t)h * 8 * (256 * 64)) = w; } }
                }
            }
        }
    }
}

constexpr int TP = 272, TILE_B = 128 * TP;
__device__ __forceinline__ bf16x8 ldfrag(LAS unsigned char* tile, int row, int kk, int fq) { return *(const LAS bf16x8*)(tile + row * TP + (32 * kk + 8 * fq) * 2); }
__device__ __forceinline__ void st4(LAS unsigned char* tile, int row, int col, float a, float b, float c, float d) { u32x2 w; w.x = pk2(a, b); w.y = pk2(c, d); *(LAS u32x2*)(tile + row * TP + col * 2) = w; }
__device__ __forceinline__ bf16x8 ident_frag(int nt, int fr, int fq) { const int jj = 16 * (nt & 1) + fr - 8 * fq; bf16x8 f;
#pragma unroll
    for (int j = 0; j < 8; ++j) f[j] = (j == jj) ? (short)0x3F80 : (short)0;
    return f; }
constexpr float LOG2E = 1.4426950408889634f, LN2 = 0.6931471805599453f;
__device__ __forceinline__ float fexp(float x) { return __builtin_amdgcn_exp2f(x * LOG2E); }
__device__ __forceinline__ float fsigmoid(float x) { return __builtin_amdgcn_rcpf(1.0f + fexp(-x)); }
__device__ __forceinline__ float flog_sigmoid(float x) { return fminf(x, 0.f) - LN2 * __builtin_amdgcn_logf(1.0f + fexp(-fabsf(x))); }
struct GateScan { float ip0, ip1, b0, b1, g; int tau0, tau1; };
__device__ __forceinline__ GateScan gate_scan(const float* gates, int R0, int dir, int h, int lane) {
    GateScan r; r.tau0 = dir ? 127 - 2 * lane : 2 * lane; r.tau1 = dir ? r.tau0 - 1 : r.tau0 + 1;
    const float* gr = gates + (size_t)R0 * 16 + dir * 4 + h;
    r.ip0 = gr[r.tau0 * 16]; r.ip1 = gr[r.tau1 * 16];
    const float lf0 = flog_sigmoid(gr[r.tau0 * 16 + 8]), lf1 = flog_sigmoid(gr[r.tau1 * 16 + 8]);
    const float s = lf0 + lf1; float incl = s;
#pragma unroll
    for (int o = 1; o < 64; o <<= 1) { const float t = __shfl_up(incl, o); if (lane >= o) incl += t; }
    r.b0 = incl - s + lf0; r.b1 = incl; r.g = __shfl(incl, 63);
    return r;
}
__device__ __forceinline__ void make_vt(const bf16* vrow  , LAS unsigned char* VT, int w, int fr, int fq) {
#pragma unroll
    for (int nt = 0; nt < 8; ++nt) { const bf16x8 vf = *(const bf16x8*)(vrow + 32 * (nt >> 1) + 8 * fq);
        const f32x4 a = mfma16(vf, ident_frag(nt, fr, fq), (f32x4){0.f, 0.f, 0.f, 0.f});
        st4(VT, 16 * nt + fr, 16 * w + 4 * fq, a[0], a[1], a[2], a[3]); }
}

constexpr int M1_U = 0, M1_KW0 = TILE_B, M1_KW1 = 2 * TILE_B, M1_VT = 3 * TILE_B, M1_WGT = 4 * TILE_B;
constexpr int M1_UNITS = NB * NH * NTB;
struct M1Pre { u32x4 cu[4], pv[4], nx[4]; bf16x8 vf[8]; float gi0, gi1, gf0, gf1; };
__device__ __forceinline__ void m1_geom(int unit, int& bh, int& tb, int& R0, int& t0, int& L) {
    bh = unit & 7; tb = unit >> 3; const int b = bh >> 2; const bool isctx = tb < 2;
    R0 = isctx ? ML + b * CTXL + tb * 128 : b * SEQ + (tb - 2) * 128; t0 = isctx ? tb * 128 : (tb - 2) * 128; L = isctx ? CTXL : SEQ; }
__device__ __forceinline__ void m1_load(const Ctx& F, int unit, M1Pre& P) {
    const int tid = F.tid, lane = F.lane, w = F.wave, fr = lane & 15, fq = lane >> 4;
    int bh, tb, R0, t0, L; m1_geom(unit, bh, tb, R0, t0, L); const int h = bh & 3;
    const bf16* pb = F.P + (size_t)R0 * 2048 + h * 128;
    { const unsigned tau0 = tid >> 4, c8 = (tid & 15) * 8;
#pragma unroll
      for (int it = 0; it < 4; ++it) { const int tau = tau0 + 32 * it; const bool hp = (t0 + tau > 0), hn_ = (t0 + tau < L - 1);
          const unsigned o = opaque((tau * 2048 + c8) * 2); const char* pp = (const char*)pb + o;
          P.cu[it] = *(const u32x4*)pp; P.pv[it] = *(const u32x4*)(hp ? pp - 4096 : pp); P.nx[it] = *(const u32x4*)(hn_ ? pp + 4096 : pp); } }
    { const int dir = w & 1, tau0 = dir ? 127 - 2 * lane : 2 * lane, tau1 = dir ? tau0 - 1 : tau0 + 1;
      const float* gr = F.gates + (size_t)R0 * 16 + dir * 4 + h;
      P.gi0 = gr[tau0 * 16]; P.gi1 = gr[tau1 * 16]; P.gf0 = gr[tau0 * 16 + 8]; P.gf1 = gr[tau1 * 16 + 8]; }
}
__device__ __forceinline__ void m1_load_v(const Ctx& F, int unit, M1Pre& P) {
    const int lane = F.lane, w = F.wave, fr = lane & 15, fq = lane >> 4;
    int bh, tb, R0, t0, L; m1_geom(unit, bh, tb, R0, t0, L); const int h = bh & 3;
    const bf16* pb = F.P + (size_t)R0 * 2048 + h * 128;
    const unsigned o = opaque((fr * 2048 + 512 + 32 * (w >> 1) + 8 * fq) * 2);
#pragma unroll
    for (int tt = 0; tt < 8; ++tt) P.vf[tt] = ldg<bf16x8>(pb + (size_t)16 * tt * 2048, o);
}
__device__ __forceinline__ void m1_phase(const Ctx& F) {
    const int tid = F.tid, lane = F.lane, w = F.wave, fr = lane & 15, fq = lane >> 4;
    LAS unsigned char* U = F.lds + M1_U; LAS unsigned char* VT = F.lds + M1_VT; LAS float* wgt = (LAS float*)(F.lds + M1_WGT);
    int unit = F.bid; if (unit >= M1_UNITS) return;
    const int h = unit & 3;
    bf16x8 wqf[4], wkf[4];
#pragma unroll
    for (int kk = 0; kk < 4; ++kk) { wqf[kk] = *(const bf16x8*)(F.wqt + (size_t)(h * 128 + 16 * w + fr) * 128 + 32 * kk + 8 * fq); wkf[kk] = *(const bf16x8*)(F.wkt + (size_t)(h * 128 + 16 * w + fr) * 128 + 32 * kk + 8 * fq); }
    M1Pre cur; m1_load(F, unit, cur); m1_load_v(F, unit, cur);
    if ((F.G & 7) != 0) return;
#pragma unroll 1
    for (;;) {
        int bh, tb, R0, t0, L; m1_geom(unit, bh, tb, R0, t0, L);
        { const int ch8 = (tid & 15) * 8, ch = h * 128 + ch8;
          f32x4 cw[3][2], cb[2];
#pragma unroll
          for (int jj = 0; jj < 3; ++jj) { cw[jj][0] = *(const f32x4*)(F.convw + jj * MW + ch); cw[jj][1] = *(const f32x4*)(F.convw + jj * MW + ch + 4); }
          cb[0] = *(const f32x4*)(F.convb + ch); cb[1] = *(const f32x4*)(F.convb + ch + 4);
#pragma unroll
          for (int it = 0; it < 4; ++it) { const int tau = (tid >> 4) + 32 * it; const bool hp = (t0 + tau > 0), hn_ = (t0 + tau < L - 1);
            const u32x4 cu = cur.cu[it]; u32x4 pv = cur.pv[it], nx = cur.nx[it];
            pv.x = hp ? pv.x : 0u; pv.y = hp ? pv.y : 0u; pv.z = hp ? pv.z : 0u; pv.w = hp ? pv.w : 0u; nx.x = hn_ ? nx.x : 0u; nx.y = hn_ ? nx.y : 0u; nx.z = hn_ ? nx.z : 0u; nx.w = hn_ ? nx.w : 0u;
            float o[8];
#pragma unroll
            for (int e = 0; e < 8; ++e) { const unsigned wc_ = cu[e >> 1], wp = pv[e >> 1], wn = nx[e >> 1];
                const float xc = (e & 1) ? bfhi(wc_) : bflo(wc_), xp = (e & 1) ? bfhi(wp) : bflo(wp), xn = (e & 1) ? bfhi(wn) : bflo(wn);
                const float val = cb[e >> 2][e & 3] + xp * cw[0][e >> 2][e & 3] + xc * cw[1][e >> 2][e & 3] + xn * cw[2][e >> 2][e & 3];
                o[e] = val * fsigmoid(val); }
            u32x4 ow; ow.x = pk2(o[0], o[1]); ow.y = pk2(o[2], o[3]); ow.z = pk2(o[4], o[5]); ow.w = pk2(o[6], o[7]);
            *(LAS u32x4*)(U + tau * TP + ch8 * 2) = ow; } }
        if (w < 2) { const int dir = w, tau0 = dir ? 127 - 2 * lane : 2 * lane, tau1 = dir ? tau0 - 1 : tau0 + 1;
            const float ip0 = cur.gi0, ip1 = cur.gi1, lf0 = flog_sigmoid(cur.gf0), lf1 = flog_sigmoid(cur.gf1);
            const float s_ = lf0 + lf1; float incl = s_;
#pragma unroll
            for (int o = 1; o < 64; o <<= 1) { const float t = __shfl_up(incl, o); if (lane >= o) incl += t; }
            const float b0 = incl - s_ + lf0, b1 = incl, g = __shfl(incl, 63);
            const float a0 = g - b0 + ip0, a1 = g - b1 + ip1, ml = wave_max(fmaxf(a0, a1));
            wgt[dir * 128 + tau0] = fexp(a0 - ml); wgt[dir * 128 + tau1] = fexp(a1 - ml);
            const int sidx = (bh * 2 + dir) * NTB + tb;
            if (lane == 0) { F.mloc[sidx] = ml; F.gsum[sidx] = g; }
            const float c0 = ip0 - b0, c1 = ip1 - b1;
            float pm = fmaxf(c0, c1);
#pragma unroll
            for (int o = 1; o < 64; o <<= 1) { const float t = __shfl_up(pm, o); if (lane >= o) pm = fmaxf(pm, t); }
            float pmx = __shfl_up(pm, 1); if (lane == 0) pmx = -INFINITY;
            float* gbp = F.gb + (size_t)sidx * 384;
            gbp[tau0] = b0; gbp[tau1] = b1; gbp[128 + tau0] = c0; gbp[128 + tau1] = c1; gbp[256 + tau0] = fmaxf(pmx, c0); gbp[256 + tau1] = pm; }
        const int unext = unit + F.G; const bool has_next = unext < M1_UNITS;
        m1_load(F, has_next ? unext : unit, cur);
        LDS_BARRIER();
        { const bf16x8 idf = ident_frag(w, fr, fq); const float ksc = 0.08838834764831845f;
          bf16* qb = F.Q + (size_t)R0 * 512 + h * 128 + 16 * w; bf16* kb = F.K + (size_t)R0 * 512 + h * 128 + 16 * w;
          const unsigned go = opaque((fr * 512 + 4 * fq) * 2), fb16 = opaque(fr * TP + fq * 16), sb = opaque((16 * w + fr) * TP + 8 * fq);
#pragma unroll
          for (int tt = 0; tt < 8; ++tt) { bf16x8 uf[4];
#pragma unroll
              for (int kk = 0; kk < 4; ++kk) uf[kk] = *(const LAS bf16x8*)(U + fb16 + 16 * tt * TP + 64 * kk);
              f32x4 q = (f32x4){0.f, 0.f, 0.f, 0.f}, k = q, k2 = q;
#pragma unroll
              for (int kk = 0; kk < 4; ++kk) { q = mfma16(wqf[kk], uf[kk], q); k = mfma16(wkf[kk], uf[kk], k); k2 = mfma16(uf[kk], wkf[kk], k2); }
              { u32x2 o; o.x = pk2(q[0], q[1]); o.y = pk2(q[2], q[3]); stg<u32x2>(qb + (size_t)16 * tt * 512, go, o); }
              { u32x2 o; o.x = pk2(k[0] * ksc, k[1] * ksc); o.y = pk2(k[2] * ksc, k[3] * ksc); stg<u32x2>(kb + (size_t)16 * tt * 512, go, o); }
#pragma unroll
              for (int dir = 0; dir < 2; ++dir) { const f32x4 wv = *(const LAS f32x4*)(wgt + dir * 128 + 16 * tt + 4 * fq);
                  u32x2 o; o.x = pk2(k2[0] * ksc * wv[0], k2[1] * ksc * wv[1]); o.y = pk2(k2[2] * ksc * wv[2], k2[3] * ksc * wv[3]);
                  *(LAS u32x2*)(F.lds + (dir ? M1_KW1 : M1_KW0) + sb + 32 * tt) = o; }
              const f32x4 a = mfma16(cur.vf[tt], idf, (f32x4){0.f, 0.f, 0.f, 0.f});
              { u32x2 o; o.x = pk2(a[0], a[1]); o.y = pk2(a[2], a[3]); *(LAS u32x2*)(VT + sb + 32 * tt) = o; } } }
        m1_load_v(F, has_next ? unext : unit, cur);
        LDS_BARRIER();
        { const unsigned fb16 = opaque(fr * TP + fq * 16); bf16x8 vtf[4];
#pragma unroll
          for (int kk = 0; kk < 4; ++kk) vtf[kk] = *(const LAS bf16x8*)(VT + fb16 + 16 * w * TP + 64 * kk);
#pragma unroll
          for (int dir = 0; dir < 2; ++dir) { LAS unsigned char* KW = F.lds + (dir ? M1_KW1 : M1_KW0);
              const int cs = dir ? (tb < 2 ? 1 - tb : 131 - tb) : tb;
              bf16* cg_ = F.CKV + ((size_t)((bh * 2 + dir) * NTB + cs)) * 16384 + (size_t)16 * w * 128;
              const unsigned co = opaque((fr * 128 + 4 * fq) * 2);
              f32x4 acc[8];
#pragma unroll
              for (int mt = 0; mt < 8; ++mt) acc[mt] = (f32x4){0.f, 0.f, 0.f, 0.f};
#pragma unroll
              for (int kk = 0; kk < 4; ++kk) { bf16x8 kf[8];
#pragma unroll
                  for (int mt = 0; mt < 8; ++mt) kf[mt] = *(const LAS bf16x8*)(KW + fb16 + 16 * mt * TP + 64 * kk);
#pragma unroll
                  for (int mt = 0; mt < 8; ++mt) acc[mt] = mfma16(kf[mt], vtf[kk], acc[mt]); }
#pragma unroll
              for (int mt = 0; mt < 8; ++mt) { u32x2 o; o.x = pk2(acc[mt][0], acc[mt][1]); o.y = pk2(acc[mt][2], acc[mt][3]); stg<u32x2>(cg_ + 16 * mt, co, o); } } }
        if (tid < 256) { const int dir = tid >> 7, dk = tid & 127; LAS unsigned char* KW = F.lds + (dir ? M1_KW1 : M1_KW0) + dk * TP; float s_ = 0.f;
#pragma unroll
            for (int c = 0; c < 16; ++c) { const u32x4 q = *(const LAS u32x4*)(KW + 16 * c); s_ += (bflo(q.x) + bfhi(q.x)) + (bflo(q.y) + bfhi(q.y)) + (bflo(q.z) + bfhi(q.z)) + (bflo(q.w) + bfhi(q.w)); }
            const int cs = dir ? (tb < 2 ? 1 - tb : 131 - tb) : tb;
            F.cn[((size_t)((bh * 2 + dir) * NTB + cs)) * 128 + dk] = s_; }
        if (!has_next) break;
        unit = unext;
    }
}

template <int G_>
__device__ __forceinline__ void pool_unit_t(const Ctx& F, int b, int r) {
    constexpr int win = 2 << G_, lo = win >> 1, hi = win - 1 - lo;
    const int tid = F.tid, chunk = tid & 15, cb = tid >> 4;
    const int rlo = max(r - lo, 0), rhi = min(r + hi, GRID_ROWS - 1); const float cntr = (float)(rhi - rlo + 1);
    LAS float* vs = (LAS float*)F.lds;
    const bf16* base = F.P + (size_t)b * SEQ * 2048 + 1536 + G_ * 128;
    const unsigned off = opaque((cb * 2048 + 8 * chunk) * 2);
    f32x4 s[2][2];
#pragma unroll
    for (int k = 0; k < 2; ++k) { s[k][0] = (f32x4){0.f, 0.f, 0.f, 0.f}; s[k][1] = s[k][0]; }
#pragma unroll
    for (int i = 0; i < win; ++i) { const int rr = r - lo + i; const bool ok = (rr >= 0) && (rr < GRID_ROWS); const int rc = min(max(rr, 0), GRID_ROWS - 1);
#pragma unroll
        for (int k = 0; k < 2; ++k) { u32x4 wv = ldg<u32x4>(base + (size_t)(rc * GW + 32 * k) * 2048, off);
            wv.x = ok ? wv.x : 0u; wv.y = ok ? wv.y : 0u; wv.z = ok ? wv.z : 0u; wv.w = ok ? wv.w : 0u;
            s[k][0] = s[k][0] + (f32x4){bflo(wv.x), bfhi(wv.x), bflo(wv.y), bfhi(wv.y)}; s[k][1] = s[k][1] + (f32x4){bflo(wv.z), bfhi(wv.z), bflo(wv.w), bfhi(wv.w)}; } }
    u32x4 ctr[2];
#pragma unroll
    for (int k = 0; k < 2; ++k) { ctr[k] = ldg<u32x4>(base + (size_t)(r * GW + 32 * k) * 2048, off);
        LAS float* vp = vs + (cb + 32 * k) * 128 + 8 * chunk; *(LAS f32x4*)vp = s[k][0]; *(LAS f32x4*)(vp + 4) = s[k][1]; }
    LDS_BARRIER();
#pragma unroll
    for (int k = 0; k < 2; ++k) { const int c = cb + 32 * k, clo = max(c - lo, 0), chi = min(c + hi, GW - 1); f32x4 t0 = (f32x4){0.f, 0.f, 0.f, 0.f}, t1 = t0;
#pragma unroll
        for (int i = 0; i < win; ++i) { const int c2 = c - lo + i; const bool ok = (c2 >= 0) && (c2 < GW); const LAS float* vp = vs + min(max(c2, 0), GW - 1) * 128 + 8 * chunk;
            const f32x4 a0 = *(const LAS f32x4*)vp, a1 = *(const LAS f32x4*)(vp + 4); const float m_ = ok ? 1.f : 0.f; t0 = t0 + a0 * m_; t1 = t1 + a1 * m_; }
        const float inv = 1.0f / (cntr * (float)(chi - clo + 1)); const u32x4 cw = ctr[k];
        u32x4 o; o.x = pk2(t0[0] * inv - bflo(cw.x), t0[1] * inv - bfhi(cw.x)); o.y = pk2(t0[2] * inv - bflo(cw.y), t0[3] * inv - bfhi(cw.y));
        o.z = pk2(t1[0] * inv - bflo(cw.z), t1[1] * inv - bfhi(cw.z)); o.w = pk2(t1[2] * inv - bflo(cw.w), t1[3] * inv - bfhi(cw.w));
        { const int row = b * SEQ + r * GW + c, col = 512 + G_ * 128 + 8 * chunk;
          *(u32x4*)(F.MIX + (size_t)(row >> 8) * (256 * 1024) + (size_t)(col >> 6) * (256 * 64) + (size_t)(row & 255) * 64 + (col & 63)) = o; } }
    LDS_BARRIER();
}
__device__ __forceinline__ void pool_unit(const Ctx& F, int unit) {
    const int k = unit / GRID_ROWS, r = unit % GRID_ROWS, b = k >> 2, g = (r + k) & 3;
    if (g == 0) pool_unit_t<0>(F, b, r); else if (g == 1) pool_unit_t<1>(F, b, r); else if (g == 2) pool_unit_t<2>(F, b, r); else pool_unit_t<3>(F, b, r);
}

__device__ __forceinline__ void scan_phase(const Ctx& F) {
    const int nslots = 16 * 2048; constexpr int NA = 128;
    LAS float* sg = (LAS float*)F.lds;
    for (int base = F.bid * NA; base < nslots; base += F.G * NA) {
        const int slot = base + (F.tid & (NA - 1)), stream = base >> 11, po = slot & 2047, dir = stream & 1; const bool active = F.tid < NA;
        __syncthreads();
        if (F.tid < NTB) { const int c = F.tid, tb = dir ? (c < 2 ? 1 - c : 131 - c) : c; const size_t sidx = (size_t)stream * NTB + tb; sg[c] = F.gsum[sidx]; sg[NTB + c] = F.mloc[sidx]; }
        __syncthreads();
        if (!active) continue;
        const long cstep = dir ? -1 : 1; const int tb0 = dir ? 129 : 2;
        if (po < 32) {
            f32x4 nv = (f32x4){0.f, 0.f, 0.f, 0.f}; float m = 0.f;
            const float* cnp = F.cn + (size_t)stream * NTB * 128 + 4 * po; float* ninp = F.nin + ((size_t)stream * NTB + tb0) * 128 + 4 * po; float* minp = F.min_ + (size_t)stream * NTB + tb0;
#pragma unroll 1
            for (int c0 = 0; c0 < NTB; c0 += 26) { f32x4 cnv[26];
#pragma unroll
                for (int i = 0; i < 26; ++i) cnv[i] = *(const f32x4*)(cnp + (size_t)(c0 + i) * 128);
#pragma unroll
                for (int i = 0; i < 26; ++i) { const int c = c0 + i;
                    if (c >= 2) { *(f32x4*)(ninp + cstep * (long)(c - 2) * 128) = nv; if (po == 0) minp[cstep * (long)(c - 2)] = m; }
                    const float gi = sg[c], mi = sg[NTB + c];
                    const float mn = fmaxf(gi + m, mi), ao = fexp(gi + m - mn), an = fexp(mi - mn);
                    nv = nv * ao + cnv[i] * an; m = mn; } } }
        f32x4 C0 = (f32x4){0.f, 0.f, 0.f, 0.f}, C1 = C0; float m = 0.f;
        const bf16* ckv = F.CKV + (size_t)stream * NTB * 16384 + 8 * po; bf16* cin = F.CIN + ((size_t)stream * 128 + (tb0 - 2)) * 16384 + 8 * po;
#pragma unroll 1
        for (int c0 = 0; c0 < NTB; c0 += 13) {
            u32x4 ck[13];
#pragma unroll
            for (int i = 0; i < 13; ++i) ck[i] = *(const u32x4*)(ckv + (size_t)(c0 + i) * 16384);
#pragma unroll
            for (int i = 0; i < 13; ++i) { const int c = c0 + i;
                if (c >= 2) { u32x4 o; o.x = pk2(C0[0], C0[1]); o.y = pk2(C0[2], C0[3]); o.z = pk2(C1[0], C1[1]); o.w = pk2(C1[2], C1[3]); *(u32x4*)(cin + cstep * (long)(c - 2) * 16384) = o; }
                const float gi = sg[c], mi = sg[NTB + c];
                const float mn = fmaxf(gi + m, mi), ao = fexp(gi + m - mn), an = fexp(mi - mn);
                C0 = C0 * ao + (f32x4){bflo(ck[i].x), bfhi(ck[i].x), bflo(ck[i].y), bfhi(ck[i].y)} * an;
                C1 = C1 * ao + (f32x4){bflo(ck[i].z), bfhi(ck[i].z), bflo(ck[i].w), bfhi(ck[i].w)} * an; m = mn; }
        }
    }
    __syncthreads();
}

constexpr int M3_K = 0, M3_VT = TILE_B, M3_CT0 = 2 * TILE_B, M3_CT1 = 3 * TILE_B, M3_MISC = 4 * TILE_B;
constexpr int M3_UNITS = NB * NH * 128;
struct M3Pre { u32x4 kr[4]; };
__device__ __forceinline__ void m3_decode(int unit, int& bh, int& j) { bh = unit & 7; j = unit >> 3; }
__device__ __forceinline__ void m3_load(const Ctx& F, int unit, M3Pre& P) {
    const int tid = F.tid;
    int bh, j; m3_decode(unit, bh, j); const int h = bh & 3, b = bh >> 2, R0 = b * SEQ + j * 128;
    const bf16* kb = F.K + (size_t)R0 * 512 + h * 128;
    const unsigned row0 = tid >> 4, c8 = (tid & 15) * 8;
    const unsigned ok_ = opaque((row0 * 512 + c8) * 2);
#pragma unroll
    for (int it = 0; it < 4; ++it) P.kr[it] = ldg<u32x4>(kb + (size_t)it * 32 * 512, ok_);
}
__device__ __forceinline__ void m3_phase(const Ctx& F) {
    const int tid = F.tid, lane = F.lane, w = F.wave, fr = lane & 15, fq = lane >> 4;
    LAS unsigned char* Kt = F.lds + M3_K; LAS unsigned char* VT = F.lds + M3_VT;
    LAS float* rt2 = (LAS float*)(F.lds + M3_MISC); LAS float* ct2 = rt2 + 256; LAS float* winter = rt2 + 512; LAS float* minv = rt2 + 768; LAS float* ninl = rt2 + 1024;
    int unit = F.bid; if (unit >= M3_UNITS) return;
    M3Pre cur; m3_load(F, unit, cur);
    const int t = 16 * w + fr;
#pragma unroll 1
    for (;;) {
        int bh, j; m3_decode(unit, bh, j); const int h = bh & 3, b = bh >> 2, R0 = b * SEQ + j * 128;
        bf16x8 qf[4], vr[4];
        { const bf16* vb = F.P + (size_t)R0 * 2048 + 512 + h * 128; const bf16* qb = F.Q + (size_t)R0 * 512 + h * 128; const unsigned tr = opaque(16 * w + fr);
#pragma unroll
          for (int kk = 0; kk < 4; ++kk) { vr[kk] = ldg<bf16x8>(vb, (tr * 2048 + 8 * fq + 32 * kk) * 2); qf[kk] = ldg<bf16x8>(qb, (tr * 512 + 32 * kk + 8 * fq) * 2); } }
        float g_b, g_c, g_pm, g_min, g_nin;
        { const unsigned t2 = tid & 255, dir = t2 >> 7, tau = t2 & 127; const size_t s0 = (size_t)(bh * 2) * NTB + j + 2;
          const unsigned so = opaque(dir * NTB);
          g_b = ldg<float>(F.gb + s0 * 384, (so * 384 + tau) * 4); g_c = ldg<float>(F.gb + s0 * 384, (so * 384 + 128 + tau) * 4); g_pm = ldg<float>(F.gb + s0 * 384, (so * 384 + 256 + tau) * 4);
          g_min = ldg<float>(F.min_ + s0, so * 4); g_nin = ldg<float>(F.nin + s0 * 128, (so * 128 + tau) * 4); }
        u32x4 c0r[4], c1r[4];
        { const bf16* cin0 = F.CIN + ((size_t)(bh * 2 + 0) * 128 + j) * 16384; const bf16* cin1 = F.CIN + ((size_t)(bh * 2 + 1) * 128 + j) * 16384; const unsigned oc_ = opaque(((tid >> 4) * 128 + (tid & 15) * 8) * 2);
#pragma unroll
          for (int it = 0; it < 4; ++it) { c0r[it] = ldg<u32x4>(cin0 + (size_t)it * 32 * 128, oc_); c1r[it] = ldg<u32x4>(cin1 + (size_t)it * 32 * 128, oc_); } }
        LDS_BARRIER();
        { LAS unsigned char* wb = F.lds + opaque((tid >> 4) * TP + (tid & 15) * 16);
#pragma unroll
          for (int it = 0; it < 4; ++it) { *(LAS u32x4*)(wb + M3_K + it * 32 * TP) = cur.kr[it]; *(LAS u32x4*)(wb + M3_CT0 + it * 32 * TP) = c0r[it]; *(LAS u32x4*)(wb + M3_CT1 + it * 32 * TP) = c1r[it]; } }
        { const int fr_o = (int)opaque((unsigned)fr);
#pragma unroll
          for (int nt = 0; nt < 8; ++nt) { const f32x4 a = mfma16(vr[nt >> 1], ident_frag(nt, fr_o, fq), (f32x4){0.f, 0.f, 0.f, 0.f}); st4(VT, 16 * nt + fr_o, 16 * w + 4 * fq, a[0], a[1], a[2], a[3]); } }
        if (tid < 256) { const float mt_ = g_b + fmaxf(g_pm, g_min); LAS float* mb = (LAS float*)(F.lds + M3_MISC + opaque(tid * 4));
            mb[1024] = g_nin; mb[0] = (g_b - mt_) * LOG2E; mb[256] = g_c * LOG2E; mb[512] = fexp(g_b + g_min - mt_); mb[768] = fexp(-mt_); }
        const int unext = unit + F.G; const bool has_next = unext < M3_UNITS;
        m3_load(F, has_next ? unext : unit, cur);
        LDS_BARRIER();
        const unsigned fb16 = opaque(fr * TP + fq * 16), fb8 = opaque(fr * TP + fq * 8);
        const int dlt = (int)opaque((unsigned)(t - 4 * fq));
        f32x4 acc[8];
#pragma unroll
        for (int mt = 0; mt < 8; ++mt) acc[mt] = (f32x4){0.f, 0.f, 0.f, 0.f};
#pragma unroll
        for (int kk = 0; kk < 4; ++kk) { bf16x8 kf[8];
#pragma unroll
            for (int mt = 0; mt < 8; ++mt) kf[mt] = *(const LAS bf16x8*)(Kt + fb16 + 16 * mt * TP + 64 * kk);
#pragma unroll
            for (int mt = 0; mt < 8; ++mt) acc[mt] = mfma16(kf[mt], qf[kk], acc[mt]); }
        u32x2 sp[2][8]; float wi2[2], rdn[2];
#pragma unroll
        for (int dir = 0; dir < 2; ++dir) {
            const float rt = rt2[dir * 128 + t], wi = winter[dir * 128 + t], mi = minv[dir * 128 + t];
            const int sgn = dir ? -1 : 1, dl2 = (int)opaque((unsigned)(sgn * dlt));
            float dsum = 0.f;
#pragma unroll
            for (int mt = 0; mt < 8; ++mt) { const f32x4 ct = *(const LAS f32x4*)(ct2 + dir * 128 + 16 * mt + 4 * fq); float o[4];
#pragma unroll
                for (int e = 0; e < 4; ++e) { const bool ok = sgn * (16 * mt + e) <= dl2; o[e] = ok ? acc[mt][e] * __builtin_amdgcn_exp2f(rt + ct[e]) : 0.f; dsum += o[e]; }
                sp[dir][mt].x = pk2(o[0], o[1]); sp[dir][mt].y = pk2(o[2], o[3]); }
            dsum += __shfl_xor(dsum, 16); dsum += __shfl_xor(dsum, 32);
            float qn = 0.f;
#pragma unroll
            for (int kk = 0; kk < 4; ++kk)
#pragma unroll
                for (int e = 0; e < 8; ++e) qn += __uint_as_float(((unsigned)(unsigned short)qf[kk][e]) << 16) * ninl[dir * 128 + 32 * kk + 8 * fq + e];
            qn += __shfl_xor(qn, 16); qn += __shfl_xor(qn, 32);
            const float den = wi * qn + dsum; wi2[dir] = wi; rdn[dir] = 1.0f / fmaxf(fabsf(den), mi); }
        f32x4 Hs[8];
#pragma unroll
        for (int mt = 0; mt < 8; ++mt) Hs[mt] = (f32x4){0.f, 0.f, 0.f, 0.f};
#pragma unroll
        for (int dir = 0; dir < 2; ++dir) {
            LAS unsigned char* CT = F.lds + (dir ? M3_CT1 : M3_CT0);
#pragma unroll
            for (int mt = 0; mt < 8; ++mt) acc[mt] = (f32x4){0.f, 0.f, 0.f, 0.f};
#pragma unroll
            for (int kk = 0; kk < 4; ++kk) { bf16x8 cf[8];
#pragma unroll
                for (int mt = 0; mt < 8; ++mt) cf[mt] = *(const LAS bf16x8*)(CT + fb16 + 16 * mt * TP + 64 * kk);
#pragma unroll
                for (int mt = 0; mt < 8; ++mt) acc[mt] = mfma16(cf[mt], qf[kk], acc[mt]); }
            const float wi = wi2[dir], rden = rdn[dir];
#pragma unroll
            for (int mt = 0; mt < 8; ++mt) acc[mt] = acc[mt] * wi;
#pragma unroll
            for (int kk = 0; kk < 4; ++kk) {
                if (dir ? (2 * kk + 1 >= w) : (2 * kk <= w)) { u32x2 lo[8], hi[8];
                    const u32x4 bv = (u32x4){sp[dir][2 * kk].x, sp[dir][2 * kk].y, sp[dir][2 * kk + 1].x, sp[dir][2 * kk + 1].y};
#pragma unroll
                    for (int mt = 0; mt < 8; ++mt) { const LAS unsigned char* vp = VT + fb8 + 16 * mt * TP + 64 * kk; lo[mt] = *(const LAS u32x2*)vp; hi[mt] = *(const LAS u32x2*)(vp + 32); }
#pragma unroll
                    for (int mt = 0; mt < 8; ++mt) { const u32x4 av = (u32x4){lo[mt].x, lo[mt].y, hi[mt].x, hi[mt].y};
                        acc[mt] = mfma16(__builtin_bit_cast(bf16x8, av), __builtin_bit_cast(bf16x8, bv), acc[mt]); } } }
#pragma unroll
            for (int mt = 0; mt < 8; ++mt) Hs[mt] = Hs[mt] + acc[mt] * rden;
        }
        f32x4 hn[8]; u32x2 ogr[8]; const unsigned t_o = opaque((unsigned)t), fq_o = opaque((unsigned)fq);
#pragma unroll
        for (int mt = 0; mt < 8; ++mt) { hn[mt] = ldg<f32x4>(F.hnorm + h * 128 + 16 * mt, (4 * fq_o) * 4); ogr[mt] = ldg<u32x2>(F.P + (size_t)R0 * 2048 + 1024 + h * 128 + 16 * mt, (t_o * 2048 + 4 * fq_o) * 2); }
        float ss = 0.f;
#pragma unroll
        for (int mt = 0; mt < 8; ++mt) ss += (Hs[mt][0] * Hs[mt][0] + Hs[mt][1] * Hs[mt][1]) + (Hs[mt][2] * Hs[mt][2] + Hs[mt][3] * Hs[mt][3]);
        ss += __shfl_xor(ss, 16); ss += __shfl_xor(ss, 32);
        const float rr = rsqrtf(ss * (1.0f / HD) + EPS);
        bf16* mixb = F.MIX + (size_t)(R0 >> 8) * (256 * 1024) + (size_t)(2 * h) * (256 * 64) + (size_t)(R0 & 255) * 64;
#pragma unroll
        for (int mt = 0; mt < 8; ++mt) { const u32x2 ow = ogr[mt];
            const float o0 = bflo(ow.x), o1 = bfhi(ow.x), o2 = bflo(ow.y), o3 = bfhi(ow.y);
            u32x2 r; r.x = pk2(Hs[mt][0] * rr * hn[mt][0] * fsigmoid(o0), Hs[mt][1] * rr * hn[mt][1] * fsigmoid(o1));
            r.y = pk2(Hs[mt][2] * rr * hn[mt][2] * fsigmoid(o2), Hs[mt][3] * rr * hn[mt][3] * fsigmoid(o3));
            stg<u32x2>(mixb + (size_t)(mt >> 2) * (256 * 64) + 16 * (mt & 3), (t_o * 64 + 4 * fq_o) * 2, r); }
        if (!has_next) break;
        unit = unext;
    }
}

#define XB_TMO      128
#define XB_XCNT(j)  (256  + 64 * (j))
#define XB_XSUB(j)  (1280 + 64 * (j))
#define XB_XGEN(j)  (2304 + 64 * (j))
#define XB_TOP      3328
#define XB_TOPGEN   3392
#define XCD_BAR_WORDS 3456
#define XB_SPIN_CAP (1u << 18)

__device__ __forceinline__ unsigned xb_ld(unsigned* p)              { return __hip_atomic_load(p, __ATOMIC_RELAXED, __HIP_MEMORY_SCOPE_AGENT); }
__device__ __forceinline__ unsigned xb_add(unsigned* p, unsigned v) { return __hip_atomic_fetch_add(p, v, __ATOMIC_RELAXED, __HIP_MEMORY_SCOPE_AGENT); }
__device__ __forceinline__ unsigned xb_xcc_id() { return (unsigned)__builtin_amdgcn_s_getreg((3 << 11) | 20) & 0xFu; }
#define XB_SPIN(cond, bar) do { unsigned _sp = 0; while (cond) { __builtin_amdgcn_s_sleep(1); \
    if ((++_sp & 255u) == 0u) { if (xb_ld(&(bar)[XB_TMO])) break; if (_sp > XB_SPIN_CAP) { atomicAdd(&(bar)[XB_TMO], 1u); break; } } } } while (0)

struct XcdBarrier {
    unsigned* bar; unsigned x;
    volatile LAS unsigned* st;
};

__device__ __forceinline__ XcdBarrier xcd_barrier_post(unsigned* bar, volatile LAS unsigned* st) {
    XcdBarrier b; b.bar = bar; b.x = xb_xcc_id(); b.st = st;
    if (threadIdx.x == 0) (void)xb_add(&bar[XB_XCNT(b.x)], 1u);
    return b;
}
__device__ __forceinline__ void xcd_barrier_complete(unsigned* bar, unsigned x, unsigned& nloc, unsigned& nx) {
    const unsigned G = gridDim.x * gridDim.y * gridDim.z;
    unsigned sum, cnt, mine, sp = 0u;
    for (;;) {
        sum = 0u; cnt = 0u; mine = 0u;
#pragma unroll
        for (unsigned j = 0; j < 16; ++j) { const unsigned c = xb_ld(&bar[XB_XCNT(j)]); sum += c; cnt += (c > 0u) ? 1u : 0u; mine = (j == x) ? c : mine; }
        if (sum == G) break;
        __builtin_amdgcn_s_sleep(1);
        if ((++sp & 255u) == 0u) { if (xb_ld(&bar[XB_TMO])) break; if (sp > XB_SPIN_CAP) { atomicAdd(&bar[XB_TMO], 1u); break; } }
    }
    nloc = mine > 0u ? mine : 1u; nx = cnt > 0u ? cnt : 1u;
}

__device__ __forceinline__ void xcd_barrier(const XcdBarrier& b) {
    asm volatile("s_waitcnt vmcnt(0)" ::: "memory");
    __syncthreads();
    if (threadIdx.x == 0) {
        unsigned* bar = b.bar;
        __builtin_amdgcn_s_waitcnt(0);
        unsigned nloc = b.st[0], nx = b.st[1];
        if (nloc == 0u) { xcd_barrier_complete(bar, b.x, nloc, nx); b.st[0] = nloc; b.st[1] = nx; }
        const unsigned old = xb_add(&bar[XB_XSUB(b.x)], 1u);
        const unsigned gen = old / nloc;
        if (old + 1u == (gen + 1u) * nloc) {
            __builtin_amdgcn_fence(__ATOMIC_RELEASE, "agent");
            asm volatile("s_waitcnt vmcnt(0)" ::: "memory");
            const unsigned og = xb_add(&bar[XB_TOP], 1u);
            const unsigned tg = og / nx;
            if (og + 1u == (tg + 1u) * nx) xb_add(&bar[XB_TOPGEN], 1u);
            else XB_SPIN(xb_ld(&bar[XB_TOPGEN]) == tg, bar);
            __builtin_amdgcn_fence(__ATOMIC_ACQUIRE, "agent");
            xb_add(&bar[XB_XGEN(b.x)], 1u);
            asm volatile("s_waitcnt vmcnt(0)" ::: "memory");
        } else {
            XB_SPIN(xb_ld(&bar[XB_XGEN(b.x)]) == gen, bar);
            __builtin_amdgcn_fence(__ATOMIC_ACQUIRE, "agent");
            asm volatile("s_waitcnt vmcnt(0)" ::: "memory");
        }
    }
    __syncthreads();
}

#ifndef PROBE_MASK
#define PROBE_MASK 0
#endif
#ifndef PREFETCH_MB
#define PREFETCH_MB 32
#endif
constexpr int N_PHASES = 14;
__global__ void __launch_bounds__(NTHREADS, 2) fwd_kernel(Args args) {
    extern __shared__ __attribute__((aligned(16))) unsigned char lds_raw[];
    Ctx F;
    F.lds = (LAS unsigned char*)lds_raw;
    F.tid = threadIdx.x; F.lane = F.tid & 63; F.wave = __builtin_amdgcn_readfirstlane(F.tid >> 6); F.G = gridDim.x; F.bid = blockIdx.x; F.probe = args.probe;
    F.x = args.in[0]; F.c = args.in[1]; F.ctx = args.in[2]; F.cctx = args.in[3]; F.wmod = args.in[4]; F.bmod = args.in[5]; F.npre = args.in[6]; F.npost = args.in[7];
    F.fwin = args.in[8]; F.fwout = args.in[9]; F.win = args.in[10]; F.wout = args.in[11]; F.convw = args.in[12]; F.convb = args.in[13]; F.wq = args.in[14]; F.wk = args.in[15];
    F.ibias = args.in[16]; F.fbias = args.in[17]; F.hnorm = args.in[18]; F.poolw = args.in[19]; F.pscale = args.in[20];
    F.out = args.out; F.ws = args.ws; unsigned char* ws = args.ws;
    F.mod = (float*)(ws + WS_MOD); F.wqt = (bf16*)(ws + WS_WQT); F.wkt = (bf16*)(ws + WS_WKT); F.mloc = (float*)(ws + WS_MLOC); F.gsum = (float*)(ws + WS_G); F.min_ = (float*)(ws + WS_MIN);
    F.gb = (float*)(ws + WS_GB); F.cn = (float*)(ws + WS_CN); F.nin = (float*)(ws + WS_NIN); F.gates = (float*)(ws + WS_GATES);
    F.W1 = (bf16*)(ws + WS_W1); F.W2 = (bf16*)(ws + WS_W2); F.WIN = (bf16*)(ws + WS_WIN); F.WOUT = (bf16*)(ws + WS_WOUT); F.Y = (bf16*)(ws + WS_Y); F.Z = (bf16*)(ws + WS_Z);
    F.H = (bf16*)(ws + WS_H); F.P = (bf16*)(ws + WS_P); F.Q = (bf16*)(ws + WS_Q); F.K = (bf16*)(ws + WS_K); F.CIN = (bf16*)(ws + WS_CIN); F.MIX = (bf16*)(ws + WS_MIX); F.CKV = (bf16*)(ws + WS_CKV); F.XB = (bf16*)(ws + WS_XB);
    const int lo = args.ph_lo, hi = args.ph_hi;
    volatile LAS unsigned* bst = (volatile LAS unsigned*)(F.lds + LDS_BYTES - 64);
    if (F.tid < 16) bst[F.tid] = 0u;
    __syncthreads();
    XcdBarrier bar; bar.bar = (unsigned*)(ws + WS_CTL) + 1024; bar.x = 0; bar.st = bst;
    if (hi - lo > 1) bar = xcd_barrier_post((unsigned*)(ws + WS_CTL) + 1024, bst);
#ifndef PROBE_MASK
#define PROBE_MASK 0
#endif
#define IN(k) (lo <= (k) && (k) < hi)
#if PROBE_MASK
#define REPS(k) _Pragma("unroll 1") for (int rep_ = 0; rep_ <= ((args.probe >> (k)) & 1); ++rep_)
#else
#define REPS(k)
#endif
#if PROBE_MASK
#define SEAM(k) do { if (IN(k) && IN((k) + 1)) { xcd_barrier(bar); } \
    if (tphase) { const unsigned long long tn_ = __builtin_amdgcn_s_memrealtime(); if (tphase == (k) + 1) tdur = tn_ - tprev; tprev = tn_; } } while (0)
    const int tphase = (args.probe >> 20) & 31;
    unsigned long long tprev = __builtin_amdgcn_s_memrealtime(), tdur = 0ull;
#else
#define SEAM(k) do { if (IN(k) && IN((k) + 1)) { xcd_barrier(bar); } } while (0)
    constexpr int tphase = 0; unsigned long long tprev = 0ull, tdur = 0ull; (void)tprev; (void)tdur;
#endif

    if (IN(0)) REPS(0) { p0_prologue(F);
        if (F.bid >= 144) {
            constexpr int PF_MB = PREFETCH_MB;
            const size_t n16 = (size_t)PF_MB * 65536; const int t = (F.bid - 144) * NTHREADS + F.tid, nt = (F.G - 144) * NTHREADS;
            for (size_t e = (size_t)t; e < n16; e += (size_t)nt * 8) { f32x4 v[8];
#pragma unroll
                for (int i = 0; i < 8; ++i) { const size_t ee = e + (size_t)i * nt; v[i] = (ee < n16) ? ((const f32x4*)F.x)[ee] : (f32x4){0.f, 0.f, 0.f, 0.f}; }
#pragma unroll
                for (int i = 0; i < 8; ++i) asm volatile("" :: "v"(v[i])); } } } SEAM(0);
    if (IN(1)) REPS(1) { convert_items(F, 0, 0, F.G);
        if (PROBE_MASK && ((args.probe >> 19) & 1)) { xcd_barrier(bar); if (tphase) { const unsigned long long tn_ = __builtin_amdgcn_s_memrealtime(); if (tphase == 15) tdur = tn_ - tprev; tprev = tn_; } }
        row_phase<false, 0, 0, true>(F, MT, 0.f, 0); } SEAM(1);
    if (IN(2)) { pg8::Gemm g{F.Y, F.W1, ML, 2 * FF, DM, 1}; pg8::StaticOrder S; S.init(ML, 2 * FF, F.G, F.bid); pg8::EpiSwiglu E{F.H, FF};
        pg8::gemm_phase<pg8::EpiSwiglu, pg8::StaticOrder, true, true>(F.lds, g, S, E); } SEAM(2);
    if (IN(3)) {
        const int ncx = (MC / 256) * (2 * FF / 256), gA = F.G - 8; unsigned* cxcnt = (unsigned*)(F.ws + WS_CTL) + CTXCNT_WORD;
        if (F.bid >= 8 && F.bid - 8 < ncx) {
            pg8::Gemm g{F.Y + (size_t)(ML / 256) * (256 * DM), F.W1, MC, 2 * FF, DM, 1}; pg8::StaticOrder S; S.init(MC, 2 * FF, gA, F.bid - 8);
            pg8::EpiSwiglu E{F.H + (size_t)(ML / 256) * (FF / 64) * (256 * 64), FF};
            pg8::gemm_phase<pg8::EpiSwiglu, pg8::StaticOrder, true, true>(F.lds, g, S, E);
            asm volatile("s_waitcnt vmcnt(0)" ::: "memory"); __syncthreads();
            if (F.tid == 0) { __builtin_amdgcn_fence(__ATOMIC_RELEASE, "agent"); asm volatile("s_waitcnt vmcnt(0)" ::: "memory");
                __hip_atomic_fetch_add(cxcnt, 1u, __ATOMIC_RELAXED, __HIP_MEMORY_SCOPE_AGENT); } }
        { pg8::Gemm g{F.H, F.W2, MT, DM, FF, 1}; pg8::GatedOrder S; S.init(MT, DM, F.G, F.bid, 2); S.cnt = cxcnt; S.need = (unsigned)min(ncx, gA); S.pm_gate = ML / 256; pg8::EpiStore E{F.Z, DM};
          pg8::gemm_phase<pg8::EpiStore, pg8::GatedOrder, true, true>(F.lds, g, S, E); }
        { const int nb3 = (MT / 256) * (DM / 256) - 2 * F.G;
          const int first = 8 + ncx;
          if (nb3 > 0 && nb3 <= 8 && first < F.G) { constexpr int cut = (IT_PART1 * 88) / 100;
              convert_items(F, 1, first, F.G - first, 0, cut); convert_items(F, 1, 8, ncx, cut, IT_PART1); }
          else convert_items(F, 1, 0, F.G); } } SEAM(3);
    if (IN(4)) { row_phase<true, 0, 1, true>(F, MT, 0.5f, 1); } SEAM(4);
    if (IN(5)) { pg8::Gemm g{F.Y, F.WIN, MT, 2304, DM, 1}; pg8::StaticOrder S; S.init(MT, 2304, F.G, F.bid); pg8::EpiInProj E{F.P, F.gates, F.ibias, F.fbias};
        pg8::gemm_phase<pg8::EpiInProj, pg8::StaticOrder, true, true>(F.lds, g, S, E); } SEAM(5);
    if (IN(6)) { REPS(15) m1_phase(F);
        if (PROBE_MASK && ((args.probe >> 18) & 1)) { xcd_barrier(bar); if (tphase) { const unsigned long long tn_ = __builtin_amdgcn_s_memrealtime(); if (tphase == 16) tdur = tn_ - tprev; tprev = tn_; } }
                 REPS(14) {
                 if (F.G == 256) {
                     const int nk = (F.bid < 16) ? 5 : 8;
                     for (int k = 0; k < nk; ++k) pool_unit(F, F.bid + 256 * k);
                     if (F.bid >= 16 && F.bid < 64) { const int e = F.bid - 16; pool_unit(F, e / 3 + 256 * (5 + e % 3)); } }
                 else for (int u = F.bid; u < NB * GRID_ROWS * 4; u += F.G) pool_unit(F, u); } } SEAM(6);
    if (IN(7)) REPS(7) { scan_phase(F); } SEAM(7);
    if (IN(8)) REPS(8) { m3_phase(F); } SEAM(8);
    if (IN(9)) REPS(9) { pg8::Gemm g{F.MIX, F.WOUT, ML, DM, DM, 1}; pg8::StaticOrder S; S.init(ML, DM, F.G, F.bid); pg8::EpiStore E{F.Z, DM};
        pg8::gemm_phase<pg8::EpiStore, pg8::StaticOrder, true, true>(F.lds, g, S, E); } SEAM(9);
    if (IN(10)) { row_phase<true, 1, 1, true>(F, ML, 1.0f, 2); } SEAM(10);
    if (IN(11)) { pg8::Gemm g{F.Y, F.W1 + (size_t)2 * FF * DM, ML, 2 * FF, DM, 1}; pg8::StaticOrder S; S.init(ML, 2 * FF, F.G, F.bid); pg8::EpiSwiglu E{F.H, FF};
        pg8::gemm_phase<pg8::EpiSwiglu, pg8::StaticOrder, true, true>(F.lds, g, S, E); } SEAM(11);
    if (IN(12)) { pg8::Gemm g{F.H, F.W2 + (size_t)DM * FF, ML, DM, FF, 1}; pg8::StaticOrder S; S.init(ML, DM, F.G, F.bid, 1); pg8::EpiStore E{F.Z, DM};
        pg8::gemm_phase<pg8::EpiStore, pg8::StaticOrder, true, true>(F.lds, g, S, E); } SEAM(12);
    if (IN(13)) { row_phase<true, 1, 2, false>(F, ML, 0.5f, 3); }
    if (tphase) { asm volatile("s_waitcnt vmcnt(0)" ::: "memory"); __syncthreads();
        const unsigned long long tn_ = __builtin_amdgcn_s_memrealtime(); if (tphase == 14) tdur = tn_ - tprev;
        if (F.bid == 0) { const unsigned long long t0_ = __builtin_amdgcn_s_memrealtime(); while (__builtin_amdgcn_s_memrealtime() - t0_ < 10ull * tdur) __builtin_amdgcn_s_sleep(8); } }
#undef IN
#undef SEAM
}

#ifndef PROBE_MASK
#define PROBE_MASK 0
#endif
#ifndef N_LAUNCHES
#define N_LAUNCHES 1
#endif
extern "C" void kernel_launch(void* const* d_in, const int* in_sizes, int n_in, void* d_out, int out_size, void* d_ws, size_t ws_size, hipStream_t stream) {
    static int grid = 0;
    if (grid == 0) {
        if (n_in != 21 || in_sizes[0] != ML * DM || out_size != ML * DM || ws_size < WS_END) { fprintf(stderr, "kernel_launch: unexpected shapes (n_in %d, in0 %d, out %d, ws %zu)\n", n_in, n_in > 0 ? in_sizes[0] : -1, out_size, ws_size); grid = -1; return; }
        int dev = 0, cus = 0, per_cu = 0;
        (void)hipGetDevice(&dev); (void)hipDeviceGetAttribute(&cus, hipDeviceAttributeMultiprocessorCount, dev);
        (void)hipFuncSetAttribute((const void*)fwd_kernel, hipFuncAttributeMaxDynamicSharedMemorySize, LDS_BYTES);
        (void)hipOccupancyMaxActiveBlocksPerMultiprocessor(&per_cu, (const void*)fwd_kernel, NTHREADS, LDS_BYTES);
        (void)hipGetLastError();
        if (per_cu < 1) { fprintf(stderr, "kernel_launch: occupancy query says %d blocks per CU\n", per_cu); grid = -1; return; }
        grid = cus;
    }
    if (grid < 0) return;
    Args a{};
    for (int i = 0; i < 21; ++i) a.in[i] = (const float*)d_in[i];
    a.out = (float*)d_out; a.ws = (unsigned char*)d_ws; a.probe = PROBE_MASK;
    if (N_LAUNCHES == 1) {
        (void)hipMemsetAsync((char*)d_ws + WS_CTL, 0, CTL_ZERO_BYTES, stream);
        a.ph_lo = 0; a.ph_hi = N_PHASES; void* kargs[] = {&a};
        hipError_t e = hipLaunchCooperativeKernel((const void*)fwd_kernel, dim3(grid), dim3(NTHREADS), kargs, LDS_BYTES, stream);
        if (e != hipSuccess) fprintf(stderr, "cooperative launch failed: %s (grid %d)\n", hipGetErrorString(e), grid);
    } else {
        for (int p = 0; p < N_PHASES; ++p) { a.ph_lo = p; a.ph_hi = p + 1; hipLaunchKernelGGL(fwd_kernel, dim3(grid), dim3(NTHREADS), LDS_BYTES, stream, a); }
    }
}
```
